# Optimizing an MI355X kernel written in HIP

```python
import math
import jax, jax.numpy as jnp
from jax import lax
import numpy as np

D_MODEL = 1024
BATCH = 16
SEQ = 2048
DEPTH = 2

N_HEADS = 16
HEAD_DIM = D_MODEL // N_HEADS
N_KV_HEADS = 4
GROUP = N_HEADS // N_KV_HEADS
ATTN_WIDTH = N_HEADS * HEAD_DIM
KV_WIDTH = N_KV_HEADS * HEAD_DIM
IDX_HEADS = 8
IDX_DIM = 64
DSA_TOPK_MAX = 256
MOBA_BLOCK = 256
MOBA_TOPK = 3
REL_BUCKETS = 32
REL_MAX_DIST = 128
EPS = 1e-6
N_A_LAYERS = max(1, DEPTH // 2)
N_B_LAYERS = DEPTH - N_A_LAYERS
QBLK_A = 64
QBLK_B = 16
A_PARTS = [ATTN_WIDTH, KV_WIDTH, KV_WIDTH, ATTN_WIDTH, IDX_HEADS * IDX_DIM, IDX_HEADS, IDX_DIM]
A_COLS = sum(A_PARTS)
A_SPLITS = list(np.cumsum(A_PARTS)[:-1])

kernel_name = "yoco_dsa_moba_hybrid"


def rmsnorm(x, g):
    xf = x.astype(jnp.float32)
    y = xf * lax.rsqrt(jnp.mean(xf * xf, axis=-1, keepdims=True) + EPS)
    return (y * g.astype(jnp.float32)).astype(x.dtype)


def rel_bucket(dist):
    n = jnp.maximum(dist, 0)
    max_exact = REL_BUCKETS // 2
    nf = jnp.maximum(n, 1).astype(jnp.float32)
    large = max_exact + (jnp.log(nf / max_exact) / math.log(REL_MAX_DIST / max_exact)
                         * (REL_BUCKETS - max_exact)).astype(jnp.int32)
    large = jnp.minimum(large, REL_BUCKETS - 1)
    return jnp.where(n < max_exact, n, large)


def dsa_layer(x, norm_g, w_in, qn_g, kn_g, w_out, rel_bias):
    B, T, _ = x.shape
    h = rmsnorm(x, norm_g)
    q, k, v, gate, iq, iw, ik = jnp.split(h @ w_in, A_SPLITS, axis=-1)
    q = rmsnorm(q.reshape(B, T, N_KV_HEADS, GROUP, HEAD_DIM), qn_g)
    k = rmsnorm(k.reshape(B, T, N_KV_HEADS, HEAD_DIM), kn_g)
    v = v.reshape(B, T, N_KV_HEADS, HEAD_DIM)
    iq = iq.reshape(B, T, IDX_HEADS, IDX_DIM)
    iw = iw * IDX_HEADS ** -0.5
    topk = min(DSA_TOPK_MAX, T // 4)
    nblk = T // QBLK_A
    spos = jnp.arange(T)
    bidx = jnp.arange(B)[:, None, None]

    def block(i):
        t0 = i * QBLK_A
        qb = lax.dynamic_slice_in_dim(q, t0, QBLK_A, axis=1)
        iqb = lax.dynamic_slice_in_dim(iq, t0, QBLK_A, axis=1)
        iwb = lax.dynamic_slice_in_dim(iw, t0, QBLK_A, axis=1)
        tpos = t0 + jnp.arange(QBLK_A)
        causal = spos[None, :] <= tpos[:, None]
        isc = jnp.einsum('bqhd,bsd->bqhs', iqb, ik) * IDX_DIM ** -0.5
        iscore = jnp.einsum('bqh,bqhs->bqs', iwb, jax.nn.relu(isc)).astype(jnp.float32)
        iscore = jnp.where(causal[None], iscore, -jnp.inf)
        _, sel = lax.top_k(iscore, topk)
        valid = sel <= tpos[None, :, None]
        ks = k[bidx, sel]
        vs = v[bidx, sel]
        logits = jnp.einsum('bqgjd,bqkgd->bqgjk', qb, ks).astype(jnp.float32) * HEAD_DIM ** -0.5
        bias = rel_bias[rel_bucket(tpos[None, :, None] - sel)]
        bias = bias.reshape(B, QBLK_A, topk, N_KV_HEADS, GROUP).transpose(0, 1, 3, 4, 2)
        logits = jnp.where(valid[:, :, None, None, :], logits + bias.astype(jnp.float32), -jnp.inf)
        p = jax.nn.softmax(logits, axis=-1).astype(vs.dtype)
        o = jnp.einsum('bqgjk,bqkgd->bqgjd', p, vs)
        return o.reshape(B, QBLK_A, ATTN_WIDTH)

    o = lax.map(block, jnp.arange(nblk))
    o = o.transpose(1, 0, 2, 3).reshape(B, T, ATTN_WIDTH)
    return x + (o * jax.nn.silu(gate)) @ w_out


def shared_kv(x, norm_g, w_kv, kn_g):
    B, T, _ = x.shape
    h = rmsnorm(x, norm_g)
    k, v = jnp.split(h @ w_kv, 2, axis=-1)
    k = rmsnorm(k.reshape(B, T, N_KV_HEADS, HEAD_DIM), kn_g)
    v = v.reshape(B, T, N_KV_HEADS, HEAD_DIM)
    nb = -(-T // MOBA_BLOCK)
    pad = nb * MOBA_BLOCK - T
    kp = jnp.pad(k, ((0, 0), (0, pad), (0, 0), (0, 0)))
    vp = jnp.pad(v, ((0, 0), (0, pad), (0, 0), (0, 0)))
    kb = kp.reshape(B, nb, MOBA_BLOCK, N_KV_HEADS, HEAD_DIM).transpose(0, 3, 1, 2, 4)
    vb = vp.reshape(B, nb, MOBA_BLOCK, N_KV_HEADS, HEAD_DIM).transpose(0, 3, 1, 2, 4)
    counts = jnp.minimum(T - jnp.arange(nb) * MOBA_BLOCK, MOBA_BLOCK).astype(kb.dtype)
    kmean = kb.sum(axis=3) / counts[None, None, :, None]
    return kb, vb, kmean


def moba_layer(x, norm_g, w_in, qn_g, w_out, rel_bias, kb, vb, kmean):
    B, T, _ = x.shape
    h = rmsnorm(x, norm_g)
    q, gate = jnp.split(h @ w_in, 2, axis=-1)
    q = rmsnorm(q.reshape(B, T, N_KV_HEADS, GROUP, HEAD_DIM), qn_g)
    nb = kb.shape[2]
    nsel = min(MOBA_TOPK, nb - 1)
    bias_g = rel_bias.reshape(REL_BUCKETS, N_KV_HEADS, GROUP).transpose(1, 0, 2)
    r = jnp.arange(MOBA_BLOCK)
    bidx = jnp.arange(B)[:, None, None, None]
    gidx = jnp.arange(N_KV_HEADS)[None, None, :, None]
    nblk = T // QBLK_B

    def block(i):
        t0 = i * QBLK_B
        own = t0 // MOBA_BLOCK
        qb = lax.dynamic_slice_in_dim(q, t0, QBLK_B, axis=1)
        tpos = t0 + jnp.arange(QBLK_B)
        own_blk = jnp.full((B, QBLK_B, N_KV_HEADS, 1), own, dtype=jnp.int32)
        own_ok = jnp.ones((B, QBLK_B, N_KV_HEADS, 1), dtype=bool)
        if nsel > 0:
            gs = jnp.einsum('bqgjd,bgnd->bqgn', qb, kmean).astype(jnp.float32)
            gs = jnp.where(jnp.arange(nb) < own, gs, -jnp.inf)
            gv, sel = lax.top_k(gs, nsel)
            blocks = jnp.concatenate([sel.astype(jnp.int32), own_blk], axis=-1)
            ok = jnp.concatenate([jnp.isfinite(gv), own_ok], axis=-1)
        else:
            blocks, ok = own_blk, own_ok
        S = blocks.shape[-1]
        ks = kb[bidx, gidx, blocks]
        vs = vb[bidx, gidx, blocks]
        kpos = blocks[..., None] * MOBA_BLOCK + r
        mask = ok[..., None] & (kpos <= tpos[None, :, None, None, None])
        logits = jnp.einsum('bqgjd,bqgsrd->bqgjsr', qb, ks).astype(jnp.float32) * HEAD_DIM ** -0.5
        bucket = rel_bucket(tpos[None, :, None, None, None] - kpos)
        bias = bias_g[gidx[..., None], bucket]
        bias = jnp.moveaxis(bias, -1, 3).astype(jnp.float32)
        logits = jnp.where(mask[:, :, :, None], logits + bias, -jnp.inf)
        logits = logits.reshape(B, QBLK_B, N_KV_HEADS, GROUP, S * MOBA_BLOCK)
        p = jax.nn.softmax(logits, axis=-1).astype(vs.dtype)
        p = p.reshape(B, QBLK_B, N_KV_HEADS, GROUP, S, MOBA_BLOCK)
        o = jnp.einsum('bqgjsr,bqgsrd->bqgjd', p, vs)
        return o.reshape(B, QBLK_B, ATTN_WIDTH)

    o = lax.map(block, jnp.arange(nblk))
    o = o.transpose(1, 0, 2, 3).reshape(B, T, ATTN_WIDTH)
    return x + (o * jax.nn.silu(gate)) @ w_out


def setup_inputs(seed: int = 0) -> dict:
    key = jax.random.key(seed)
    ks = jax.random.split(key, 16)
    f32 = jnp.float32

    def nrm(k, shape, scale):
        return jax.random.normal(k, shape, f32) * scale

    def gain(k, shape):
        return 1.0 + 0.02 * jax.random.normal(k, shape, f32)

    return {
        "x": jax.random.normal(ks[0], (BATCH, SEQ, D_MODEL), f32),
        "norm_a_g": gain(ks[1], (N_A_LAYERS, D_MODEL)),
        "w_in_a": nrm(ks[2], (N_A_LAYERS, D_MODEL, A_COLS), D_MODEL ** -0.5),
        "qn_a_g": gain(ks[3], (N_A_LAYERS, HEAD_DIM)),
        "kn_a_g": gain(ks[4], (N_A_LAYERS, HEAD_DIM)),
        "w_out_a": nrm(ks[5], (N_A_LAYERS, ATTN_WIDTH, D_MODEL), ATTN_WIDTH ** -0.5),
        "rel_bias": nrm(ks[6], (REL_BUCKETS, N_HEADS), 0.5),
        "norm_kv_g": gain(ks[7], (D_MODEL,)),
        "w_kv": nrm(ks[8], (D_MODEL, 2 * KV_WIDTH), D_MODEL ** -0.5),
        "kn_b_g": gain(ks[9], (HEAD_DIM,)),
        "norm_b_g": gain(ks[10], (N_B_LAYERS, D_MODEL)),
        "w_in_b": nrm(ks[11], (N_B_LAYERS, D_MODEL, 2 * ATTN_WIDTH), D_MODEL ** -0.5),
        "qn_b_g": gain(ks[12], (N_B_LAYERS, HEAD_DIM)),
        "w_out_b": nrm(ks[13], (N_B_LAYERS, ATTN_WIDTH, D_MODEL), ATTN_WIDTH ** -0.5),
    }


def reference(x, norm_a_g, w_in_a, qn_a_g, kn_a_g, w_out_a, rel_bias, norm_kv_g, w_kv,
              kn_b_g, norm_b_g, w_in_b, qn_b_g, w_out_b):
    h = x
    kb = vb = kmean = None
    for layer in range(DEPTH):
        if layer < N_A_LAYERS:
            h = dsa_layer(h, norm_a_g[layer], w_in_a[layer], qn_a_g[layer], kn_a_g[layer],
                          w_out_a[layer], rel_bias)
            if layer == N_A_LAYERS - 1:
                kb, vb, kmean = shared_kv(h, norm_kv_g, w_kv, kn_b_g)
        else:
            j = layer - N_A_LAYERS
            h = moba_layer(h, norm_b_g[j], w_in_b[j], qn_b_g[j], w_out_b[j], rel_bias,
                           kb, vb, kmean)
    return h
```

```cpp
#include <hip/hip_runtime.h>
#include <hip/hip_cooperative_groups.h>
#include <cstdio>
#include <cstdint>
__device__ __forceinline__ int lane_id_hw() { unsigned z = 0u; asm volatile("" : "+v"(z)); return (int)__builtin_amdgcn_mbcnt_hi(~0u, __builtin_amdgcn_mbcnt_lo(~0u, z)); }
namespace pg8 {
#define PG8_LAS __attribute__((address_space(3)))
typedef unsigned short bf16_t;
typedef short bf16x8 __attribute__((ext_vector_type(8)));
typedef float f32x4 __attribute__((ext_vector_type(4)));
typedef unsigned u32x4 __attribute__((ext_vector_type(4)));
constexpr int BM = 256, BK = 64, HALF = 128, HTB = HALF * BK * 2  , STAGE_BYTES = 8 * HTB, NXCD = 8, WGM = 8;

__host__ __device__ __forceinline__ int lds_byte(int r, int c) { const int st = (r >> 4) * 2 + (c >> 5), rr = r & 15, cc = c & 31, ob = rr * 64 + cc * 2; return st * 1024 + (ob ^ (((ob >> 9) & 1) << 5)); }
__host__ __device__ __forceinline__ void stage_rc(int b, int& R, int& C) { const int st = b / 1024, sb = b % 1024, swz = sb ^ (((sb >> 9) & 1) << 5); R = (st >> 1) * 16 + swz / 64; C = (st & 1) * 32 + (swz % 64) / 2; }
__host__ __device__ __forceinline__ int perm32(int rho) { const int n = rho >> 4, i = rho & 15; return 8 * (i >> 2) + 4 * n + (i & 3); }

struct Unit { int pm, pn; };
struct Gemm { const bf16_t* A; const bf16_t* Bt; int M, N, K; };

struct StaticOrder {
    int nM, nN, nwg, G, c;
    __host__ __device__ void init(int M, int N, int G_, int c_) { nM = M / BM; nN = N / BM; nwg = nM * nN; G = G_; c = c_; }
    __host__ __device__ bool next(int i, Unit& u) const {
        const long L = (long)i * G + c; if (L >= nwg) return false;
        int wgid = (int)L; { const int q = nwg / NXCD, r = nwg % NXCD, xcd = wgid % NXCD, off = wgid / NXCD; wgid = (xcd < r ? xcd * (q + 1) : r * (q + 1) + (xcd - r) * q) + off; }
        const int nig = WGM * nN, gid = wgid / nig, fm = gid * WGM, gsz = (nM - fm) < WGM ? (nM - fm) : WGM;
        u.pm = fm + ((wgid % nig) % gsz); u.pn = (wgid % nig) / gsz; return true;
    }
    __device__ __forceinline__ void a_ready(const Unit&) const {}
    __device__ __forceinline__ void done(const Unit&) const {}
};

template <class Epi, class Sched, bool ALIGN_EPI = false, bool SP2 = false>
__device__ __forceinline__ void gemm_phase(PG8_LAS unsigned char* lds, const Gemm g, const Sched& S, const Epi& E, int wave_) {
    const int tid = wave_ * 64 + lane_id_hw(), wid = __builtin_amdgcn_readfirstlane(tid >> 6), lane = tid & 63, wr = wid >> 2, wc = wid & 3, fr = lane & 15, fq = lane >> 4;
    const int K = g.K, nt = K / BK;
    unsigned voffA[2], voffB[2];
#pragma unroll
    for (int i = 0; i < 2; ++i) { int R, C; stage_rc(tid * 16 + i * 8192, R, C); const int Rb = Epi::PERM ? ((R & ~31) + perm32(R & 31)) : R;
        voffA[i] = (unsigned)(R * K + C) * 2u; voffB[i] = (unsigned)(Rb * K + C) * 2u; }
    const size_t kstep = (size_t)(BK * 2);
    const size_t hstep = (size_t)HALF * K * 2;
    const size_t tstep = 2 * hstep;
    const unsigned ldsw = (unsigned)wid * 1024u;
    const int aoff = lds_byte(wr * 64 + fr, fq * 8), boff = lds_byte(wc * 32 + fr, fq * 8);
#define PG8_SA(b, h) (((b) * 2 + (h)) * HTB)
#define PG8_SB(b, h) ((4 + (b) * 2 + (h)) * HTB)
#define PG8_STAGE(bufoff, gbase, voff) do { _Pragma("unroll") for (int _i = 0; _i < 2; ++_i) \
        __builtin_amdgcn_global_load_lds((const unsigned*)((const char*)(gbase) + (voff)[_i]), (PG8_LAS unsigned*)(lds + (bufoff) + ldsw + _i * 8192), 16, 0, 0); } while (0)
#define PG8_LDA(dst, b, h) do { _Pragma("unroll") for (int m = 0; m < 4; ++m) _Pragma("unroll") for (int k = 0; k < 2; ++k) dst[m][k] = *(const PG8_LAS bf16x8*)(lds + PG8_SA(b, h) + aoff + m * 2048 + k * 1024); } while (0)
#define PG8_LDB(dst, b, h) do { _Pragma("unroll") for (int n = 0; n < 2; ++n) _Pragma("unroll") for (int k = 0; k < 2; ++k) dst[n][k] = *(const PG8_LAS bf16x8*)(lds + PG8_SB(b, h) + boff + n * 2048 + k * 1024); } while (0)
#define PG8_MMA(ai, bj, At, Bt) do { __builtin_amdgcn_s_setprio(1); _Pragma("unroll") for (int m = 0; m < 4; ++m) _Pragma("unroll") for (int n = 0; n < 2; ++n) _Pragma("unroll") for (int k = 0; k < 2; ++k) \
        acc[ai][bj][m][n] = __builtin_amdgcn_mfma_f32_16x16x32_bf16(Bt[n][k], At[m][k], acc[ai][bj][m][n], 0, 0, 0); __builtin_amdgcn_s_setprio(0); } while (0)
#define PG8_WAIT_V(n) asm volatile("s_waitcnt vmcnt(" #n ")" ::: "memory")
#define PG8_WAIT_L(n) asm volatile("s_waitcnt lgkmcnt(" #n ")" ::: "memory")
#define PG8_BAR __builtin_amdgcn_s_barrier()
#define PG8_SCHED __builtin_amdgcn_sched_barrier(0)
    Unit cur, nxt; int ui = 0;
    if (!S.next(0, cur)) return;
    f32x4 acc[2][2][4][2];
#pragma unroll
    for (int a = 0; a < 2; ++a)
#pragma unroll
        for (int b = 0; b < 2; ++b)
#pragma unroll
            for (int m = 0; m < 4; ++m)
#pragma unroll
                for (int n = 0; n < 2; ++n) acc[a][b][m][n] = (f32x4){0.f, 0.f, 0.f, 0.f};
    bf16x8 At[4][2], B0[2][2], B1[2][2];
    const char* cA = (const char*)g.A + (size_t)cur.pm * tstep; const char* cB = (const char*)g.Bt + (size_t)cur.pn * tstep;
    S.a_ready(cur);
    if constexpr (SP2) {
        PG8_STAGE(PG8_SB(0, 0), cB, voffB); PG8_STAGE(PG8_SB(0, 1), cB + hstep, voffB); PG8_STAGE(PG8_SA(0, 0), cA, voffA); PG8_STAGE(PG8_SA(0, 1), cA + hstep, voffA);
        if (wr == 1) PG8_BAR;
        PG8_WAIT_V(2); PG8_BAR;
        PG8_STAGE(PG8_SB(1, 0), cB + kstep, voffB); PG8_STAGE(PG8_SA(1, 0), cA + kstep, voffA); PG8_STAGE(PG8_SB(1, 1), cB + hstep + kstep, voffB);
        PG8_WAIT_V(6); PG8_BAR;
    } else {
        PG8_STAGE(PG8_SB(0, 0), cB, voffB); PG8_STAGE(PG8_SA(0, 0), cA, voffA); PG8_STAGE(PG8_SB(0, 1), cB + hstep, voffB); PG8_STAGE(PG8_SA(0, 1), cA + hstep, voffA);
        if (wr == 1) PG8_BAR;
        PG8_WAIT_V(4); PG8_BAR;
        PG8_STAGE(PG8_SB(1, 0), cB + kstep, voffB); PG8_STAGE(PG8_SA(1, 0), cA + kstep, voffA); PG8_STAGE(PG8_SB(1, 1), cB + hstep + kstep, voffB);
        PG8_WAIT_V(6); PG8_BAR;
    }
    for (;;) {
        const bool has_next = S.next(ui + 1, nxt);
        const char* nA = has_next ? (const char*)g.A + (size_t)nxt.pm * tstep : cA; const char* nB = has_next ? (const char*)g.Bt + (size_t)nxt.pn * tstep : cB;
        for (int t = 0; t < nt; t += 2) {
            const bool last = (t == nt - 2);
            const char* a1 = cA + (size_t)(t + 1) * kstep;
            const char* a2 = last ? nA : cA + (size_t)(t + 2) * kstep; const char* b2 = last ? nB : cB + (size_t)(t + 2) * kstep;
            const char* a3 = a2 + kstep; const char* b3 = b2 + kstep;
            if (last && has_next) S.a_ready(nxt);
            if constexpr (SP2) {
            PG8_LDB(B0, 0, 0); PG8_LDB(B1, 0, 1); PG8_SCHED; PG8_LDA(At, 0, 0); PG8_STAGE(PG8_SA(1, 1), a1 + hstep, voffA);
            PG8_WAIT_V(8); PG8_WAIT_L(0); PG8_BAR; PG8_MMA(0, 0, At, B0); PG8_MMA(0, 1, At, B1); PG8_BAR; PG8_SCHED;
            PG8_LDA(At, 0, 1); PG8_STAGE(PG8_SB(0, 0), b2, voffB); PG8_STAGE(PG8_SB(0, 1), b2 + hstep, voffB); PG8_STAGE(PG8_SA(0, 0), a2, voffA);
            PG8_WAIT_V(8); PG8_WAIT_L(0); PG8_BAR; PG8_MMA(1, 0, At, B0); PG8_MMA(1, 1, At, B1); PG8_BAR; PG8_SCHED;
            PG8_LDB(B0, 1, 0); PG8_LDB(B1, 1, 1); PG8_SCHED; PG8_LDA(At, 1, 0); PG8_STAGE(PG8_SA(0, 1), a2 + hstep, voffA);
            PG8_WAIT_V(8); PG8_WAIT_L(0); PG8_BAR; PG8_MMA(0, 0, At, B0); PG8_MMA(0, 1, At, B1); PG8_BAR; PG8_SCHED;
            PG8_LDA(At, 1, 1); PG8_STAGE(PG8_SB(1, 0), b3, voffB); PG8_STAGE(PG8_SB(1, 1), b3 + hstep, voffB); PG8_STAGE(PG8_SA(1, 0), a3, voffA);
            PG8_WAIT_V(8); PG8_WAIT_L(0); PG8_BAR; PG8_MMA(1, 0, At, B0); PG8_MMA(1, 1, At, B1); PG8_BAR; PG8_SCHED;
            } else {
            PG8_LDB(B0, 0, 0); PG8_SCHED; PG8_LDA(At, 0, 0); PG8_STAGE(PG8_SA(1, 1), a1 + hstep, voffA);
            PG8_WAIT_L(8); PG8_BAR; PG8_WAIT_L(0); PG8_MMA(0, 0, At, B0); PG8_BAR; PG8_SCHED;
            PG8_LDB(B1, 0, 1); PG8_STAGE(PG8_SB(0, 0), b2, voffB);
            PG8_BAR; PG8_WAIT_L(0); PG8_MMA(0, 1, At, B1); PG8_BAR;
            PG8_LDA(At, 0, 1); PG8_STAGE(PG8_SA(0, 0), a2, voffA);
            PG8_BAR; PG8_WAIT_L(0); PG8_MMA(1, 0, At, B0); PG8_BAR; PG8_SCHED;
            PG8_STAGE(PG8_SB(0, 1), b2 + hstep, voffB);
            PG8_WAIT_V(6); PG8_BAR; PG8_MMA(1, 1, At, B1); PG8_BAR;
            PG8_LDB(B0, 1, 0); PG8_SCHED; PG8_LDA(At, 1, 0); PG8_STAGE(PG8_SA(0, 1), a2 + hstep, voffA);
            PG8_WAIT_L(8); PG8_BAR; PG8_WAIT_L(0); PG8_MMA(0, 0, At, B0); PG8_BAR; PG8_SCHED;
            PG8_LDB(B1, 1, 1); PG8_STAGE(PG8_SB(1, 0), b3, voffB);
            PG8_BAR; PG8_WAIT_L(0); PG8_MMA(0, 1, At, B1); PG8_BAR;
            PG8_LDA(At, 1, 1); PG8_STAGE(PG8_SA(1, 0), a3, voffA);
            PG8_BAR; PG8_WAIT_L(0); PG8_MMA(1, 0, At, B0); PG8_BAR; PG8_SCHED;
            PG8_STAGE(PG8_SB(1, 1), b3 + hstep, voffB);
            PG8_WAIT_V(6); PG8_BAR; PG8_MMA(1, 1, At, B1); PG8_BAR;
            }
        }
        if constexpr (ALIGN_EPI) { if (wr == 0) PG8_BAR; }
        if constexpr (!Epi::AFTER_DRAIN) { E(acc, cur, wr, wc, fr, fq); S.done(cur); }
        if (!has_next) break;
#pragma unroll
        for (int a = 0; a < 2; ++a)
#pragma unroll
            for (int b = 0; b < 2; ++b)
#pragma unroll
                for (int m = 0; m < 4; ++m)
#pragma unroll
                    for (int n = 0; n < 2; ++n) acc[a][b][m][n] = (f32x4){0.f, 0.f, 0.f, 0.f};
        cur = nxt; cA = nA; cB = nB; ++ui;
        if constexpr (ALIGN_EPI) { if (wr == 1) PG8_BAR; }
    }
    PG8_WAIT_V(0);
    if constexpr (!ALIGN_EPI) { if (wr == 0) PG8_BAR; }
    PG8_BAR;
    if constexpr (Epi::AFTER_DRAIN) { E.fused(acc, cur, wr, wc, fr, fq, lds, wid, lane); S.done(cur); }
#undef PG8_SA
#undef PG8_SB
#undef PG8_STAGE
#undef PG8_LDA
#undef PG8_LDB
#undef PG8_MMA
#undef PG8_WAIT_V
#undef PG8_WAIT_L
#undef PG8_BAR
#undef PG8_SCHED
}
}

#ifndef MK_N_LAUNCHES
#define MK_N_LAUNCHES 1
#endif
namespace cg = cooperative_groups;
#define DI __device__ __forceinline__
#define LAS __attribute__((address_space(3)))
typedef unsigned short bf16;
typedef short bf16x8 __attribute__((ext_vector_type(8)));
typedef float f32x4 __attribute__((ext_vector_type(4)));
typedef float f32x16 __attribute__((ext_vector_type(16)));
typedef unsigned u32x4 __attribute__((ext_vector_type(4)));
typedef unsigned u32x2 __attribute__((ext_vector_type(2)));
typedef float f32x2_t __attribute__((ext_vector_type(2)));
typedef __bf16 bf16x2_t __attribute__((ext_vector_type(2)));
typedef short s16x2 __attribute__((ext_vector_type(2)));
typedef unsigned short u16x2 __attribute__((ext_vector_type(2)));

constexpr int SEQ = 2048, DM = 1024, NBATCH = 16, MTOK = NBATCH * SEQ;
constexpr int NCOL_A = 3328, NCOL_B = 2560;
constexpr float EPS = 1e-6f;
constexpr float LOG2E = 1.4426950408889634f;
constexpr float C2 = 0.125f * LOG2E;
constexpr int NPHASE = 9;

constexpr size_t MiB = 1u << 20;
constexpr size_t WS_WA = 1 * MiB, WS_WOA = 8 * MiB, WS_WB = 10 * MiB, WS_WOB = 15 * MiB, WS_KM = 17 * MiB, WS_IW = 18 * MiB, WS_IK = 19 * MiB;
constexpr size_t WS_XN = 24 * MiB, WS_Q = 88 * MiB, WS_K = 152 * MiB, WS_VT = 168 * MiB, WS_SG = 184 * MiB, WS_IQ = 248 * MiB, WS_OG = 280 * MiB, WS_H1 = 344 * MiB, WS_END = 472 * MiB;

constexpr int LDS_BYTES = 153600;
constexpr int IQ_STRIDE = 1040;
constexpr int WRING = 16384, WSLOT = 8192;
constexpr int L_IQ = 0, L_HIST = 33280, L_SEL = 8 * WRING, L_MASK = L_SEL + 512, L_BTAB = L_MASK + 8192, L_SELM = L_BTAB + 12288, L_BLK = L_SELM + 128, L_END = L_BLK + 16;
static_assert(L_HIST + 32 * 257 * 4 + 256 <= L_SEL, "selection scratch inside the ring");
constexpr int L_EPI = 131072;
static_assert(L_EPI + 8 * 2304 <= 152320, "epilogue staging");
constexpr int L_MISC = 152320;
static_assert(L_END <= L_MISC && L_MISC + 64 + 128 <= LDS_BYTES && LDS_BYTES <= 163840, "LDS map");

__device__ const unsigned char BKT[128] = {
  0, 1, 2, 3, 4, 5, 6, 7, 8, 9, 10, 11, 12, 13, 14, 15, 16, 16, 16, 17, 17, 18, 18, 18, 19, 19, 19, 20, 20, 20, 20, 21,
  21, 21, 21, 22, 22, 22, 22, 22, 23, 23, 23, 23, 23, 23, 24, 24, 24, 24, 24, 24, 25, 25, 25, 25, 25, 25, 25, 26, 26, 26, 26, 26,
  26, 26, 26, 27, 27, 27, 27, 27, 27, 27, 27, 27, 27, 28, 28, 28, 28, 28, 28, 28, 28, 28, 28, 29, 29, 29, 29, 29, 29, 29, 29, 29,
  29, 29, 29, 30, 30, 30, 30, 30, 30, 30, 30, 30, 30, 30, 30, 30, 30, 31, 31, 31, 31, 31, 31, 31, 31, 31, 31, 31, 31, 31, 31, 31};

struct Args { const float* in[14]; float* out; unsigned char* ws; int ph_lo, ph_hi; };

struct Ptrs {
  const float *x, *norm_a_g, *w_in_a, *qn_a_g, *kn_a_g, *w_out_a, *rel_bias, *norm_kv_g, *w_kv, *kn_b_g, *norm_b_g, *w_in_b, *qn_b_g, *w_out_b;
  float* out;
  bf16 *WtA, *WtOA, *WtB, *WtOB, *XN, *Q, *KV, *SG, *IQ, *IK, *OG;
  float *IW, *KM, *RINV, *SSQ;
};

DI unsigned cvtpk(float lo, float hi) { f32x2_t v = {lo, hi}; bf16x2_t b = __builtin_convertvector(v, bf16x2_t); return __builtin_bit_cast(unsigned, b); }
DI float bflo(unsigned u) { return __uint_as_float(u << 16); }
DI float bfhi(unsigned u) { return __uint_as_float(u & 0xffff0000u); }
DI float wave_sum(float v) {
#pragma unroll
  for (int o = 1; o < 64; o <<= 1) v += __shfl_xor(v, o);
  return v;
}
DI float silu_f(float v) { return v * __builtin_amdgcn_rcpf(1.0f + __expf(-v)); }
#define MFMA32(a, b, c) __builtin_amdgcn_mfma_f32_32x32x16_bf16((a), (b), (c), 0, 0, 0)

#define XB_TMO      128
#define XB_XCNT(j)  (256  + 64 * (j))
#define XB_XSUB(j)  (1280 + 64 * (j))
#define XB_XGEN(j)  (2304 + 64 * (j))
#define XB_TOP      3328
#define XB_TOPGEN   3392
#define XCD_BAR_WORDS 3456
#define XB_SPIN_CAP (1u << 18)

__device__ __forceinline__ unsigned xb_ld(unsigned* p)              { return __hip_atomic_load(p, __ATOMIC_RELAXED, __HIP_MEMORY_SCOPE_AGENT); }
__device__ __forceinline__ unsigned xb_add(unsigned* p, unsigned v) { return __hip_atomic_fetch_add(p, v, __ATOMIC_RELAXED, __HIP_MEMORY_SCOPE_AGENT); }
__device__ __forceinline__ unsigned xb_xcc_id() { return (unsigned)__builtin_amdgcn_s_getreg((3 << 11) | 20) & 0xFu; }
#define XB_SPIN(cond, bar) do { unsigned _sp = 0; while (cond) { __builtin_amdgcn_s_sleep(1); \
    if ((++_sp & 255u) == 0u) { if (xb_ld(&(bar)[XB_TMO])) break; if (_sp > XB_SPIN_CAP) { atomicAdd(&(bar)[XB_TMO], 1u); break; } } } } while (0)

struct XcdBarrier {
    unsigned* bar; unsigned x; unsigned total;
    volatile LAS unsigned* st;
};

__device__ __forceinline__ XcdBarrier xcd_barrier_post(unsigned* bar, volatile LAS unsigned* st, bool lead_, unsigned total_) {
    XcdBarrier b; b.bar = bar; b.x = xb_xcc_id(); b.st = st; b.total = total_;
    if (lead_) (void)xb_add(&bar[XB_XCNT(b.x)], 1u);
    return b;
}
__device__ __forceinline__ void xcd_barrier_complete(unsigned* bar, unsigned x, unsigned& nloc, unsigned& nx, unsigned G) {
    unsigned sum, cnt, mine, sp = 0u;
    for (;;) {
        sum = 0u; cnt = 0u; mine = 0u;
#pragma unroll
        for (unsigned j = 0; j < 16; ++j) { const unsigned c = xb_ld(&bar[XB_XCNT(j)]); sum += c; cnt += (c > 0u) ? 1u : 0u; mine = (j == x) ? c : mine; }
        if (sum == G) break;
        __builtin_amdgcn_s_sleep(1);
        if ((++sp & 255u) == 0u) { if (xb_ld(&bar[XB_TMO])) break; if (sp > XB_SPIN_CAP) { atomicAdd(&bar[XB_TMO], 1u); break; } }
    }
    nloc = mine > 0u ? mine : 1u; nx = cnt > 0u ? cnt : 1u;
}

__device__ __forceinline__ void xcd_barrier(const XcdBarrier& b, bool lead_) {
    asm volatile("s_waitcnt vmcnt(0)" ::: "memory");
    __syncthreads();
    if (lead_) {
        unsigned* bar = b.bar;
        __builtin_amdgcn_s_waitcnt(0);
        unsigned nloc = b.st[0], nx = b.st[1];
        if (nloc == 0u) { xcd_barrier_complete(bar, b.x, nloc, nx, b.total); b.st[0] = nloc; b.st[1] = nx; }
        const unsigned old = xb_add(&bar[XB_XSUB(b.x)], 1u);
        const unsigned gen = old / nloc;
        if (old + 1u == (gen + 1u) * nloc) {
            __builtin_amdgcn_fence(__ATOMIC_RELEASE, "agent");
            asm volatile("s_waitcnt vmcnt(0)" ::: "memory");
            if (nx > 1u) {
            const unsigned og = xb_add(&bar[XB_TOP], 1u);
            const unsigned tg = og / nx;
            if (og + 1u == (tg + 1u) * nx) xb_add(&bar[XB_TOPGEN], 1u);
            else XB_SPIN(xb_ld(&bar[XB_TOPGEN]) == tg, bar);
            }
            if (nx == 1u) (void)__hip_atomic_fetch_add(&bar[XB_XGEN(b.x)], 1u, __ATOMIC_RELAXED, __HIP_MEMORY_SCOPE_AGENT);
            __builtin_amdgcn_fence(__ATOMIC_ACQUIRE, "agent");
            if (nx > 1u) xb_add(&bar[XB_XGEN(b.x)], 1u);
            asm volatile("s_waitcnt vmcnt(0)" ::: "memory");
        } else {
            XB_SPIN(xb_ld(&bar[XB_XGEN(b.x)]) == gen, bar);
            __builtin_amdgcn_fence(__ATOMIC_ACQUIRE, "agent");
            asm volatile("s_waitcnt vmcnt(0)" ::: "memory");
        }
    }
    __syncthreads();
}

DI int slot_of(int gc) { const int u = gc & 255; return (gc & ~255) + 128 * ((u >> 5) & 1) + 32 * (u >> 6) + 16 * ((u >> 2) & 1) + 4 * ((u >> 3) & 3) + (u & 3); }

typedef pg8::f32x4 accq;
DI int pi32(int r) { return (r & ~12) | ((r & 4) << 1) | ((r & 8) >> 1); }
DI size_t kv_tile_elem(int row) { return (size_t)(row >> 5) * 16384; }
DI void head_norm_store(const accq (&acc)[2][2][4][2], int ai, int m, const float (&gv)[2][2][4], bf16* dst0, bf16* dst1) {
  float ss = 0.f;
#pragma unroll
  for (int bj = 0; bj < 2; ++bj)
#pragma unroll
    for (int n = 0; n < 2; ++n)
#pragma unroll
      for (int e = 0; e < 4; ++e) { const float v = acc[ai][bj][m][n][e]; ss += v * v; }
  ss += __shfl_xor(ss, 16); ss += __shfl_xor(ss, 32);
  const float rn = rsqrtf(ss * (1.0f / 64.0f) + EPS);
#pragma unroll
  for (int bj = 0; bj < 2; ++bj) {
    u32x4 w;
    w.x = cvtpk(acc[ai][bj][m][0][0] * rn * gv[bj][0][0], acc[ai][bj][m][0][1] * rn * gv[bj][0][1]);
    w.y = cvtpk(acc[ai][bj][m][0][2] * rn * gv[bj][0][2], acc[ai][bj][m][0][3] * rn * gv[bj][0][3]);
    w.z = cvtpk(acc[ai][bj][m][1][0] * rn * gv[bj][1][0], acc[ai][bj][m][1][1] * rn * gv[bj][1][1]);
    w.w = cvtpk(acc[ai][bj][m][1][2] * rn * gv[bj][1][2], acc[ai][bj][m][1][3] * rn * gv[bj][1][3]);
    *(u32x4*)(bj ? dst1 : dst0) = w;
  }
}
DI bf16* k_piece(bf16* KV, int row, int g, int bj, int fq) {
  return KV + kv_tile_elem(row) + (size_t)(((g * 4 + 2 * bj + (fq >> 1)) * 64 + (fq & 1) * 32 + pi32(row & 31)) * 8);
}
DI void load_gain(float (&gv)[2][2][4], const float* g, int fq, float sc) {
#pragma unroll
  for (int bj = 0; bj < 2; ++bj)
#pragma unroll
    for (int n = 0; n < 2; ++n)
#pragma unroll
      for (int e = 0; e < 4; ++e) gv[bj][n][e] = g[32 * bj + 8 * fq + 4 * n + e] * sc;
}
template <int ACT  > DI void plain_store(const accq (&acc)[2][2][4][2], int ai, int m, float sc, bf16* dst) {
#pragma unroll
  for (int bj = 0; bj < 2; ++bj) {
    float v[8];
#pragma unroll
    for (int n = 0; n < 2; ++n)
#pragma unroll
      for (int e = 0; e < 4; ++e) { float t = acc[ai][bj][m][n][e] * sc; if (ACT == 1) t = silu_f(t); v[4 * n + e] = t; }
    u32x4 w; w.x = cvtpk(v[0], v[1]); w.y = cvtpk(v[2], v[3]); w.z = cvtpk(v[4], v[5]); w.w = cvtpk(v[6], v[7]);
    *(u32x4*)(dst + 32 * bj) = w;
  }
}
DI void v_store_scaled(const accq (&acc)[2][2][4][2], int ai, int m, bf16* KV, int row, int g, int fq, float sc) {
  const int i = row & 31;
  bf16* base = KV + kv_tile_elem(row) + (size_t)((16 + g * 4 + (i >> 4)) * 512 + ((i >> 3) & 1) * 256 + (i & 7));
#pragma unroll
  for (int bj = 0; bj < 2; ++bj)
#pragma unroll
    for (int n = 0; n < 2; ++n)
#pragma unroll
      for (int e = 0; e < 4; e += 2) {
        const unsigned pk = cvtpk(acc[ai][bj][m][n][e] * sc, acc[ai][bj][m][n][e + 1] * sc);
        const int r = 8 * fq + 4 * n + e;
        base[bj * 1024 + r * 8] = (bf16)(pk & 0xffffu); base[bj * 1024 + (r + 1) * 8] = (bf16)(pk >> 16);
      }
}

struct EpiA {
  static constexpr bool PERM = false, AFTER_DRAIN = false;
  bf16 *Q, *KV, *SG, *IQ, *IK; float* IW; const float *qn_g, *kn_g; const float* rinv;
  DI void operator()(const accq (&acc)[2][2][4][2], const pg8::Unit& u, int wr, int wc, int fr, int fq) const {
    const int pn = u.pn, row0 = u.pm * 256 + wr * 64 + fr;
    if (pn <= 4) {
      float gv[2][2][4]; load_gain(gv, pn < 4 ? qn_g : kn_g, fq, pn < 4 ? C2 : 1.0f);
#pragma unroll
      for (int ai = 0; ai < 2; ++ai)
#pragma unroll
        for (int m = 0; m < 4; ++m) { const int row = row0 + 128 * ai + 16 * m; const float ri = rinv[row];
          float v[2][2][4]; float ss = 0.f;
#pragma unroll
          for (int bj = 0; bj < 2; ++bj)
#pragma unroll
            for (int n = 0; n < 2; ++n)
#pragma unroll
              for (int e = 0; e < 4; ++e) { v[bj][n][e] = acc[ai][bj][m][n][e] * ri; ss += v[bj][n][e] * v[bj][n][e]; }
          ss += __shfl_xor(ss, 16); ss += __shfl_xor(ss, 32);
          const float rn = rsqrtf(ss * (1.0f / 64.0f) + EPS);
#pragma unroll
          for (int bj = 0; bj < 2; ++bj) {
            u32x4 w; w.x = cvtpk(v[bj][0][0] * rn * gv[bj][0][0], v[bj][0][1] * rn * gv[bj][0][1]); w.y = cvtpk(v[bj][0][2] * rn * gv[bj][0][2], v[bj][0][3] * rn * gv[bj][0][3]);
            w.z = cvtpk(v[bj][1][0] * rn * gv[bj][1][0], v[bj][1][1] * rn * gv[bj][1][1]); w.w = cvtpk(v[bj][1][2] * rn * gv[bj][1][2], v[bj][1][3] * rn * gv[bj][1][3]);
            bf16* dst = pn < 4 ? Q + (size_t)row * 1024 + (4 * pn + wc) * 64 + 8 * fq + 32 * bj : k_piece(KV, row, wc, bj, fq);
            *(u32x4*)dst = w; } }
    } else if (pn == 5) {
#pragma unroll
      for (int ai = 0; ai < 2; ++ai)
#pragma unroll
        for (int m = 0; m < 4; ++m) { const int row = row0 + 128 * ai + 16 * m; v_store_scaled(acc, ai, m, KV, row, wc, fq, rinv[row]); }
    } else if (pn <= 9) {
#pragma unroll
      for (int ai = 0; ai < 2; ++ai)
#pragma unroll
        for (int m = 0; m < 4; ++m) { const int row = row0 + 128 * ai + 16 * m; plain_store<1>(acc, ai, m, rinv[row], SG + (size_t)row * 1024 + 256 * (pn - 6) + 64 * wc + 8 * fq); }
    } else if (pn <= 11) {
#pragma unroll
      for (int ai = 0; ai < 2; ++ai)
#pragma unroll
        for (int m = 0; m < 4; ++m) { const int row = row0 + 128 * ai + 16 * m; plain_store<0>(acc, ai, m, 0.125f * rinv[row], IQ + (size_t)row * 512 + 256 * (pn - 10) + 64 * wc + 8 * fq); }
    } else {
      if (wc == 0) {
#pragma unroll
        for (int ai = 0; ai < 2; ++ai)
#pragma unroll
          for (int m = 0; m < 4; ++m) { const int row = row0 + 128 * ai + 16 * m; const float sc = rinv[row];
#pragma unroll
            for (int bj = 0; bj < 2; ++bj) { u32x4 w; w.x = cvtpk(acc[ai][bj][m][0][0] * sc, acc[ai][bj][m][0][1] * sc); w.y = cvtpk(acc[ai][bj][m][0][2] * sc, acc[ai][bj][m][0][3] * sc);
              w.z = cvtpk(acc[ai][bj][m][1][0] * sc, acc[ai][bj][m][1][1] * sc); w.w = cvtpk(acc[ai][bj][m][1][2] * sc, acc[ai][bj][m][1][3] * sc);
              *(u32x4*)(IK + (size_t)(row >> 5) * 2048 + (size_t)(((2 * bj + (fq >> 1)) * 64 + (fq & 1) * 32 + pi32(row & 31)) * 8)) = w; } }
      } else if (wc == 1 && fq == 0) {
#pragma unroll
        for (int ai = 0; ai < 2; ++ai)
#pragma unroll
          for (int m = 0; m < 4; ++m) { const int row = row0 + 128 * ai + 16 * m; float* d = IW + (size_t)row * 8; const float sc = 0.35355339059327373f * rinv[row];
            *(f32x4*)d = acc[ai][0][m][0] * sc; *(f32x4*)(d + 4) = acc[ai][0][m][1] * sc; }
      }
    }
  }
};
DI float row_rinv(const float* ssq, int row) {
  const f32x4* p = (const f32x4*)(ssq + (size_t)row * 16); const f32x4 a = p[0], b = p[1], c = p[2], d = p[3];
  const float t = (((a.x + a.y) + (a.z + a.w)) + ((b.x + b.y) + (b.z + b.w))) + (((c.x + c.y) + (c.z + c.w)) + ((d.x + d.y) + (d.z + d.w)));
  return rsqrtf(t * (1.0f / 1024.0f) + EPS);
}
struct EpiB {
  static constexpr bool PERM = false, AFTER_DRAIN = false;
  bf16 *Q, *KV, *SG; const float *qn_g, *kn_g; const float* rinv2; float* KM;
  DI void operator()(const accq (&acc)[2][2][4][2], const pg8::Unit& u, int wr, int wc, int fr, int fq) const {
    const int pn = u.pn, row0 = u.pm * 256 + wr * 64 + fr;
    if (pn == 0 || (pn >= 2 && pn <= 5)) {
      float gv[2][2][4]; load_gain(gv, pn == 0 ? kn_g : qn_g, fq, pn == 0 ? 1.0f : C2);
      float cs[2][2][4];
#pragma unroll
      for (int bj = 0; bj < 2; ++bj)
#pragma unroll
        for (int n = 0; n < 2; ++n)
#pragma unroll
          for (int e = 0; e < 4; ++e) cs[bj][n][e] = 0.f;
#pragma unroll
      for (int ai = 0; ai < 2; ++ai)
#pragma unroll
        for (int m = 0; m < 4; ++m) { const int row = row0 + 128 * ai + 16 * m; const float ri = rinv2[row];
          float v[2][2][4]; float ss = 0.f;
#pragma unroll
          for (int bj = 0; bj < 2; ++bj)
#pragma unroll
            for (int n = 0; n < 2; ++n)
#pragma unroll
              for (int e = 0; e < 4; ++e) { v[bj][n][e] = acc[ai][bj][m][n][e] * ri; ss += v[bj][n][e] * v[bj][n][e]; }
          ss += __shfl_xor(ss, 16); ss += __shfl_xor(ss, 32);
          const float rn = rsqrtf(ss * (1.0f / 64.0f) + EPS);
#pragma unroll
          for (int bj = 0; bj < 2; ++bj) {
#pragma unroll
            for (int n = 0; n < 2; ++n)
#pragma unroll
              for (int e = 0; e < 4; ++e) { v[bj][n][e] = v[bj][n][e] * rn * gv[bj][n][e]; cs[bj][n][e] += v[bj][n][e]; }
            u32x4 w; w.x = cvtpk(v[bj][0][0], v[bj][0][1]); w.y = cvtpk(v[bj][0][2], v[bj][0][3]); w.z = cvtpk(v[bj][1][0], v[bj][1][1]); w.w = cvtpk(v[bj][1][2], v[bj][1][3]);
            bf16* dst = pn != 0 ? Q + (size_t)row * 1024 + (4 * (pn - 2) + wc) * 64 + 8 * fq + 32 * bj : k_piece(KV, row, wc, bj, fq);
            *(u32x4*)dst = w; } }
      if (pn == 0) {
        float* km = KM + ((size_t)((u.pm >> 3) * 4 + wc) * 8 + (u.pm & 7)) * 64 + 8 * fq;
#pragma unroll
        for (int bj = 0; bj < 2; ++bj)
#pragma unroll
          for (int n = 0; n < 2; ++n)
#pragma unroll
            for (int e = 0; e < 4; ++e) { float t = cs[bj][n][e]; t += __shfl_xor(t, 1); t += __shfl_xor(t, 2); t += __shfl_xor(t, 4); t += __shfl_xor(t, 8);
              if (fr == 0) atomicAdd(km + 32 * bj + 4 * n + e, t * (1.0f / 256.0f)); }
      }
    } else if (pn == 1) {
#pragma unroll
      for (int ai = 0; ai < 2; ++ai)
#pragma unroll
        for (int m = 0; m < 4; ++m) { const int row = row0 + 128 * ai + 16 * m; const float ri = rinv2[row];
          v_store_scaled(acc, ai, m, KV, row, wc, fq, ri); }
    } else {
#pragma unroll
      for (int ai = 0; ai < 2; ++ai)
#pragma unroll
        for (int m = 0; m < 4; ++m) { const int row = row0 + 128 * ai + 16 * m; plain_store<1>(acc, ai, m, rinv2[row], SG + (size_t)row * 1024 + 256 * (pn - 6) + 64 * wc + 8 * fq); }
    }
  }
};
DI void unpack8(const u32x4 w, float (&f)[8]) { f[0] = bflo(w.x); f[1] = bfhi(w.x); f[2] = bflo(w.y); f[3] = bfhi(w.y); f[4] = bflo(w.z); f[5] = bfhi(w.z); f[6] = bflo(w.w); f[7] = bfhi(w.w); }
struct EpiRes {
  static constexpr bool PERM = false, AFTER_DRAIN = false;
  const bf16* res; float* out; LAS unsigned char* stg0;
  DI void operator()(const accq (&acc)[2][2][4][2], const pg8::Unit& u, int wr, int wc, int fr, int fq) const {
    const int row0 = u.pm * 256 + wr * 64 + fr, col0 = u.pn * 256 + 64 * wc + 8 * fq; LAS unsigned char* stg = stg0 + (wr * 4 + wc) * 2304; const int lane = fq * 16 + fr, r8 = lane >> 3, p8 = lane & 7;
#pragma unroll
    for (int ai = 0; ai < 2; ++ai)
#pragma unroll
      for (int m = 0; m < 4; ++m) { const size_t off = (size_t)(row0 + 128 * ai + 16 * m) * 1024 + col0;
#pragma unroll
        for (int bj = 0; bj < 2; ++bj) { float f[8]; unpack8(*(const u32x4*)(res + off + 32 * bj), f);
          f32x4 o0 = acc[ai][bj][m][0], o1 = acc[ai][bj][m][1];
          o0.x += f[0]; o0.y += f[1]; o0.z += f[2]; o0.w += f[3]; o1.x += f[4]; o1.y += f[5]; o1.z += f[6]; o1.w += f[7];
          *(LAS f32x4*)(stg + fr * 144 + fq * 32) = o0; *(LAS f32x4*)(stg + fr * 144 + fq * 32 + 16) = o1;
          asm volatile("" ::: "memory");
          const f32x4 a = *(const LAS f32x4*)(stg + r8 * 144 + p8 * 16), b = *(const LAS f32x4*)(stg + (r8 + 8) * 144 + p8 * 16);
          float* ob = out + (size_t)(row0 - fr + 128 * ai + 16 * m) * 1024 + u.pn * 256 + 64 * wc + 32 * bj + 4 * p8;
          __builtin_nontemporal_store(a, (f32x4*)(ob + (size_t)r8 * 1024)); __builtin_nontemporal_store(b, (f32x4*)(ob + (size_t)(r8 + 8) * 1024));
          asm volatile("" ::: "memory"); } }
  }
};
struct EpiRes2 {
  static constexpr bool PERM = false, AFTER_DRAIN = false;
  bf16* xh; float* ssq;
  DI void operator()(const accq (&acc)[2][2][4][2], const pg8::Unit& u, int wr, int wc, int fr, int fq) const {
    const int row0 = u.pm * 256 + wr * 64 + fr, col0 = u.pn * 256 + 64 * wc + 8 * fq;
#pragma unroll
    for (int ai = 0; ai < 2; ++ai)
#pragma unroll
      for (int m = 0; m < 4; ++m) { const int row = row0 + 128 * ai + 16 * m; const size_t off = (size_t)row * 1024 + col0; float ss = 0.f;
#pragma unroll
        for (int bj = 0; bj < 2; ++bj) { float f[8]; unpack8(*(const u32x4*)(xh + off + 32 * bj), f);
#pragma unroll
          for (int n = 0; n < 2; ++n)
#pragma unroll
            for (int e = 0; e < 4; ++e) { f[4 * n + e] += acc[ai][bj][m][n][e]; ss += f[4 * n + e] * f[4 * n + e]; }
          u32x4 w; w.x = cvtpk(f[0], f[1]); w.y = cvtpk(f[2], f[3]); w.z = cvtpk(f[4], f[5]); w.w = cvtpk(f[6], f[7]);
          *(u32x4*)(xh + off + 32 * bj) = w; }
        ss += __shfl_xor(ss, 16); ss += __shfl_xor(ss, 32);
        if (fq == 0) ssq[(size_t)row * 16 + u.pn * 4 + wc] = ss; }
  }
};
DI int srccol_A(int gc) { if (gc < 3072) return gc; if (gc < 3136) return 3080 + (gc - 3072); if (gc < 3144) return 3072 + (gc - 3136); return -1; }
DI void trans_item(const float* W, int Ns, const float* gk, bf16* Wt, int item, int nblk, int kindA, LAS float* scr, int lane) {
  const int kb = item / nblk, nb = item % nblk, k0 = 64 * kb, gc0 = 32 * nb;
  const int n = lane & 31, gc = gc0 + n; const int sc = kindA ? srccol_A(gc) : gc;
#pragma unroll 8
  for (int i = 0; i < 32; ++i) { const int kk = 2 * i + (lane >> 5); float v = 0.f; if (sc >= 0) v = __builtin_nontemporal_load(W + (size_t)(k0 + kk) * Ns + sc); if (gk) v *= gk[k0 + kk]; scr[kk * 33 + n] = v; }
  asm volatile("s_waitcnt lgkmcnt(0)" ::: "memory");
  const int c = lane & 7;
#pragma unroll
  for (int j = 0; j < 4; ++j) { const int nn = (lane >> 3) + 8 * j; const LAS float* s = scr + (8 * c) * 33 + nn;
    u32x4 o; o.x = cvtpk(s[0 * 33], s[1 * 33]); o.y = cvtpk(s[2 * 33], s[3 * 33]); o.z = cvtpk(s[4 * 33], s[5 * 33]); o.w = cvtpk(s[6 * 33], s[7 * 33]);
    *(u32x4*)(Wt + (size_t)slot_of(gc0 + nn) * 1024 + k0 + 8 * c) = o; }
  asm volatile("s_waitcnt lgkmcnt(0)" ::: "memory");
}
DI void cvt_row(const float* xrow, bf16* orow, float* rinv_out, int lane) {
  const f32x4* xr = (const f32x4*)xrow + lane; f32x4 v[4]; float s = 0.f;
#pragma unroll
  for (int j = 0; j < 4; ++j) { v[j] = xr[64 * j]; s += (v[j].x * v[j].x + v[j].y * v[j].y) + (v[j].z * v[j].z + v[j].w * v[j].w); }
  const float rinv = rsqrtf(wave_sum(s) * (1.0f / 1024.0f) + EPS);
  u32x2* o8 = (u32x2*)orow + lane;
#pragma unroll
  for (int j = 0; j < 4; ++j) { u32x2 w; w.x = cvtpk(v[j].x, v[j].y); w.y = cvtpk(v[j].z, v[j].w); o8[64 * j] = w; }
  if (lane == 0) *rinv_out = rinv;
}

DI int kidx(int r, int hi) { return 16 * (r >> 3) + 8 * hi + (r & 7); }
DI void glds16(const void* gsrc, unsigned lds_dst) { unsigned keep;
  asm volatile("s_mov_b32 %0, m0\n\ts_mov_b32 m0, %2\n\ts_nop 0\n\tglobal_load_lds_dwordx4 %1, off\n\ts_mov_b32 m0, %0" : "=&s"(keep) : "v"(gsrc), "s"(lds_dst) : "memory"); }
#define WAIT_BAR(N) asm volatile("s_waitcnt vmcnt(" #N ") lgkmcnt(0)\n\ts_barrier" ::: "memory")
DI void dma_tile_w(const char* ksrc  , unsigned voff  , unsigned lds_slot  ) {
  unsigned keep;
  asm volatile("s_waitcnt lgkmcnt(0)\n\ts_mov_b32 %0, m0\n\ts_mov_b32 m0, %3\n\ts_nop 0\n\t"
               "global_load_lds_dwordx4 %1, %2\n\tglobal_load_lds_dwordx4 %1, %2 offset:1024\n\tglobal_load_lds_dwordx4 %1, %2 offset:2048\n\tglobal_load_lds_dwordx4 %1, %2 offset:3072\n\t"
               "s_mov_b32 m0, %5\n\ts_nop 0\n\t"
               "global_load_lds_dwordx4 %1, %4\n\tglobal_load_lds_dwordx4 %1, %4 offset:1024\n\tglobal_load_lds_dwordx4 %1, %4 offset:2048\n\tglobal_load_lds_dwordx4 %1, %4 offset:3072\n\t"
               "s_mov_b32 m0, %0"
               : "=&s"(keep) : "v"(voff), "s"(ksrc), "s"(lds_slot), "s"(ksrc + 16384), "s"(lds_slot + 4096u) : "memory");
}
DI void frags_load(bf16x8 (&kf)[4], bf16x8 (&vf)[4], const char* sbase  , unsigned voff  ) {
  asm volatile("global_load_dwordx4 %0, %8, %9\n\tglobal_load_dwordx4 %1, %8, %9 offset:1024\n\tglobal_load_dwordx4 %2, %8, %9 offset:2048\n\tglobal_load_dwordx4 %3, %8, %9 offset:3072\n\t"
               "global_load_dwordx4 %4, %8, %10\n\tglobal_load_dwordx4 %5, %8, %10 offset:1024\n\tglobal_load_dwordx4 %6, %8, %10 offset:2048\n\tglobal_load_dwordx4 %7, %8, %10 offset:3072"
               : "=&v"(kf[0]), "=&v"(kf[1]), "=&v"(kf[2]), "=&v"(kf[3]), "=&v"(vf[0]), "=&v"(vf[1]), "=&v"(vf[2]), "=&v"(vf[3])
               : "v"(voff), "s"(sbase), "s"(sbase + 16384) : "memory");
}
DI void frags_wait(bf16x8 (&kf)[4], bf16x8 (&vf)[4]) {
  asm volatile("s_waitcnt vmcnt(0)" : "+v"(kf[0]), "+v"(kf[1]), "+v"(kf[2]), "+v"(kf[3]), "+v"(vf[0]), "+v"(vf[1]), "+v"(vf[2]), "+v"(vf[3]) :: "memory");
}
template <int MODE> DI void attn_tile(f32x16 (&O)[2][2], float (&l)[2], const bf16x8 (&kf)[4], const bf16x8 (&vf4)[4], const bf16x8 (&qf)[2][4], unsigned m, bool near, int dist0, const LAS float* bt0) {
  f32x16 c[2];
#pragma unroll
  for (int j = 0; j < 2; ++j) {
    if (near) {
      const LAS float* tp = bt0 + j * 192 + (dist0 + 8);
      f32x16 ci;
#pragma unroll
      for (int r = 0; r < 16; ++r) ci[r] = tp[23 - (16 * (r >> 3) + (r & 7))];
      c[j] = MFMA32(kf[0], qf[j][0], ci);
    } else {
      f32x16 z;
#pragma unroll
      for (int r = 0; r < 16; ++r) z[r] = 0.f;
      c[j] = MFMA32(kf[0], qf[j][0], z);
    }
#pragma unroll
    for (int s = 1; s < 4; ++s) c[j] = MFMA32(kf[s], qf[j][s], c[j]);
  }
#pragma unroll
  for (int j = 0; j < 2; ++j) {
    float p[16]; float ls = 0.f;
#pragma unroll
    for (int r = 0; r < 16; ++r) {
      const float e = __builtin_amdgcn_exp2f(c[j][r]);
      if (MODE == 0) { const unsigned ext = (unsigned)__builtin_amdgcn_sbfe((int)m, r, 1); p[r] = __uint_as_float(__float_as_uint(e) & ext); }
      else p[r] = e;
      ls += p[r];
    }
    if (MODE == 1) ls = __uint_as_float(__float_as_uint(ls) & m);
    l[j] += ls;
    bf16x8 pk[2];
#pragma unroll
    for (int s = 0; s < 2; ++s) { u32x4 w; w.x = cvtpk(p[8 * s], p[8 * s + 1]); w.y = cvtpk(p[8 * s + 2], p[8 * s + 3]); w.z = cvtpk(p[8 * s + 4], p[8 * s + 5]); w.w = cvtpk(p[8 * s + 6], p[8 * s + 7]);
      if (MODE == 1) { w.x &= m; w.y &= m; w.z &= m; w.w &= m; }
      pk[s] = __builtin_bit_cast(bf16x8, w); }
#pragma unroll
    for (int dt = 0; dt < 2; ++dt)
#pragma unroll
      for (int s = 0; s < 2; ++s) O[j][dt] = MFMA32(vf4[dt * 2 + s], pk[s], O[j][dt]);
  }
}
DI void k_dma(const char* ksrc  , unsigned voff  , unsigned lds_slot  ) {
  unsigned keep;
  asm volatile("s_waitcnt lgkmcnt(0)\n\ts_mov_b32 %0, m0\n\ts_mov_b32 m0, %3\n\ts_nop 0\n\t"
               "global_load_lds_dwordx4 %1, %2\n\tglobal_load_lds_dwordx4 %1, %2 offset:1024\n\tglobal_load_lds_dwordx4 %1, %2 offset:2048\n\tglobal_load_lds_dwordx4 %1, %2 offset:3072\n\t"
               "s_mov_b32 m0, %0" : "=&s"(keep) : "v"(voff), "s"(ksrc), "s"(lds_slot) : "memory");
}
DI void v_load(bf16x8 (&vf)[4], const char* vsrc  , unsigned voff) {
  asm volatile("global_load_dwordx4 %0, %4, %5\n\tglobal_load_dwordx4 %1, %4, %5 offset:1024\n\tglobal_load_dwordx4 %2, %4, %5 offset:2048\n\tglobal_load_dwordx4 %3, %4, %5 offset:3072"
               : "=&v"(vf[0]), "=&v"(vf[1]), "=&v"(vf[2]), "=&v"(vf[3]) : "v"(voff), "s"(vsrc) : "memory");
}
DI void kv_wait(bf16x8 (&vf)[4]) { asm volatile("s_waitcnt vmcnt(0)" : "+v"(vf[0]), "+v"(vf[1]), "+v"(vf[2]), "+v"(vf[3]) :: "memory"); }
DI void qk_tile(f32x16 (&c)[2], const LAS unsigned char* kslot  , const bf16x8 (&qf)[2][4]) {
  bf16x8 kf[4];
#pragma unroll
  for (int s = 0; s < 4; ++s) kf[s] = *(const LAS bf16x8*)(kslot + s * 1024);
#pragma unroll
  for (int j = 0; j < 2; ++j) {
    f32x16 z;
#pragma unroll
    for (int r = 0; r < 16; ++r) z[r] = 0.f;
    c[j] = MFMA32(kf[0], qf[j][0], z);
#pragma unroll
    for (int s = 1; s < 4; ++s) c[j] = MFMA32(kf[s], qf[j][s], c[j]);
  }
}
DI void add_bias(f32x16 (&c)[2], const LAS float* bt0, int dist0) {
#pragma unroll
  for (int j = 0; j < 2; ++j) { const LAS float* tp = bt0 + j * 192 + (dist0 + 8);
#pragma unroll
    for (int r = 0; r < 16; ++r) c[j][r] += tp[23 - (16 * (r >> 3) + (r & 7))]; }
}
template <int MODE> DI void sm_pv(f32x16 (&O)[2][2], float (&l)[2], const f32x16 (&c)[2], const bf16x8 (&vf4)[4], unsigned m) {
#pragma unroll
  for (int j = 0; j < 2; ++j) {
    float p[16]; float ls = 0.f;
#pragma unroll
    for (int r = 0; r < 16; ++r) {
      const float e = __builtin_amdgcn_exp2f(c[j][r]);
      if (MODE == 0) { const unsigned ext = (unsigned)__builtin_amdgcn_sbfe((int)m, r, 1); p[r] = __uint_as_float(__float_as_uint(e) & ext); }
      else p[r] = e;
      ls += p[r];
    }
    if (MODE == 1) ls = __uint_as_float(__float_as_uint(ls) & m);
    l[j] += ls;
    bf16x8 pk[2];
#pragma unroll
    for (int s = 0; s < 2; ++s) { u32x4 w; w.x = cvtpk(p[8 * s], p[8 * s + 1]); w.y = cvtpk(p[8 * s + 2], p[8 * s + 3]); w.z = cvtpk(p[8 * s + 4], p[8 * s + 5]); w.w = cvtpk(p[8 * s + 6], p[8 * s + 7]);
      if (MODE == 1) { w.x &= m; w.y &= m; w.z &= m; w.w &= m; }
      pk[s] = __builtin_bit_cast(bf16x8, w); }
#pragma unroll
    for (int dt = 0; dt < 2; ++dt)
#pragma unroll
      for (int s = 0; s < 2; ++s) O[j][dt] = MFMA32(vf4[dt * 2 + s], pk[s], O[j][dt]);
  }
}
DI void attn_store(const f32x16 (&O)[2][2], const float (&l)[2], const bf16* SG, bf16* OG, size_t row0, int head0, LAS unsigned char* stg, int lane) {
  const int q = lane & 31, hi = lane >> 5, rr = lane >> 3, pc = lane & 7;
  const size_t goff = (row0 + rr) * 1024 + (size_t)head0 * 64 + 8 * pc;
  u32x4 sg[2][4];
#pragma unroll
  for (int j = 0; j < 2; ++j)
#pragma unroll
    for (int i = 0; i < 4; ++i) sg[j][i] = *(const u32x4*)(SG + goff + (size_t)i * 8192 + j * 64);
  LAS unsigned char* wb = stg + q * 256; const int wt = ((q & 15) ^ hi) << 4;
  const LAS unsigned char* rb = stg + rr * 256; const int rt = ((2 * pc) ^ rr) << 4;
#pragma unroll
  for (int j = 0; j < 2; ++j) {
    const float lt = l[j] + __shfl_xor(l[j], 32); const float inv = 1.0f / lt;
#pragma unroll
    for (int dt = 0; dt < 2; ++dt)
#pragma unroll
      for (int a = 0; a < 4; ++a) {
        f32x4 v; v.x = O[j][dt][4 * a + 0] * inv; v.y = O[j][dt][4 * a + 1] * inv; v.z = O[j][dt][4 * a + 2] * inv; v.w = O[j][dt][4 * a + 3] * inv;
        *(LAS f32x4*)(wb + (wt ^ ((8 * dt + 2 * a) << 4))) = v;
      }
    asm volatile("" ::: "memory");
#pragma unroll
    for (int i = 0; i < 4; ++i) {
      const int x0 = rt ^ ((i & 1) << 7);
      const f32x4 a0 = *(const LAS f32x4*)(rb + i * 2048 + x0), a1 = *(const LAS f32x4*)(rb + i * 2048 + (x0 ^ 16));
      const u32x4 g = sg[j][i]; u32x4 w;
      w.x = cvtpk(a0.x * bflo(g.x), a0.y * bfhi(g.x)); w.y = cvtpk(a0.z * bflo(g.y), a0.w * bfhi(g.y));
      w.z = cvtpk(a1.x * bflo(g.z), a1.y * bfhi(g.z)); w.w = cvtpk(a1.z * bflo(g.w), a1.w * bfhi(g.w));
      *(u32x4*)(OG + goff + (size_t)i * 8192 + j * 64) = w;
    }
    asm volatile("" ::: "memory");
  }
}
DI void build_btab(LAS unsigned char* lds, const float* rel_bias, int tid_) {
  LAS float* bt = (LAS float*)(lds + L_BTAB);
  for (int i = tid_; i < 16 * 192; i += 512) { const int h = i / 192, dist = i % 192 - 31;
    bt[i] = dist < 0 ? -INFINITY : (dist < 128 ? (rel_bias[(int)BKT[dist] * 16 + h] - rel_bias[31 * 16 + h]) * LOG2E : 0.f); }
}
DI unsigned causal16(int q, int hi) { unsigned m = 0;
#pragma unroll
  for (int r = 0; r < 16; ++r) m |= (kidx(r, hi) <= q) ? (1u << r) : 0u;
  return m; }

DI void dsa_unit(LAS unsigned char* lds, const Ptrs& P, int b, int qt, int wave_) {
  int tid = wave_ * 64 + lane_id_hw(); asm volatile("" : "+v"(tid));
  const int lane = tid & 63, w = __builtin_amdgcn_readfirstlane(tid >> 6), q = lane & 31, hi = lane >> 5;
  const int t0 = 32 * qt, nkt = qt + 1; const size_t rowb = (size_t)b * SEQ;
  LAS unsigned short* maskl = (LAS unsigned short*)(lds + L_MASK);
  bf16x8 qf[2][4];
#pragma unroll
  for (int j = 0; j < 2; ++j)
#pragma unroll
    for (int s = 0; s < 4; ++s) qf[j][s] = *(const bf16x8*)(P.Q + (rowb + t0 + q) * 1024 + (2 * w + j) * 64 + 16 * s + 8 * hi);
  __syncthreads();
  if (qt >= 8) {
    const bf16* ikb = P.IK + (size_t)(b * 64) * 2048 + lane * 8;
    bf16x8 ikc[4], ikn[4];
#pragma unroll
    for (int s = 0; s < 4; ++s) ikc[s] = *(const bf16x8*)(ikb + (size_t)w * 2048 + 512 * s);
    LAS float* wl = (LAS float*)(lds + L_HIST);
    { f32x4 wv = {0.f, 0.f, 0.f, 0.f}; if (tid < 64) wv = *(const f32x4*)(P.IW + (rowb + t0) * 8 + tid * 4);
      const int row = tid >> 4, ch = tid & 15; const u32x4* src = (const u32x4*)(P.IQ + (rowb + t0 + row) * 512);
#pragma unroll
      for (int c = 0; c < 4; ++c) *(LAS u32x4*)(lds + L_IQ + row * IQ_STRIDE + (ch + 16 * c) * 16) = __builtin_nontemporal_load(src + ch + 16 * c);
      if (tid < 64) *(LAS f32x4*)(wl + tid * 4) = wv; }
    __syncthreads();
    unsigned pl[4][16];
#pragma unroll
    for (int B = 0; B < 4; ++B) {
#pragma unroll
      for (int h2 = 0; h2 < 2; ++h2) {
        const int kt = w + 8 * (2 * B + h2);
        if (2 * B + h2 < 7) { const int ktn = (kt + 8 < nkt) ? kt + 8 : w;
#pragma unroll
          for (int s = 0; s < 4; ++s) ikn[s] = *(const bf16x8*)(ikb + (size_t)ktn * 2048 + 512 * s); }
        float sc[16];
        if (2 * B + h2 == 0 || kt < nkt) {
#pragma unroll
          for (int s = 0; s < 4; ++s) asm volatile("" : "+v"(ikc[s]));
#pragma unroll
          for (int r = 0; r < 16; ++r) sc[r] = 0.f;
#pragma unroll 2
          for (int hd = 0; hd < 8; ++hd) {
            f32x16 c;
#pragma unroll
            for (int r = 0; r < 16; ++r) c[r] = 0.f;
#pragma unroll
            for (int s = 0; s < 4; ++s) { const bf16x8 bq = *(const LAS bf16x8*)(lds + L_IQ + q * IQ_STRIDE + (hd * 64 + 16 * s + 8 * hi) * 2); c = MFMA32(ikc[s], bq, c); }
            const float wh = wl[q * 8 + hd];
#pragma unroll
            for (int r = 0; r < 16; ++r) { const int ci_ = __builtin_bit_cast(int, (float)c[r]); sc[r] += wh * __builtin_bit_cast(float, ci_ > 0 ? ci_ : 0); asm("" : "+v"(sc[r])); }
          }
          if (kt == qt) {
#pragma unroll
            for (int r = 0; r < 16; ++r) if (kidx(r, hi) > q) sc[r] = -INFINITY;
          }
        } else {
#pragma unroll
          for (int r = 0; r < 16; ++r) sc[r] = -INFINITY;
        }
#pragma unroll
        for (int v = 0; v < 16; ++v) {
          if (h2 == 0) pl[B][v] = __builtin_bit_cast(unsigned, __builtin_amdgcn_cvt_pkrtz(sc[v], 0.f));
          else pl[B][v] |= __builtin_bit_cast(unsigned, __builtin_amdgcn_cvt_pkrtz(0.f, sc[v]));
        }
#pragma unroll
        for (int s = 0; s < 4; ++s) ikc[s] = ikn[s];
      }
#pragma unroll
      for (int v = 0; v < 16; ++v) { const unsigned u = pl[B][v]; pl[B][v] = u ^ (((u >> 15) & 0x00010001u) * 0x7FFFu); }
#define TR_STAGE(J, MJ) _Pragma("unroll") for (int k = 0; k < 16; ++k) if ((k & (J)) == 0) { const unsigned t = ((pl[B][k] >> (J)) ^ pl[B][k + (J)]) & (MJ); pl[B][k + (J)] ^= t; pl[B][k] ^= t << (J); }
      TR_STAGE(8, 0x00FF00FFu) TR_STAGE(4, 0x0F0F0F0Fu) TR_STAGE(2, 0x33333333u) TR_STAGE(1, 0x55555555u)
#undef TR_STAGE
      pl[B][15] = ~pl[B][15];
#pragma unroll
      for (int v = 0; v < 16; ++v) asm volatile("" : "+v"(pl[B][v]));
      __builtin_amdgcn_sched_barrier(0);
    }
    LAS unsigned* cb = (LAS unsigned*)(lds + L_HIST + 32 * 257 * 4);
    if (tid < 64) cb[tid] = 0u;
    __syncthreads();
    unsigned mm[4] = {0xFFFFFFFFu, 0xFFFFFFFFu, 0xFFFFFFFFu, 0xFFFFFFFFu}, gt[4] = {0u, 0u, 0u, 0u}, Gtot = 0u, prev0 = 0u, prev1 = 0u;
#pragma unroll
    for (int bit = 15; bit >= 0; --bit) {
      unsigned t4[4]; unsigned cnt = 0u;
#pragma unroll
      for (int B = 0; B < 4; ++B) { t4[B] = mm[B] & pl[B][bit]; cnt += (unsigned)__builtin_popcount(t4[B]); }
      LAS unsigned* cw = cb + ((bit & 1) ? 32 : 0) + q;
      __hip_atomic_fetch_add(cw, cnt, __ATOMIC_RELAXED, __HIP_MEMORY_SCOPE_WORKGROUP);
      __syncthreads();
      const unsigned run = *cw; unsigned tot;
      if (bit & 1) { tot = run - prev1; prev1 = run; } else { tot = run - prev0; prev0 = run; }
      const bool acc1 = (Gtot + tot) >= 256u;
#pragma unroll
      for (int B = 0; B < 4; ++B) { if (acc1) mm[B] = t4[B]; else { gt[B] |= t4[B]; mm[B] ^= t4[B]; } }
      if (!acc1) Gtot += tot;
    }
    LAS unsigned short* tm = (LAS unsigned short*)(lds + L_HIST + 1024); LAS unsigned short* pf = (LAS unsigned short*)(lds + L_HIST + 1024 + 8192);
#pragma unroll
    for (int B = 0; B < 4; ++B) {
      tm[((w + 8 * (2 * B)) * 32 + q) * 2 + hi] = (unsigned short)(mm[B] & 0xFFFFu);
      tm[((w + 8 * (2 * B + 1)) * 32 + q) * 2 + hi] = (unsigned short)(mm[B] >> 16);
    }
    __syncthreads();
#pragma unroll
    for (int e = 0; e < 4; ++e) {
      const int qq = 4 * w + e;
      const unsigned c = (unsigned)__builtin_popcount(((const LAS unsigned*)tm)[lane * 32 + qq]);
      unsigned incl = c;
#pragma unroll
      for (int o = 1; o < 64; o <<= 1) { const unsigned t = __shfl_up(incl, o); if (lane >= o) incl += t; }
      pf[lane * 32 + qq] = (unsigned short)(incl - c);
    }
    __syncthreads();
    { const unsigned need = 256u - Gtot;
#pragma unroll
      for (int B = 0; B < 4; ++B) {
        unsigned sel = gt[B];
#pragma unroll
        for (int h2 = 0; h2 < 2; ++h2) {
          const unsigned t16 = (mm[B] >> (16 * h2)) & 0xFFFFu;
          if (t16) {
            const int kt = w + 8 * (2 * B + h2);
            const unsigned pair = ((const LAS unsigned*)tm)[kt * 32 + q], base = pf[kt * 32 + q];
            const unsigned c0 = (unsigned)__builtin_popcount(pair & 0xFFu), c1 = (unsigned)__builtin_popcount(pair & 0xFF0000u), c2 = (unsigned)__builtin_popcount(pair & 0xFF00u);
            const unsigned offL = base + (hi ? c0 : 0u), offH = base + (hi ? c0 + c1 + c2 : c0 + c1);
            unsigned rem = t16;
            while (rem) { const int pos = __builtin_ctz(rem); rem &= rem - 1u;
              const unsigned below = (unsigned)__builtin_popcount(t16 & ((1u << pos) - 1u) & (pos >= 8 ? 0xFF00u : 0xFFu));
              if ((pos >= 8 ? offH : offL) + below < need) sel |= 1u << (pos + 16 * h2); }
          }
        }
        if (w + 8 * (2 * B) < nkt) maskl[(w + 8 * (2 * B)) * 64 + lane] = (unsigned short)(sel & 0xFFFFu);
        if (w + 8 * (2 * B + 1) < nkt) maskl[(w + 8 * (2 * B + 1)) * 64 + lane] = (unsigned short)(sel >> 16);
      } }
  } else {
    const unsigned cm = causal16(q, hi);
#pragma unroll
    for (int i = 0; i < 8; ++i) { const int kt = w + 8 * i; if (kt < nkt) maskl[kt * 64 + lane] = (unsigned short)(kt == qt ? cm : 0xFFFFu); }
  }
  __syncthreads();
  const int g = w >> 1;
  const bf16* img = P.KV + (size_t)(b * 64) * 16384;
  const unsigned lds0 = (unsigned)(uintptr_t)lds;
#pragma unroll
  for (int j = 0; j < 2; ++j)
#pragma unroll
    for (int s = 0; s < 4; ++s) asm volatile("" : "+v"(qf[j][s]));
  f32x16 O[2][2]; float l[2] = {0.f, 0.f};
#pragma unroll
  for (int j = 0; j < 2; ++j)
#pragma unroll
    for (int dt = 0; dt < 2; ++dt)
#pragma unroll
      for (int r = 0; r < 16; ++r) O[j][dt][r] = 0.f;
  const LAS float* bt0 = (const LAS float*)(lds + L_BTAB) + (2 * w) * 192;
  LAS unsigned char* ringp = lds + 65536 + w * 8192;
  const char* ksrc = (const char*)img + g * 4096; const unsigned voff = (unsigned)lane * 16u;
  const unsigned kring = lds0 + (unsigned)w * 8192u; const LAS unsigned char* kl = lds + w * 8192 + lane * 16;
#define TSRC(t_) (ksrc + (size_t)((t_) < nkt ? (t_) : nkt - 1) * 32768)
  bf16x8 vA[4], vB[4]; f32x16 cA[2], cB[2];
  k_dma(TSRC(0), voff, kring); v_load(vA, TSRC(0) + 16384, voff); k_dma(TSRC(1), voff, kring + 4096u);
  kv_wait(vA);
  qk_tile(cA, kl, qf);
#pragma unroll 1
  for (int kt = 0; ; kt += 2) {
    k_dma(TSRC(kt + 2), voff, kring); v_load(vB, TSRC(kt + 1) + 16384, voff);
    if (qt - kt <= 4) add_bias(cA, bt0, (t0 + q) - (32 * kt + 8 * hi));
    { const unsigned m16 = maskl[kt * 64 + lane];
      qk_tile(cB, kl + 4096, qf); sm_pv<0>(O, l, cA, vA, m16); }
    kv_wait(vB);
    if (kt + 1 >= nkt) break;
    k_dma(TSRC(kt + 3), voff, kring + 4096u); v_load(vA, TSRC(kt + 2) + 16384, voff);
    if (qt - (kt + 1) <= 4) add_bias(cB, bt0, (t0 + q) - (32 * (kt + 1) + 8 * hi));
    { const unsigned m16 = maskl[(kt + 1) * 64 + lane];
      qk_tile(cA, kl, qf); sm_pv<0>(O, l, cB, vB, m16); }
    kv_wait(vA);
    if (kt + 2 >= nkt) break;
  }
#undef TSRC
  { int tid2 = lane_id_hw(); asm volatile("" : "+v"(tid2)); const int lane2 = tid2 & 63;
    attn_store(O, l, P.SG, P.OG, rowb + t0, 2 * w, ringp, lane2); }
}

DI void moba_unit(LAS unsigned char* lds, const Ptrs& P, int b, int qt, int wave_) {
  int tid = wave_ * 64 + lane_id_hw(); asm volatile("" : "+v"(tid));
  const int lane = tid & 63, w = __builtin_amdgcn_readfirstlane(tid >> 6), q = lane & 31, hi = lane >> 5;
  const int t0 = 32 * qt, ob = qt >> 3; const size_t rowb = (size_t)b * SEQ;
  LAS unsigned char* selm = lds + L_SELM; LAS unsigned* blkw = (LAS unsigned*)(lds + L_BLK);
  bf16x8 qf[2][4];
#pragma unroll
  for (int j = 0; j < 2; ++j)
#pragma unroll
    for (int s = 0; s < 4; ++s) qf[j][s] = *(const bf16x8*)(P.Q + (rowb + t0 + q) * 1024 + (2 * w + j) * 64 + 16 * s + 8 * hi);
  __syncthreads();
  if (tid == 0) blkw[0] = 0u;
  __syncthreads();
  if (ob > 0) {
    const int qq = tid & 31, gg = (tid >> 5) & 3, part = tid >> 7;
    float gs[7];
#pragma unroll
    for (int n = 0; n < 7; ++n) gs[n] = 0.f;
    const bf16* qp = P.Q + (rowb + t0 + qq) * 1024 + gg * 256 + part * 16;
#pragma unroll
    for (int c = 0; c < 2; ++c) {
      float qs[8];
#pragma unroll
      for (int e = 0; e < 8; ++e) qs[e] = 0.f;
#pragma unroll
      for (int j = 0; j < 4; ++j) { const u32x4 v = *(const u32x4*)(qp + j * 64 + c * 8);
        qs[0] += bflo(v.x); qs[1] += bfhi(v.x); qs[2] += bflo(v.y); qs[3] += bfhi(v.y); qs[4] += bflo(v.z); qs[5] += bfhi(v.z); qs[6] += bflo(v.w); qs[7] += bfhi(v.w); }
#pragma unroll
      for (int n = 0; n < 7; ++n) if (n < ob) { const f32x4* km = (const f32x4*)(P.KM + ((size_t)(b * 4 + gg) * 8 + n) * 64 + part * 16 + c * 8); const f32x4 k0 = km[0], k1 = km[1];
        gs[n] += (qs[0] * k0.x + qs[1] * k0.y + qs[2] * k0.z + qs[3] * k0.w) + (qs[4] * k1.x + qs[5] * k1.y + qs[6] * k1.z + qs[7] * k1.w); }
    }
    LAS float* gp = (LAS float*)lds + (size_t)(part * 128 + gg * 32 + qq) * 8;
#pragma unroll
    for (int n = 0; n < 7; ++n) gp[n] = gs[n];
  }
  __syncthreads();
  if (tid < 128) {
    const int qq = tid & 31, gg = tid >> 5; unsigned sel = 0;
    if (ob > 0) {
      float gs[7]; const LAS float* gp = (const LAS float*)lds + (size_t)(gg * 32 + qq) * 8;
#pragma unroll
      for (int n = 0; n < 7; ++n) gs[n] = (n < ob) ? ((gp[n] + gp[1024 + n]) + (gp[2048 + n] + gp[3072 + n])) : -INFINITY;
#pragma unroll
      for (int n = 0; n < 7; ++n) { if (n < ob) { int rank = 0;
#pragma unroll
          for (int m = 0; m < 7; ++m) if (m != n && m < ob) rank += ((gs[m] > gs[n]) || (gs[m] == gs[n] && m < n)) ? 1 : 0;
          if (rank < 3) sel |= 1u << n; } }
    }
    selm[gg * 32 + qq] = (unsigned char)sel;
    if (sel) __hip_atomic_fetch_or(blkw, sel, __ATOMIC_RELAXED, __HIP_MEMORY_SCOPE_WORKGROUP);
  }
  __syncthreads();
  const int g = w >> 1;
  const unsigned mysel = selm[g * 32 + q];
  const unsigned blk = (unsigned)__builtin_amdgcn_readfirstlane(blkw[0]) | (1u << ob);
  const bf16* img = P.KV + (size_t)(b * 64) * 16384;
  const unsigned lds0 = (unsigned)(uintptr_t)lds;
#pragma unroll
  for (int j = 0; j < 2; ++j)
#pragma unroll
    for (int s = 0; s < 4; ++s) asm volatile("" : "+v"(qf[j][s]));
  f32x16 O[2][2]; float l[2] = {0.f, 0.f};
#pragma unroll
  for (int j = 0; j < 2; ++j)
#pragma unroll
    for (int dt = 0; dt < 2; ++dt)
#pragma unroll
      for (int r = 0; r < 16; ++r) O[j][dt][r] = 0.f;
  const LAS float* bt0 = (const LAS float*)(lds + L_BTAB) + (2 * w) * 192;
#define NEXT_TILE(kt_, out_) do { int kn_ = (kt_) + 1; if (kn_ > qt) kn_ = -1; else if (((blk >> (kn_ >> 3)) & 1u) == 0u) kn_ = 8 * ((kn_ >> 3) + __builtin_ctz(blk >> (kn_ >> 3))); (out_) = kn_; } while (0)
  LAS unsigned char* ringp = lds + 65536 + w * 8192;
  const char* ksrc = (const char*)img + g * 4096; const unsigned voff = (unsigned)lane * 16u;
  const unsigned kring = lds0 + (unsigned)w * 8192u; const LAS unsigned char* kl = lds + w * 8192 + lane * 16;
  int ta = 8 * __builtin_ctz(blk), tb, tc, td;
  NEXT_TILE(ta, tb); tc = -1; if (tb >= 0) NEXT_TILE(tb, tc);
  const int tfirst = ta;
#define TSRC(t_) (ksrc + (size_t)((t_) >= 0 ? (t_) : tfirst) * 32768)
#define MOBA_SM(C, VF, KT) do { const int n_ = (KT) >> 3; const unsigned lm_ = (n_ < ob) ? (0u - ((mysel >> n_) & 1u)) : 0xFFFFFFFFu; sm_pv<1>(O, l, C, VF, lm_); } while (0)
  bf16x8 vA[4], vB[4]; f32x16 cA[2], cB[2];
  k_dma(TSRC(ta), voff, kring); v_load(vA, TSRC(ta) + 16384, voff); k_dma(TSRC(tb), voff, kring + 4096u);
  kv_wait(vA);
  qk_tile(cA, kl, qf);
#pragma unroll 1
  while (true) {
    k_dma(TSRC(tc), voff, kring); v_load(vB, TSRC(tb) + 16384, voff);
    if (qt - ta <= 4) add_bias(cA, bt0, (t0 + q) - (32 * ta + 8 * hi));
    qk_tile(cB, kl + 4096, qf); MOBA_SM(cA, vA, ta);
    kv_wait(vB);
    if (tb < 0) break;
    td = -1; if (tc >= 0) NEXT_TILE(tc, td);
    k_dma(TSRC(td), voff, kring + 4096u); v_load(vA, TSRC(tc) + 16384, voff);
    if (qt - tb <= 4) add_bias(cB, bt0, (t0 + q) - (32 * tb + 8 * hi));
    qk_tile(cA, kl, qf); MOBA_SM(cB, vB, tb);
    kv_wait(vA);
    if (tc < 0) break;
    ta = tc; tb = td; tc = -1; if (tb >= 0) NEXT_TILE(tb, tc);
  }
#undef MOBA_SM
#undef TSRC
#undef NEXT_TILE
  { int tid2 = lane_id_hw(); asm volatile("" : "+v"(tid2)); const int lane2 = tid2 & 63;
    attn_store(O, l, P.SG, P.OG, rowb + t0, 2 * w, ringp, lane2); }
}

__global__ void __launch_bounds__(512, 2) fwd(Args args) {
  extern __shared__ __attribute__((aligned(16))) unsigned char lds_raw[];
  LAS unsigned char* lds = (LAS unsigned char*)lds_raw;
  const int wave = __builtin_amdgcn_readfirstlane((int)threadIdx.x >> 6);
#define FRESH_TID(t_) int t_ = wave * 64 + lane_id_hw(); asm volatile("" : "+v"(t_))
  const int G = gridDim.x, bx = blockIdx.x;
  const int vcu = (G % 8 == 0) ? (bx % 8) * (G / 8) + bx / 8 : bx;
  LAS unsigned long long* ptab = (LAS unsigned long long*)(lds + L_MISC + 64);
  { FRESH_TID(tid0);
    if (tid0 < 16) { const unsigned long long* ka = (const unsigned long long*)__builtin_amdgcn_kernarg_segment_ptr(); ptab[tid0] = ka[tid0]; ((LAS unsigned*)(lds + L_MISC))[tid0] = 0u; }
    __syncthreads(); }
#define TABPTR(k) ((unsigned char*)(__attribute__((address_space(1))) unsigned char*)(((unsigned long long)(unsigned)__builtin_amdgcn_readfirstlane((int)(ptab[(k)] >> 32)) << 32) | (unsigned long long)(unsigned)__builtin_amdgcn_readfirstlane((int)(unsigned)ptab[(k)])))
#define LOAD_PTRS() Ptrs P; { asm volatile("" ::: "memory"); unsigned char* ws = TABPTR(15); \
  P.x = (const float*)TABPTR(0); P.norm_a_g = (const float*)TABPTR(1); P.w_in_a = (const float*)TABPTR(2); P.qn_a_g = (const float*)TABPTR(3); P.kn_a_g = (const float*)TABPTR(4); P.w_out_a = (const float*)TABPTR(5); P.rel_bias = (const float*)TABPTR(6); \
  P.norm_kv_g = (const float*)TABPTR(7); P.w_kv = (const float*)TABPTR(8); P.kn_b_g = (const float*)TABPTR(9); P.norm_b_g = (const float*)TABPTR(10); P.w_in_b = (const float*)TABPTR(11); P.qn_b_g = (const float*)TABPTR(12); P.w_out_b = (const float*)TABPTR(13); \
  P.out = (float*)TABPTR(14); \
  P.WtA = (bf16*)(ws + WS_WA); P.WtOA = (bf16*)(ws + WS_WOA); P.WtB = (bf16*)(ws + WS_WB); P.WtOB = (bf16*)(ws + WS_WOB); \
  P.XN = (bf16*)(ws + WS_XN); P.Q = (bf16*)(ws + WS_Q); P.KV = (bf16*)(ws + WS_K); P.SG = (bf16*)(ws + WS_SG); \
  P.IQ = (bf16*)(ws + WS_IQ); P.IK = (bf16*)(ws + WS_IK); P.OG = (bf16*)(ws + WS_OG); \
  P.IW = (float*)(ws + WS_IW); P.KM = (float*)(ws + WS_KM); P.RINV = (float*)(ws + WS_KM + 524288); P.SSQ = (float*)(ws + WS_H1); }
  const int lo = args.ph_lo, hi = args.ph_hi;
#ifndef PH_MASK
#define PH_MASK 0x1ff
#endif
#ifndef REP_MASK
#define REP_MASK 0
#endif
#define IN(k) (((PH_MASK >> (k)) & 1) && lo <= (k) && (k) < hi)
#define NREP(k) ((((REP_MASK) >> (k)) & 1) ? 2 : 1)
#if MK_N_LAUNCHES == 1
  const bool grouped = (G == 256);
  XcdBarrier xbar = xcd_barrier_post((unsigned*)TABPTR(15), (volatile LAS unsigned*)(lds + L_MISC), wave == 0 && lane_id_hw() == 0, (unsigned)G);
  XcdBarrier xbarL = xcd_barrier_post((unsigned*)(TABPTR(15) + 16384 * (1 + (bx & 7))), (volatile LAS unsigned*)(lds + L_MISC) + 2, wave == 0 && lane_id_hw() == 0, (unsigned)(G / 8));
#define SEAM(k) do { if (IN(k) && (hi > (k) + 1)) { if ((k) == 0 || !grouped) xcd_barrier(xbar, wave == 0 && lane_id_hw() == 0); else xcd_barrier(xbarL, wave == 0 && lane_id_hw() == 0); } } while (0)
#else
#define SEAM(k) do { } while (0)
#endif
  const int gw = vcu * 8 + wave, NGW = G * 8;

  if (IN(0)) {
    LOAD_PTRS();
    FRESH_TID(tid); const int lane = tid & 63;
    LAS float* scr = (LAS float*)(lds + wave * 8448);
    constexpr int I_A = 16 * (NCOL_A / 32), I_O = 16 * 32, I_KV = 16 * 16, I_B = 16 * 64;
    constexpr int NITEMS = I_A + I_O + I_KV + I_B + I_O;
    for (int it = gw; it < NITEMS; it += NGW) {
      int r = it;
      if (r < I_A) { trans_item(P.w_in_a, 3144, P.norm_a_g, P.WtA, r, NCOL_A / 32, 1, scr, lane); continue; } r -= I_A;
      if (r < I_O) { trans_item(P.w_out_a, 1024, nullptr, P.WtOA, r, 32, 0, scr, lane); continue; } r -= I_O;
      if (r < I_KV) { trans_item(P.w_kv, 512, P.norm_kv_g, P.WtB, r, 16, 0, scr, lane); continue; } r -= I_KV;
      if (r < I_B) { trans_item(P.w_in_b, 2048, P.norm_b_g, P.WtB + (size_t)512 * 1024, r, 64, 0, scr, lane); continue; } r -= I_B;
      trans_item(P.w_out_b, 1024, nullptr, P.WtOB, r, 32, 0, scr, lane);
    }
    for (int m = gw; m < MTOK; m += 4 * NGW) {
      f32x4 v[4][4]; float ss[4];
#pragma unroll
      for (int u = 0; u < 4; ++u) { const int mm = m + u * NGW; const f32x4* xr = (const f32x4*)(P.x + (size_t)(mm < MTOK ? mm : m) * 1024) + lane;
#pragma unroll
        for (int j = 0; j < 4; ++j) v[u][j] = __builtin_nontemporal_load(xr + 64 * j); }
#pragma unroll
      for (int u = 0; u < 4; ++u) { float a = 0.f;
#pragma unroll
        for (int j = 0; j < 4; ++j) a += (v[u][j].x * v[u][j].x + v[u][j].y * v[u][j].y) + (v[u][j].z * v[u][j].z + v[u][j].w * v[u][j].w);
        ss[u] = a; }
#pragma unroll
      for (int o = 1; o < 64; o <<= 1) {
#pragma unroll
        for (int u = 0; u < 4; ++u) ss[u] += __shfl_xor(ss[u], o); }
#pragma unroll
      for (int u = 0; u < 4; ++u) { const int mm = m + u * NGW; if (mm < MTOK) {
          u32x2* o8 = (u32x2*)(P.XN + (size_t)mm * 1024) + lane;
#pragma unroll
          for (int j = 0; j < 4; ++j) { u32x2 w; w.x = cvtpk(v[u][j].x, v[u][j].y); w.y = cvtpk(v[u][j].z, v[u][j].w); o8[64 * j] = w; }
          if (lane == 0) P.RINV[mm] = rsqrtf(ss[u] * (1.0f / 1024.0f) + EPS); } }
    }
    for (int i = gw * 64 + lane; i < NBATCH * 4 * 8 * 64; i += NGW * 64) P.KM[i] = 0.f;
    __syncthreads();
  }
  SEAM(0);
  if (IN(1)) for (int rep_ = 0; rep_ < NREP(1); ++rep_) {
    LOAD_PTRS();
    pg8::Gemm g{P.XN, P.WtA, MTOK, NCOL_A, 1024}; pg8::StaticOrder S; S.init(MTOK, NCOL_A, G, bx);
    EpiA E{P.Q, P.KV, P.SG, P.IQ, P.IK, P.IW, P.qn_a_g, P.kn_a_g, P.RINV};
    pg8::gemm_phase<EpiA, pg8::StaticOrder, true, true>(lds, g, S, E, wave);
    __syncthreads();
  }
  SEAM(1);
  if (IN(2)) for (int rep_ = 0; rep_ < NREP(2); ++rep_) {
    LOAD_PTRS();
    { FRESH_TID(tidb); build_btab(lds, P.rel_bias, tidb); }
#pragma unroll 1
    for (int i = 0; ; ++i) { int b, qt;
      if (G == 256) { if (i >= 4) break; const int c = vcu & 31; b = 2 * (vcu >> 5) + (i >> 1); qt = (i & 1) ? c : 63 - c; }
      else { const int u = vcu + i * G; if (u >= 1024) break; b = u >> 6; qt = 63 - (u & 63); }
      dsa_unit(lds, P, b, qt, wave); }
    __syncthreads();
  }
  SEAM(2);
  if (IN(3)) for (int rep_ = 0; rep_ < NREP(3); ++rep_) {
    LOAD_PTRS();
    pg8::Gemm g{P.OG, P.WtOA, MTOK, 1024, 1024}; pg8::StaticOrder S; S.init(MTOK, 1024, G, bx);
    EpiRes2 E{P.XN, P.SSQ};
    pg8::gemm_phase<EpiRes2, pg8::StaticOrder, true, true>(lds, g, S, E, wave);
    __syncthreads();
  }
  SEAM(3);
  if (IN(4)) { LOAD_PTRS(); FRESH_TID(tidr);
    if (G == 256) { if (tidr < 128) { const int r = 4096 * (bx & 7) + 128 * (bx >> 3) + tidr; P.RINV[r] = row_rinv(P.SSQ, r); } }
    else for (int r = bx * 512 + tidr; r < MTOK; r += G * 512) P.RINV[r] = row_rinv(P.SSQ, r); }
  SEAM(4);
  if (IN(5)) for (int rep_ = 0; rep_ < NREP(5); ++rep_) {
    LOAD_PTRS();
    pg8::Gemm g{P.XN, P.WtB, MTOK, NCOL_B, 1024}; pg8::StaticOrder S; S.init(MTOK, NCOL_B, G, bx);
    EpiB E{P.Q, P.KV, P.SG, P.qn_b_g, P.kn_b_g, P.RINV, P.KM};
    pg8::gemm_phase<EpiB, pg8::StaticOrder, true, true>(lds, g, S, E, wave);
    __syncthreads();
  }
  SEAM(5);
  if (IN(7)) for (int rep_ = 0; rep_ < NREP(7); ++rep_) {
    LOAD_PTRS();
    { FRESH_TID(tidb); build_btab(lds, P.rel_bias, tidb); }
#pragma unroll 1
    for (int i = 0; ; ++i) { int b, qt;
      if (G == 256) { if (i >= 4) break; const int c = vcu & 31; b = 2 * (vcu >> 5) + (i >> 1); qt = (i & 1) ? c : 63 - c; }
      else { const int u = vcu + i * G; if (u >= 1024) break; b = u >> 6; qt = 63 - (u & 63); }
      moba_unit(lds, P, b, qt, wave); }
    __syncthreads();
  }
  SEAM(7);
  if (IN(8)) for (int rep_ = 0; rep_ < NREP(8); ++rep_) {
    LOAD_PTRS();
    pg8::Gemm g{P.OG, P.WtOB, MTOK, 1024, 1024}; pg8::StaticOrder S; S.init(MTOK, 1024, G, bx);
    EpiRes E{P.XN, P.out, lds + L_EPI};
    pg8::gemm_phase<EpiRes, pg8::StaticOrder, true, true>(lds, g, S, E, wave);
  }
#undef IN
#undef SEAM
}

extern "C" void kernel_launch(void* const* d_in, const int* in_sizes, int n_in, void* d_out, int out_size, void* d_ws, size_t ws_size, hipStream_t stream) {
  static int grid = 0;
  if (grid == 0) {
    if (n_in != 14 || out_size != MTOK * DM || ws_size < WS_END) { fprintf(stderr, "kernel_launch: unexpected problem (n_in %d, out %d, ws %zu)\n", n_in, out_size, ws_size); grid = -1; return; }
    int dev = 0, cus = 0, per_cu = 0;
    if (hipGetDevice(&dev) != hipSuccess || hipDeviceGetAttribute(&cus, hipDeviceAttributeMultiprocessorCount, dev) != hipSuccess) { grid = -1; return; }
    if (hipFuncSetAttribute((const void*)fwd, hipFuncAttributeMaxDynamicSharedMemorySize, LDS_BYTES) != hipSuccess) { fprintf(stderr, "kernel_launch: hipFuncSetAttribute failed\n"); grid = -1; return; }
    if (hipOccupancyMaxActiveBlocksPerMultiprocessor(&per_cu, (const void*)fwd, 512, LDS_BYTES) != hipSuccess || per_cu < 1) { fprintf(stderr, "kernel_launch: occupancy query says %d\n", per_cu); per_cu = 1; }
    (void)hipGetLastError();
    grid = cus;
  }
  if (grid < 0) return;
  Args a{};
  for (int i = 0; i < 14; ++i) a.in[i] = (const float*)d_in[i];
  a.out = (float*)d_out; a.ws = (unsigned char*)d_ws;
#if MK_N_LAUNCHES == 1
  if (hipMemsetAsync(d_ws, 0, 16384 * 9, stream) != hipSuccess) { fprintf(stderr, "kernel_launch: memset of the barrier words failed\n"); return; }
  a.ph_lo = 0; a.ph_hi = NPHASE;
  void* kargs[] = {&a};
  hipError_t e = hipLaunchCooperativeKernel((const void*)fwd, dim3(grid), dim3(512), kargs, LDS_BYTES, stream);
  if (e != hipSuccess) fprintf(stderr, "kernel_launch: cooperative launch failed: %s\n", hipGetErrorString(e));
#else
#ifndef HOST_REP_MASK
#define HOST_REP_MASK 0
#endif
  for (int p = 0; p < NPHASE; ++p) { a.ph_lo = p; a.ph_hi = p + 1; for (int r = 0; r < (((HOST_REP_MASK >> p) & 1) ? 2 : 1); ++r) hipLaunchKernelGGL(fwd, dim3(grid), dim3(512), LDS_BYTES, stream, a); }
#endif
}
```

```cpp
#include <hip/hip_runtime.h>
#include <hip/hip_cooperative_groups.h>
#include <cstdio>
#include <cstdint>
__device__ __forceinline__ int lane_id_hw() { unsigned z = 0u; asm volatile("" : "+v"(z)); return (int)__builtin_amdgcn_mbcnt_hi(~0u, __builtin_amdgcn_mbcnt_lo(~0u, z)); }
namespace pg8 {
#define PG8_LAS __attribute__((address_space(3)))
typedef unsigned short bf16_t;
typedef short bf16x8 __attribute__((ext_vector_type(8)));
typedef float f32x4 __attribute__((ext_vector_type(4)));
typedef unsigned u32x4 __attribute__((ext_vector_type(4)));
constexpr int BM = 256, BK = 64, HALF = 128, HTB = HALF * BK * 2  , STAGE_BYTES = 8 * HTB, NXCD = 8, WGM = 8;

__host__ __device__ __forceinline__ int lds_byte(int r, int c) { const int st = (r >> 4) * 2 + (c >> 5), rr = r & 15, cc = c & 31, ob = rr * 64 + cc * 2; return st * 1024 + (ob ^ (((ob >> 9) & 1) << 5)); }
__host__ __device__ __forceinline__ void stage_rc(int b, int& R, int& C) { const int st = b / 1024, sb = b % 1024, swz = sb ^ (((sb >> 9) & 1) << 5); R = (st >> 1) * 16 + swz / 64; C = (st & 1) * 32 + (swz % 64) / 2; }
__host__ __device__ __forceinline__ int perm32(int rho) { const int n = rho >> 4, i = rho & 15; return 8 * (i >> 2) + 4 * n + (i & 3); }

struct Unit { int pm, pn; };
struct Gemm { const bf16_t* A; const bf16_t* Bt; int M, N, K; };

struct StaticOrder {
    int nM, nN, nwg, G, c;
    __host__ __device__ void init(int M, int N, int G_, int c_) { nM = M / BM; nN = N / BM; nwg = nM * nN; G = G_; c = c_; }
    __host__ __device__ bool next(int i, Unit& u) const {
        const long L = (long)i * G + c; if (L >= nwg) return false;
        int wgid = (int)L; { const int q = nwg / NXCD, r = nwg % NXCD, xcd = wgid % NXCD, off = wgid / NXCD; wgid = (xcd < r ? xcd * (q + 1) : r * (q + 1) + (xcd - r) * q) + off; }
        const int nig = WGM * nN, gid = wgid / nig, fm = gid * WGM, gsz = (nM - fm) < WGM ? (nM - fm) : WGM;
        u.pm = fm + ((wgid % nig) % gsz); u.pn = (wgid % nig) / gsz; return true;
    }
    __device__ __forceinline__ void a_ready(const Unit&) const {}
    __device__ __forceinline__ void done(const Unit&) const {}
};

template <class Epi, class Sched, bool ALIGN_EPI = false, bool SP2 = false>
__device__ __forceinline__ void gemm_phase(PG8_LAS unsigned char* lds, const Gemm g, const Sched& S, const Epi& E, int wave_) {
    const int tid = wave_ * 64 + lane_id_hw(), wid = __builtin_amdgcn_readfirstlane(tid >> 6), lane = tid & 63, wr = wid >> 2, wc = wid & 3, fr = lane & 15, fq = lane >> 4;
    const int K = g.K, nt = K / BK;
    unsigned voffA[2], voffB[2];
#pragma unroll
    for (int i = 0; i < 2; ++i) { int R, C; stage_rc(tid * 16 + i * 8192, R, C); const int Rb = Epi::PERM ? ((R & ~31) + perm32(R & 31)) : R;
        voffA[i] = (unsigned)(R * K + C) * 2u; voffB[i] = (unsigned)(Rb * K + C) * 2u; }
    const size_t kstep = (size_t)(BK * 2);
    const size_t hstep = (size_t)HALF * K * 2;
    const size_t tstep = 2 * hstep;
    const unsigned ldsw = (unsigned)wid * 1024u;
    const int aoff = lds_byte(wr * 64 + fr, fq * 8), boff = lds_byte(wc * 32 + fr, fq * 8);
#define PG8_SA(b, h) (((b) * 2 + (h)) * HTB)
#define PG8_SB(b, h) ((4 + (b) * 2 + (h)) * HTB)
#define PG8_STAGE(bufoff, gbase, voff) do { _Pragma("unroll") for (int _i = 0; _i < 2; ++_i) \
        __builtin_amdgcn_global_load_lds((const unsigned*)((const char*)(gbase) + (voff)[_i]), (PG8_LAS unsigned*)(lds + (bufoff) + ldsw + _i * 8192), 16, 0, 0); } while (0)
#define PG8_LDA(dst, b, h) do { _Pragma("unroll") for (int m = 0; m < 4; ++m) _Pragma("unroll") for (int k = 0; k < 2; ++k) dst[m][k] = *(const PG8_LAS bf16x8*)(lds + PG8_SA(b, h) + aoff + m * 2048 + k * 1024); } while (0)
#define PG8_LDB(dst, b, h) do { _Pragma("unroll") for (int n = 0; n < 2; ++n) _Pragma("unroll") for (int k = 0; k < 2; ++k) dst[n][k] = *(const PG8_LAS bf16x8*)(lds + PG8_SB(b, h) + boff + n * 2048 + k * 1024); } while (0)
#define PG8_MMA(ai, bj, At, Bt) do { __builtin_amdgcn_s_setprio(1); _Pragma("unroll") for (int m = 0; m < 4; ++m) _Pragma("unroll") for (int n = 0; n < 2; ++n) _Pragma("unroll") for (int k = 0; k < 2; ++k) \
        acc[ai][bj][m][n] = __builtin_amdgcn_mfma_f32_16x16x32_bf16(Bt[n][k], At[m][k], acc[ai][bj][m][n], 0, 0, 0); __builtin_amdgcn_s_setprio(0); } while (0)
#define PG8_WAIT_V(n) asm volatile("s_waitcnt vmcnt(" #n ")" ::: "memory")
#define PG8_WAIT_L(n) asm volatile("s_waitcnt lgkmcnt(" #n ")" ::: "memory")
#define PG8_BAR __builtin_amdgcn_s_barrier()
#define PG8_SCHED __builtin_amdgcn_sched_barrier(0)
    Unit cur, nxt; int ui = 0;
    if (!S.next(0, cur)) return;
    f32x4 acc[2][2][4][2];
#pragma unroll
    for (int a = 0; a < 2; ++a)
#pragma unroll
        for (int b = 0; b < 2; ++b)
#pragma unroll
            for (int m = 0; m < 4; ++m)
#pragma unroll
                for (int n = 0; n < 2; ++n) acc[a][b][m][n] = (f32x4){0.f, 0.f, 0.f, 0.f};
    bf16x8 At[4][2], B0[2][2], B1[2][2];
    const char* cA = (const char*)g.A + (size_t)cur.pm * tstep; const char* cB = (const char*)g.Bt + (size_t)cur.pn * tstep;
    S.a_ready(cur);
    if constexpr (SP2) {
        PG8_STAGE(PG8_SB(0, 0), cB, voffB); PG8_STAGE(PG8_SB(0, 1), cB + hstep, voffB); PG8_STAGE(PG8_SA(0, 0), cA, voffA); PG8_STAGE(PG8_SA(0, 1), cA + hstep, voffA);
        if (wr == 1) PG8_BAR;
        PG8_WAIT_V(2); PG8_BAR;
        PG8_STAGE(PG8_SB(1, 0), cB + kstep, voffB); PG8_STAGE(PG8_SA(1, 0), cA + kstep, voffA); PG8_STAGE(PG8_SB(1, 1), cB + hstep + kstep, voffB);
        PG8_WAIT_V(6); PG8_BAR;
    } else {
        PG8_STAGE(PG8_SB(0, 0), cB, voffB); PG8_STAGE(PG8_SA(0, 0), cA, voffA); PG8_STAGE(PG8_SB(0, 1), cB + hstep, voffB); PG8_STAGE(PG8_SA(0, 1), cA + hstep, voffA);
        if (wr == 1) PG8_BAR;
        PG8_WAIT_V(4); PG8_BAR;
        PG8_STAGE(PG8_SB(1, 0), cB + kstep, voffB); PG8_STAGE(PG8_SA(1, 0), cA + kstep, voffA); PG8_STAGE(PG8_SB(1, 1), cB + hstep + kstep, voffB);
        PG8_WAIT_V(6); PG8_BAR;
    }
    for (;;) {
        const bool has_next = S.next(ui + 1, nxt);
        const char* nA = has_next ? (const char*)g.A + (size_t)nxt.pm * tstep : cA; const char* nB = has_next ? (const char*)g.Bt + (size_t)nxt.pn * tstep : cB;
        for (int t = 0; t < nt; t += 2) {
            const bool last = (t == nt - 2);
            const char* a1 = cA + (size_t)(t + 1) * kstep;
            const char* a2 = last ? nA : cA + (size_t)(t + 2) * kstep; const char* b2 = last ? nB : cB + (size_t)(t + 2) * kstep;
            const char* a3 = a2 + kstep; const char* b3 = b2 + kstep;
            if (last && has_next) S.a_ready(nxt);
            if constexpr (SP2) {
            PG8_LDB(B0, 0, 0); PG8_LDB(B1, 0, 1); PG8_SCHED; PG8_LDA(At, 0, 0); PG8_STAGE(PG8_SA(1, 1), a1 + hstep, voffA);
            PG8_WAIT_V(8); PG8_WAIT_L(0); PG8_BAR; PG8_MMA(0, 0, At, B0); PG8_MMA(0, 1, At, B1); PG8_BAR; PG8_SCHED;
            PG8_LDA(At, 0, 1); PG8_STAGE(PG8_SB(0, 0), b2, voffB); PG8_STAGE(PG8_SB(0, 1), b2 + hstep, voffB); PG8_STAGE(PG8_SA(0, 0), a2, voffA);
            PG8_WAIT_V(8); PG8_WAIT_L(0); PG8_BAR; PG8_MMA(1, 0, At, B0); PG8_MMA(1, 1, At, B1); PG8_BAR; PG8_SCHED;
            PG8_LDB(B0, 1, 0); PG8_LDB(B1, 1, 1); PG8_SCHED; PG8_LDA(At, 1, 0); PG8_STAGE(PG8_SA(0, 1), a2 + hstep, voffA);
            PG8_WAIT_V(8); PG8_WAIT_L(0); PG8_BAR; PG8_MMA(0, 0, At, B0); PG8_MMA(0, 1, At, B1); PG8_BAR; PG8_SCHED;
            PG8_LDA(At, 1, 1); PG8_STAGE(PG8_SB(1, 0), b3, voffB); PG8_STAGE(PG8_SB(1, 1), b3 + hstep, voffB); PG8_STAGE(PG8_SA(1, 0), a3, voffA);
            PG8_WAIT_V(8); PG8_WAIT_L(0); PG8_BAR; PG8_MMA(1, 0, At, B0); PG8_MMA(1, 1, At, B1); PG8_BAR; PG8_SCHED;
            } else {
            PG8_LDB(B0, 0, 0); PG8_SCHED; PG8_LDA(At, 0, 0); PG8_STAGE(PG8_SA(1, 1), a1 + hstep, voffA);
            PG8_WAIT_L(8); PG8_BAR; PG8_WAIT_L(0); PG8_MMA(0, 0, At, B0); PG8_BAR; PG8_SCHED;
            PG8_LDB(B1, 0, 1); PG8_STAGE(PG8_SB(0, 0), b2, voffB);
            PG8_BAR; PG8_WAIT_L(0); PG8_MMA(0, 1, At, B1); PG8_BAR;
            PG8_LDA(At, 0, 1); PG8_STAGE(PG8_SA(0, 0), a2, voffA);
            PG8_BAR; PG8_WAIT_L(0); PG8_MMA(1, 0, At, B0); PG8_BAR; PG8_SCHED;
            PG8_STAGE(PG8_SB(0, 1), b2 + hstep, voffB);
            PG8_WAIT_V(6); PG8_BAR; PG8_MMA(1, 1, At, B1); PG8_BAR;
            PG8_LDB(B0, 1, 0); PG8_SCHED; PG8_LDA(At, 1, 0); PG8_STAGE(PG8_SA(0, 1), a2 + hstep, voffA);
            PG8_WAIT_L(8); PG8_BAR; PG8_WAIT_L(0); PG8_MMA(0, 0, At, B0); PG8_BAR; PG8_SCHED;
            PG8_LDB(B1, 1, 1); PG8_STAGE(PG8_SB(1, 0), b3, voffB);
            PG8_BAR; PG8_WAIT_L(0); PG8_MMA(0, 1, At, B1); PG8_BAR;
            PG8_LDA(At, 1, 1); PG8_STAGE(PG8_SA(1, 0), a3, voffA);
            PG8_BAR; PG8_WAIT_L(0); PG8_MMA(1, 0, At, B0); PG8_BAR; PG8_SCHED;
            PG8_STAGE(PG8_SB(1, 1), b3 + hstep, voffB);
            PG8_WAIT_V(6); PG8_BAR; PG8_MMA(1, 1, At, B1); PG8_BAR;
            }
        }
        if constexpr (ALIGN_EPI) { if (wr == 0) PG8_BAR; }
        if constexpr (!Epi::AFTER_DRAIN) { E(acc, cur, wr, wc, fr, fq); S.done(cur); }
        if (!has_next) break;
#pragma unroll
        for (int a = 0; a < 2; ++a)
#pragma unroll
            for (int b = 0; b < 2; ++b)
#pragma unroll
                for (int m = 0; m < 4; ++m)
#pragma unroll
                    for (int n = 0; n < 2; ++n) acc[a][b][m][n] = (f32x4){0.f, 0.f, 0.f, 0.f};
        cur = nxt; cA = nA; cB = nB; ++ui;
        if constexpr (ALIGN_EPI) { if (wr == 1) PG8_BAR; }
    }
    PG8_WAIT_V(0);
    if constexpr (!ALIGN_EPI) { if (wr == 0) PG8_BAR; }
    PG8_BAR;
    if constexpr (Epi::AFTER_DRAIN) { E.fused(acc, cur, wr, wc, fr, fq, lds, wid, lane); S.done(cur); }
#undef PG8_SA
#undef PG8_SB
#undef PG8_STAGE
#undef PG8_LDA
#undef PG8_LDB
#undef PG8_MMA
#undef PG8_WAIT_V
#undef PG8_WAIT_L
#undef PG8_BAR
#undef PG8_SCHED
}
}

#ifndef MK_N_LAUNCHES
#define MK_N_LAUNCHES 1
#endif
namespace cg = cooperative_groups;
#define DI __device__ __forceinline__
#define LAS __attribute__((address_space(3)))
typedef unsigned short bf16;
typedef short bf16x8 __attribute__((ext_vector_type(8)));
typedef float f32x4 __attribute__((ext_vector_type(4)));
typedef float f32x16 __attribute__((ext_vector_type(16)));
typedef unsigned u32x4 __attribute__((ext_vector_type(4)));
typedef unsigned u32x2 __attribute__((ext_vector_type(2)));
typedef float f32x2_t __attribute__((ext_vector_type(2)));
typedef __bf16 bf16x2_t __attribute__((ext_vector_type(2)));
typedef short s16x2 __attribute__((ext_vector_type(2)));
typedef unsigned short u16x2 __attribute__((ext_vector_type(2)));

constexpr int SEQ = 2048, DM = 1024, NBATCH = 16, MTOK = NBATCH * SEQ;
constexpr int NCOL_A = 3328, NCOL_B = 2560;
constexpr float EPS = 1e-6f;
constexpr float LOG2E = 1.4426950408889634f;
constexpr float C2 = 0.125f * LOG2E;
constexpr int NPHASE = 9;

constexpr size_t MiB = 1u << 20;
constexpr size_t WS_WA = 1 * MiB, WS_WOA = 8 * MiB, WS_WB = 10 * MiB, WS_WOB = 15 * MiB, WS_KM = 17 * MiB, WS_IW = 18 * MiB, WS_IK = 19 * MiB;
constexpr size_t WS_XN = 24 * MiB, WS_Q = 88 * MiB, WS_K = 152 * MiB, WS_VT = 168 * MiB, WS_SG = 184 * MiB, WS_IQ = 248 * MiB, WS_OG = 280 * MiB, WS_H1 = 344 * MiB, WS_END = 472 * MiB;

constexpr int LDS_BYTES = 153600;
constexpr int IQ_STRIDE = 1040;
constexpr int L_IQ = 0, L_HIST = 33280, L_SEL = 131072, L_MASK = L_SEL + 512, L_BTAB = L_MASK + 8192, L_SELM = L_BTAB + 12288, L_BLK = L_SELM + 128, L_END = L_BLK + 16;
static_assert(L_HIST + 32 * 257 * 4 + 256 <= L_SEL, "selection scratch inside the ring");
constexpr int L_EPI = 131072;
static_assert(L_EPI + 8 * 2304 <= 152320, "epilogue staging");
constexpr int L_MISC = 152320;
static_assert(L_END <= L_MISC && L_MISC + 64 + 128 <= LDS_BYTES && LDS_BYTES <= 163840, "LDS map");

__device__ const unsigned char BKT[128] = {
  0, 1, 2, 3, 4, 5, 6, 7, 8, 9, 10, 11, 12, 13, 14, 15, 16, 16, 16, 17, 17, 18, 18, 18, 19, 19, 19, 20, 20, 20, 20, 21,
  21, 21, 21, 22, 22, 22, 22, 22, 23, 23, 23, 23, 23, 23, 24, 24, 24, 24, 24, 24, 25, 25, 25, 25, 25, 25, 25, 26, 26, 26, 26, 26,
  26, 26, 26, 27, 27, 27, 27, 27, 27, 27, 27, 27, 27, 28, 28, 28, 28, 28, 28, 28, 28, 28, 28, 29, 29, 29, 29, 29, 29, 29, 29, 29,
  29, 29, 29, 30, 30, 30, 30, 30, 30, 30, 30, 30, 30, 30, 30, 30, 30, 31, 31, 31, 31, 31, 31, 31, 31, 31, 31, 31, 31, 31, 31, 31};

struct Args { const float* in[14]; float* out; unsigned char* ws; int ph_lo, ph_hi; };

struct Ptrs {
  const float *x, *norm_a_g, *w_in_a, *qn_a_g, *kn_a_g, *w_out_a, *rel_bias, *norm_kv_g, *w_kv, *kn_b_g, *norm_b_g, *w_in_b, *qn_b_g, *w_out_b;
  float* out;
  bf16 *WtA, *WtOA, *WtB, *WtOB, *XN, *Q, *KV, *SG, *IQ, *IK, *OG;
  float *IW, *KM, *RINV, *SSQ;
};

DI unsigned cvtpk(float lo, float hi) { f32x2_t v = {lo, hi}; bf16x2_t b = __builtin_convertvector(v, bf16x2_t); return __builtin_bit_cast(unsigned, b); }
DI float bflo(unsigned u) { return __uint_as_float(u << 16); }
DI float bfhi(unsigned u) { return __uint_as_float(u & 0xffff0000u); }
DI float wave_sum(float v) {
#pragma unroll
  for (int o = 1; o < 64; o <<= 1) v += __shfl_xor(v, o);
  return v;
}
DI float silu_f(float v) { return v * __builtin_amdgcn_rcpf(1.0f + __expf(-v)); }
#define MFMA32(a, b, c) __builtin_amdgcn_mfma_f32_32x32x16_bf16((a), (b), (c), 0, 0, 0)

#define XB_TMO      128
#define XB_XCNT(j)  (256  + 64 * (j))
#define XB_XSUB(j)  (1280 + 64 * (j))
#define XB_XGEN(j)  (2304 + 64 * (j))
#define XB_TOP      3328
#define XB_TOPGEN   3392
#define XCD_BAR_WORDS 3456
#define XB_SPIN_CAP (1u << 18)

__device__ __forceinline__ unsigned xb_ld(unsigned* p)              { return __hip_atomic_load(p, __ATOMIC_RELAXED, __HIP_MEMORY_SCOPE_AGENT); }
__device__ __forceinline__ unsigned xb_add(unsigned* p, unsigned v) { return __hip_atomic_fetch_add(p, v, __ATOMIC_RELAXED, __HIP_MEMORY_SCOPE_AGENT); }
__device__ __forceinline__ unsigned xb_xcc_id() { return (unsigned)__builtin_amdgcn_s_getreg((3 << 11) | 20) & 0xFu; }
#define XB_SPIN(cond, bar) do { unsigned _sp = 0; while (cond) { __builtin_amdgcn_s_sleep(1); \
    if ((++_sp & 255u) == 0u) { if (xb_ld(&(bar)[XB_TMO])) break; if (_sp > XB_SPIN_CAP) { atomicAdd(&(bar)[XB_TMO], 1u); break; } } } } while (0)

struct XcdBarrier {
    unsigned* bar; unsigned x; unsigned total;
    volatile LAS unsigned* st;
};

__device__ __forceinline__ XcdBarrier xcd_barrier_post(unsigned* bar, volatile LAS unsigned* st, bool lead_, unsigned total_) {
    XcdBarrier b; b.bar = bar; b.x = xb_xcc_id(); b.st = st; b.total = total_;
    if (lead_) (void)xb_add(&bar[XB_XCNT(b.x)], 1u);
    return b;
}
__device__ __forceinline__ void xcd_barrier_complete(unsigned* bar, unsigned x, unsigned& nloc, unsigned& nx, unsigned G) {
    unsigned sum, cnt, mine, sp = 0u;
    for (;;) {
        sum = 0u; cnt = 0u; mine = 0u;
#pragma unroll
        for (unsigned j = 0; j < 16; ++j) { const unsigned c = xb_ld(&bar[XB_XCNT(j)]); sum += c; cnt += (c > 0u) ? 1u : 0u; mine = (j == x) ? c : mine; }
        if (sum == G) break;
        __builtin_amdgcn_s_sleep(1);
        if ((++sp & 255u) == 0u) { if (xb_ld(&bar[XB_TMO])) break; if (sp > XB_SPIN_CAP) { atomicAdd(&bar[XB_TMO], 1u); break; } }
    }
    nloc = mine > 0u ? mine : 1u; nx = cnt > 0u ? cnt : 1u;
}

__device__ __forceinline__ void xcd_barrier(const XcdBarrier& b, bool lead_) {
    asm volatile("s_waitcnt vmcnt(0)" ::: "memory");
    __syncthreads();
    if (lead_) {
        unsigned* bar = b.bar;
        __builtin_amdgcn_s_waitcnt(0);
        unsigned nloc = b.st[0], nx = b.st[1];
        if (nloc == 0u) { xcd_barrier_complete(bar, b.x, nloc, nx, b.total); b.st[0] = nloc; b.st[1] = nx; }
        const unsigned old = xb_add(&bar[XB_XSUB(b.x)], 1u);
        const unsigned gen = old / nloc;
        if (old + 1u == (gen + 1u) * nloc) {
            __builtin_amdgcn_fence(__ATOMIC_RELEASE, "agent");
            asm volatile("s_waitcnt vmcnt(0)" ::: "memory");
            if (nx > 1u) {
            const unsigned og = xb_add(&bar[XB_TOP], 1u);
            const unsigned tg = og / nx;
            if (og + 1u == (tg + 1u) * nx) xb_add(&bar[XB_TOPGEN], 1u);
            else XB_SPIN(xb_ld(&bar[XB_TOPGEN]) == tg, bar);
            }
            if (nx == 1u) (void)__hip_atomic_fetch_add(&bar[XB_XGEN(b.x)], 1u, __ATOMIC_RELAXED, __HIP_MEMORY_SCOPE_AGENT);
            __builtin_amdgcn_fence(__ATOMIC_ACQUIRE, "agent");
            if (nx > 1u) xb_add(&bar[XB_XGEN(b.x)], 1u);
            asm volatile("s_waitcnt vmcnt(0)" ::: "memory");
        } else {
            XB_SPIN(xb_ld(&bar[XB_XGEN(b.x)]) == gen, bar);
            __builtin_amdgcn_fence(__ATOMIC_ACQUIRE, "agent");
            asm volatile("s_waitcnt vmcnt(0)" ::: "memory");
        }
    }
    __syncthreads();
}

DI int slot_of(int gc) { const int u = gc & 255; return (gc & ~255) + 128 * ((u >> 5) & 1) + 32 * (u >> 6) + 16 * ((u >> 2) & 1) + 4 * ((u >> 3) & 3) + (u & 3); }

typedef pg8::f32x4 accq;
DI int pi32(int r) { return (r & ~12) | ((r & 4) << 1) | ((r & 8) >> 1); }
DI size_t kv_tile_elem(int row) { return (size_t)(row >> 5) * 16384; }
DI bf16* k_piece(bf16* KV, int row, int g, int bj, int fq) {
  return KV + kv_tile_elem(row) + (size_t)(((g * 4 + 2 * bj + (fq >> 1)) * 64 + (fq & 1) * 32 + pi32(row & 31)) * 8);
}
DI void load_gain(float (&gv)[2][2][4], const float* g, int fq, float sc) {
#pragma unroll
  for (int bj = 0; bj < 2; ++bj)
#pragma unroll
    for (int n = 0; n < 2; ++n)
#pragma unroll
      for (int e = 0; e < 4; ++e) gv[bj][n][e] = g[32 * bj + 8 * fq + 4 * n + e] * sc;
}
template <int ACT  > DI void plain_store(const accq (&acc)[2][2][4][2], int ai, int m, float sc, bf16* dst) {
#pragma unroll
  for (int bj = 0; bj < 2; ++bj) {
    float v[8];
#pragma unroll
    for (int n = 0; n < 2; ++n)
#pragma unroll
      for (int e = 0; e < 4; ++e) { float t = acc[ai][bj][m][n][e] * sc; if (ACT == 1) t = silu_f(t); v[4 * n + e] = t; }
    u32x4 w; w.x = cvtpk(v[0], v[1]); w.y = cvtpk(v[2], v[3]); w.z = cvtpk(v[4], v[5]); w.w = cvtpk(v[6], v[7]);
    *(u32x4*)(dst + 32 * bj) = w;
  }
}
DI void v_store_scaled(const accq (&acc)[2][2][4][2], int ai, int m, bf16* KV, int row, int g, int fq, float sc) {
  const int i = row & 31;
  bf16* base = KV + kv_tile_elem(row) + (size_t)((16 + g * 4 + (i >> 4)) * 512 + ((i >> 3) & 1) * 256 + (i & 7));
#pragma unroll
  for (int bj = 0; bj < 2; ++bj)
#pragma unroll
    for (int n = 0; n < 2; ++n)
#pragma unroll
      for (int e = 0; e < 4; e += 2) {
        const unsigned pk = cvtpk(acc[ai][bj][m][n][e] * sc, acc[ai][bj][m][n][e + 1] * sc);
        const int r = 8 * fq + 4 * n + e;
        base[bj * 1024 + r * 8] = (bf16)(pk & 0xffffu); base[bj * 1024 + (r + 1) * 8] = (bf16)(pk >> 16);
      }
}

struct EpiA {
  static constexpr bool PERM = false, AFTER_DRAIN = false;
  bf16 *Q, *KV, *SG, *IQ, *IK; float* IW; const float *qn_g, *kn_g; const float* rinv;
  DI void operator()(const accq (&acc)[2][2][4][2], const pg8::Unit& u, int wr, int wc, int fr, int fq) const {
    const int pn = u.pn, row0 = u.pm * 256 + wr * 64 + fr;
    if (pn <= 4) {
      float gv[2][2][4]; load_gain(gv, pn < 4 ? qn_g : kn_g, fq, pn < 4 ? C2 : 1.0f);
#pragma unroll
      for (int ai = 0; ai < 2; ++ai)
#pragma unroll
        for (int m = 0; m < 4; ++m) { const int row = row0 + 128 * ai + 16 * m; const float ri = rinv[row];
          float v[2][2][4]; float ss = 0.f;
#pragma unroll
          for (int bj = 0; bj < 2; ++bj)
#pragma unroll
            for (int n = 0; n < 2; ++n)
#pragma unroll
              for (int e = 0; e < 4; ++e) { v[bj][n][e] = acc[ai][bj][m][n][e] * ri; ss += v[bj][n][e] * v[bj][n][e]; }
          ss += __shfl_xor(ss, 16); ss += __shfl_xor(ss, 32);
          const float rn = rsqrtf(ss * (1.0f / 64.0f) + EPS);
#pragma unroll
          for (int bj = 0; bj < 2; ++bj) {
            u32x4 w; w.x = cvtpk(v[bj][0][0] * rn * gv[bj][0][0], v[bj][0][1] * rn * gv[bj][0][1]); w.y = cvtpk(v[bj][0][2] * rn * gv[bj][0][2], v[bj][0][3] * rn * gv[bj][0][3]);
            w.z = cvtpk(v[bj][1][0] * rn * gv[bj][1][0], v[bj][1][1] * rn * gv[bj][1][1]); w.w = cvtpk(v[bj][1][2] * rn * gv[bj][1][2], v[bj][1][3] * rn * gv[bj][1][3]);
            bf16* dst = pn < 4 ? Q + (size_t)row * 1024 + (4 * pn + wc) * 64 + 8 * fq + 32 * bj : k_piece(KV, row, wc, bj, fq);
            *(u32x4*)dst = w; } }
    } else if (pn == 5) {
#pragma unroll
      for (int ai = 0; ai < 2; ++ai)
#pragma unroll
        for (int m = 0; m < 4; ++m) { const int row = row0 + 128 * ai + 16 * m; v_store_scaled(acc, ai, m, KV, row, wc, fq, rinv[row]); }
    } else if (pn <= 9) {
#pragma unroll
      for (int ai = 0; ai < 2; ++ai)
#pragma unroll
        for (int m = 0; m < 4; ++m) { const int row = row0 + 128 * ai + 16 * m; plain_store<1>(acc, ai, m, rinv[row], SG + (size_t)row * 1024 + 256 * (pn - 6) + 64 * wc + 8 * fq); }
    } else if (pn <= 11) {
#pragma unroll
      for (int ai = 0; ai < 2; ++ai)
#pragma unroll
        for (int m = 0; m < 4; ++m) { const int row = row0 + 128 * ai + 16 * m; plain_store<0>(acc, ai, m, 0.125f * rinv[row], IQ + (size_t)row * 512 + 256 * (pn - 10) + 64 * wc + 8 * fq); }
    } else {
      if (wc == 0) {
#pragma unroll
        for (int ai = 0; ai < 2; ++ai)
#pragma unroll
          for (int m = 0; m < 4; ++m) { const int row = row0 + 128 * ai + 16 * m; const float sc = rinv[row];
#pragma unroll
            for (int bj = 0; bj < 2; ++bj) { u32x4 w; w.x = cvtpk(acc[ai][bj][m][0][0] * sc, acc[ai][bj][m][0][1] * sc); w.y = cvtpk(acc[ai][bj][m][0][2] * sc, acc[ai][bj][m][0][3] * sc);
              w.z = cvtpk(acc[ai][bj][m][1][0] * sc, acc[ai][bj][m][1][1] * sc); w.w = cvtpk(acc[ai][bj][m][1][2] * sc, acc[ai][bj][m][1][3] * sc);
              *(u32x4*)(IK + (size_t)(row >> 5) * 2048 + (size_t)(((2 * bj + (fq >> 1)) * 64 + (fq & 1) * 32 + pi32(row & 31)) * 8)) = w; } }
      } else if (wc == 1 && fq == 0) {
#pragma unroll
        for (int ai = 0; ai < 2; ++ai)
#pragma unroll
          for (int m = 0; m < 4; ++m) { const int row = row0 + 128 * ai + 16 * m; float* d = IW + (size_t)row * 8; const float sc = 0.35355339059327373f * rinv[row];
            *(f32x4*)d = acc[ai][0][m][0] * sc; *(f32x4*)(d + 4) = acc[ai][0][m][1] * sc; }
      }
    }
  }
};
DI float row_rinv(const float* ssq, int row) {
  const f32x4* p = (const f32x4*)(ssq + (size_t)row * 16); const f32x4 a = p[0], b = p[1], c = p[2], d = p[3];
  const float t = (((a.x + a.y) + (a.z + a.w)) + ((b.x + b.y) + (b.z + b.w))) + (((c.x + c.y) + (c.z + c.w)) + ((d.x + d.y) + (d.z + d.w)));
  return rsqrtf(t * (1.0f / 1024.0f) + EPS);
}
struct EpiB {
  static constexpr bool PERM = false, AFTER_DRAIN = false;
  bf16 *Q, *KV, *SG; const float *qn_g, *kn_g; const float* rinv2; float* KM;
  DI void operator()(const accq (&acc)[2][2][4][2], const pg8::Unit& u, int wr, int wc, int fr, int fq) const {
    const int pn = u.pn, row0 = u.pm * 256 + wr * 64 + fr;
    if (pn == 0 || (pn >= 2 && pn <= 5)) {
      float gv[2][2][4]; load_gain(gv, pn == 0 ? kn_g : qn_g, fq, pn == 0 ? 1.0f : C2);
      float cs[2][2][4];
#pragma unroll
      for (int bj = 0; bj < 2; ++bj)
#pragma unroll
        for (int n = 0; n < 2; ++n)
#pragma unroll
          for (int e = 0; e < 4; ++e) cs[bj][n][e] = 0.f;
#pragma unroll
      for (int ai = 0; ai < 2; ++ai)
#pragma unroll
        for (int m = 0; m < 4; ++m) { const int row = row0 + 128 * ai + 16 * m; const float ri = rinv2[row];
          float v[2][2][4]; float ss = 0.f;
#pragma unroll
          for (int bj = 0; bj < 2; ++bj)
#pragma unroll
            for (int n = 0; n < 2; ++n)
#pragma unroll
              for (int e = 0; e < 4; ++e) { v[bj][n][e] = acc[ai][bj][m][n][e] * ri; ss += v[bj][n][e] * v[bj][n][e]; }
          ss += __shfl_xor(ss, 16); ss += __shfl_xor(ss, 32);
          const float rn = rsqrtf(ss * (1.0f / 64.0f) + EPS);
#pragma unroll
          for (int bj = 0; bj < 2; ++bj) {
#pragma unroll
            for (int n = 0; n < 2; ++n)
#pragma unroll
              for (int e = 0; e < 4; ++e) { v[bj][n][e] = v[bj][n][e] * rn * gv[bj][n][e]; cs[bj][n][e] += v[bj][n][e]; }
            u32x4 w; w.x = cvtpk(v[bj][0][0], v[bj][0][1]); w.y = cvtpk(v[bj][0][2], v[bj][0][3]); w.z = cvtpk(v[bj][1][0], v[bj][1][1]); w.w = cvtpk(v[bj][1][2], v[bj][1][3]);
            bf16* dst = pn != 0 ? Q + (size_t)row * 1024 + (4 * (pn - 2) + wc) * 64 + 8 * fq + 32 * bj : k_piece(KV, row, wc, bj, fq);
            *(u32x4*)dst = w; } }
      if (pn == 0) {
        float* km = KM + ((size_t)((u.pm >> 3) * 4 + wc) * 8 + (u.pm & 7)) * 64 + 8 * fq;
#pragma unroll
        for (int bj = 0; bj < 2; ++bj)
#pragma unroll
          for (int n = 0; n < 2; ++n)
#pragma unroll
            for (int e = 0; e < 4; ++e) { float t = cs[bj][n][e]; t += __shfl_xor(t, 1); t += __shfl_xor(t, 2); t += __shfl_xor(t, 4); t += __shfl_xor(t, 8);
              if (fr == 0) atomicAdd(km + 32 * bj + 4 * n + e, t * (1.0f / 256.0f)); }
      }
    } else if (pn == 1) {
#pragma unroll
      for (int ai = 0; ai < 2; ++ai)
#pragma unroll
        for (int m = 0; m < 4; ++m) { const int row = row0 + 128 * ai + 16 * m; const float ri = rinv2[row];
          v_store_scaled(acc, ai, m, KV, row, wc, fq, ri); }
    } else {
#pragma unroll
      for (int ai = 0; ai < 2; ++ai)
#pragma unroll
        for (int m = 0; m < 4; ++m) { const int row = row0 + 128 * ai + 16 * m; plain_store<1>(acc, ai, m, rinv2[row], SG + (size_t)row * 1024 + 256 * (pn - 6) + 64 * wc + 8 * fq); }
    }
  }
};
DI void unpack8(const u32x4 w, float (&f)[8]) { f[0] = bflo(w.x); f[1] = bfhi(w.x); f[2] = bflo(w.y); f[3] = bfhi(w.y); f[4] = bflo(w.z); f[5] = bfhi(w.z); f[6] = bflo(w.w); f[7] = bfhi(w.w); }
struct EpiRes {
  static constexpr bool PERM = false, AFTER_DRAIN = false;
  const bf16* res; float* out; LAS unsigned char* stg0;
  DI void operator()(const accq (&acc)[2][2][4][2], const pg8::Unit& u, int wr, int wc, int fr, int fq) const {
    const int row0 = u.pm * 256 + wr * 64 + fr, col0 = u.pn * 256 + 64 * wc + 8 * fq; LAS unsigned char* stg = stg0 + (wr * 4 + wc) * 2304; const int lane = fq * 16 + fr, r8 = lane >> 3, p8 = lane & 7;
#pragma unroll
    for (int ai = 0; ai < 2; ++ai)
#pragma unroll
      for (int m = 0; m < 4; ++m) { const size_t off = (size_t)(row0 + 128 * ai + 16 * m) * 1024 + col0;
#pragma unroll
        for (int bj = 0; bj < 2; ++bj) { float f[8]; unpack8(*(const u32x4*)(res + off + 32 * bj), f);
          f32x4 o0 = acc[ai][bj][m][0], o1 = acc[ai][bj][m][1];
          o0.x += f[0]; o0.y += f[1]; o0.z += f[2]; o0.w += f[3]; o1.x += f[4]; o1.y += f[5]; o1.z += f[6]; o1.w += f[7];
          *(LAS f32x4*)(stg + fr * 144 + fq * 32) = o0; *(LAS f32x4*)(stg + fr * 144 + fq * 32 + 16) = o1;
          asm volatile("" ::: "memory");
          const f32x4 a = *(const LAS f32x4*)(stg + r8 * 144 + p8 * 16), b = *(const LAS f32x4*)(stg + (r8 + 8) * 144 + p8 * 16);
          float* ob = out + (size_t)(row0 - fr + 128 * ai + 16 * m) * 1024 + u.pn * 256 + 64 * wc + 32 * bj + 4 * p8;
          __builtin_nontemporal_store(a, (f32x4*)(ob + (size_t)r8 * 1024)); __builtin_nontemporal_store(b, (f32x4*)(ob + (size_t)(r8 + 8) * 1024));
          asm volatile("" ::: "memory"); } }
  }
};
struct EpiRes2 {
  static constexpr bool PERM = false, AFTER_DRAIN = false;
  bf16* xh; float* ssq;
  DI void operator()(const accq (&acc)[2][2][4][2], const pg8::Unit& u, int wr, int wc, int fr, int fq) const {
    const int row0 = u.pm * 256 + wr * 64 + fr, col0 = u.pn * 256 + 64 * wc + 8 * fq;
#pragma unroll
    for (int ai = 0; ai < 2; ++ai)
#pragma unroll
      for (int m = 0; m < 4; ++m) { const int row = row0 + 128 * ai + 16 * m; const size_t off = (size_t)row * 1024 + col0; float ss = 0.f;
#pragma unroll
        for (int bj = 0; bj < 2; ++bj) { float f[8]; unpack8(*(const u32x4*)(xh + off + 32 * bj), f);
#pragma unroll
          for (int n = 0; n < 2; ++n)
#pragma unroll
            for (int e = 0; e < 4; ++e) { f[4 * n + e] += acc[ai][bj][m][n][e]; ss += f[4 * n + e] * f[4 * n + e]; }
          u32x4 w; w.x = cvtpk(f[0], f[1]); w.y = cvtpk(f[2], f[3]); w.z = cvtpk(f[4], f[5]); w.w = cvtpk(f[6], f[7]);
          *(u32x4*)(xh + off + 32 * bj) = w; }
        ss += __shfl_xor(ss, 16); ss += __shfl_xor(ss, 32);
        if (fq == 0) ssq[(size_t)row * 16 + u.pn * 4 + wc] = ss; }
  }
};
DI int srccol_A(int gc) { if (gc < 3072) return gc; if (gc < 3136) return 3080 + (gc - 3072); if (gc < 3144) return 3072 + (gc - 3136); return -1; }
DI void trans_item(const float* W, int Ns, const float* gk, bf16* Wt, int item, int nblk, int kindA, LAS float* scr, int lane) {
  const int kb = item / nblk, nb = item % nblk, k0 = 64 * kb, gc0 = 32 * nb;
  const int n = lane & 31, gc = gc0 + n; const int sc = kindA ? srccol_A(gc) : gc;
#pragma unroll 8
  for (int i = 0; i < 32; ++i) { const int kk = 2 * i + (lane >> 5); float v = 0.f; if (sc >= 0) v = __builtin_nontemporal_load(W + (size_t)(k0 + kk) * Ns + sc); if (gk) v *= gk[k0 + kk]; scr[kk * 33 + n] = v; }
  asm volatile("s_waitcnt lgkmcnt(0)" ::: "memory");
  const int c = lane & 7;
#pragma unroll
  for (int j = 0; j < 4; ++j) { const int nn = (lane >> 3) + 8 * j; const LAS float* s = scr + (8 * c) * 33 + nn;
    u32x4 o; o.x = cvtpk(s[0 * 33], s[1 * 33]); o.y = cvtpk(s[2 * 33], s[3 * 33]); o.z = cvtpk(s[4 * 33], s[5 * 33]); o.w = cvtpk(s[6 * 33], s[7 * 33]);
    *(u32x4*)(Wt + (size_t)slot_of(gc0 + nn) * 1024 + k0 + 8 * c) = o; }
  asm volatile("s_waitcnt lgkmcnt(0)" ::: "memory");
}

DI int kidx(int r, int hi) { return 16 * (r >> 3) + 8 * hi + (r & 7); }
DI void k_dma(const char* ksrc  , unsigned voff  , unsigned lds_slot  ) {
  unsigned keep;
  asm volatile("s_waitcnt lgkmcnt(0)\n\ts_mov_b32 %0, m0\n\ts_mov_b32 m0, %3\n\ts_nop 0\n\t"
               "global_load_lds_dwordx4 %1, %2\n\tglobal_load_lds_dwordx4 %1, %2 offset:1024\n\tglobal_load_lds_dwordx4 %1, %2 offset:2048\n\tglobal_load_lds_dwordx4 %1, %2 offset:3072\n\t"
               "s_mov_b32 m0, %0" : "=&s"(keep) : "v"(voff), "s"(ksrc), "s"(lds_slot) : "memory");
}
DI void v_load(bf16x8 (&vf)[4], const char* vsrc  , unsigned voff) {
  asm volatile("global_load_dwordx4 %0, %4, %5\n\tglobal_load_dwordx4 %1, %4, %5 offset:1024\n\tglobal_load_dwordx4 %2, %4, %5 offset:2048\n\tglobal_load_dwordx4 %3, %4, %5 offset:3072"
               : "=&v"(vf[0]), "=&v"(vf[1]), "=&v"(vf[2]), "=&v"(vf[3]) : "v"(voff), "s"(vsrc) : "memory");
}
DI void kv_wait(bf16x8 (&vf)[4]) { asm volatile("s_waitcnt vmcnt(0)" : "+v"(vf[0]), "+v"(vf[1]), "+v"(vf[2]), "+v"(vf[3]) :: "memory"); }
DI void qk_tile(f32x16 (&c)[2], const LAS unsigned char* kslot  , const bf16x8 (&qf)[2][4]) {
  bf16x8 kf[4];
#pragma unroll
  for (int s = 0; s < 4; ++s) kf[s] = *(const LAS bf16x8*)(kslot + s * 1024);
#pragma unroll
  for (int j = 0; j < 2; ++j) {
    f32x16 z;
#pragma unroll
    for (int r = 0; r < 16; ++r) z[r] = 0.f;
    c[j] = MFMA32(kf[0], qf[j][0], z);
#pragma unroll
    for (int s = 1; s < 4; ++s) c[j] = MFMA32(kf[s], qf[j][s], c[j]);
  }
}
DI void add_bias(f32x16 (&c)[2], const LAS float* bt0, int dist0) {
#pragma unroll
  for (int j = 0; j < 2; ++j) { const LAS float* tp = bt0 + j * 192 + (dist0 + 8);
#pragma unroll
    for (int r = 0; r < 16; ++r) c[j][r] += tp[23 - (16 * (r >> 3) + (r & 7))]; }
}
template <int MODE> DI void sm_pv(f32x16 (&O)[2][2], float (&l)[2], const f32x16 (&c)[2], const bf16x8 (&vf4)[4], unsigned m) {
#pragma unroll
  for (int j = 0; j < 2; ++j) {
    float p[16]; float ls = 0.f;
#pragma unroll
    for (int r = 0; r < 16; ++r) {
      const float e = __builtin_amdgcn_exp2f(c[j][r]);
      if (MODE == 0) { const unsigned ext = (unsigned)__builtin_amdgcn_sbfe((int)m, r, 1); p[r] = __uint_as_float(__float_as_uint(e) & ext); }
      else p[r] = e;
      ls += p[r];
    }
    if (MODE == 1) ls = __uint_as_float(__float_as_uint(ls) & m);
    l[j] += ls;
    bf16x8 pk[2];
#pragma unroll
    for (int s = 0; s < 2; ++s) { u32x4 w; w.x = cvtpk(p[8 * s], p[8 * s + 1]); w.y = cvtpk(p[8 * s + 2], p[8 * s + 3]); w.z = cvtpk(p[8 * s + 4], p[8 * s + 5]); w.w = cvtpk(p[8 * s + 6], p[8 * s + 7]);
      if (MODE == 1) { w.x &= m; w.y &= m; w.z &= m; w.w &= m; }
      pk[s] = __builtin_bit_cast(bf16x8, w); }
#pragma unroll
    for (int dt = 0; dt < 2; ++dt)
#pragma unroll
      for (int s = 0; s < 2; ++s) O[j][dt] = MFMA32(vf4[dt * 2 + s], pk[s], O[j][dt]);
  }
}
DI void attn_store(const f32x16 (&O)[2][2], const float (&l)[2], const bf16* SG, bf16* OG, size_t row0, int head0, LAS unsigned char* stg, int lane) {
  const int q = lane & 31, hi = lane >> 5, rr = lane >> 3, pc = lane & 7;
  const size_t goff = (row0 + rr) * 1024 + (size_t)head0 * 64 + 8 * pc;
  u32x4 sg[2][4];
#pragma unroll
  for (int j = 0; j < 2; ++j)
#pragma unroll
    for (int i = 0; i < 4; ++i) sg[j][i] = *(const u32x4*)(SG + goff + (size_t)i * 8192 + j * 64);
  LAS unsigned char* wb = stg + q * 256; const int wt = ((q & 15) ^ hi) << 4;
  const LAS unsigned char* rb = stg + rr * 256; const int rt = ((2 * pc) ^ rr) << 4;
#pragma unroll
  for (int j = 0; j < 2; ++j) {
    const float lt = l[j] + __shfl_xor(l[j], 32); const float inv = 1.0f / lt;
#pragma unroll
    for (int dt = 0; dt < 2; ++dt)
#pragma unroll
      for (int a = 0; a < 4; ++a) {
        f32x4 v; v.x = O[j][dt][4 * a + 0] * inv; v.y = O[j][dt][4 * a + 1] * inv; v.z = O[j][dt][4 * a + 2] * inv; v.w = O[j][dt][4 * a + 3] * inv;
        *(LAS f32x4*)(wb + (wt ^ ((8 * dt + 2 * a) << 4))) = v;
      }
    asm volatile("" ::: "memory");
#pragma unroll
    for (int i = 0; i < 4; ++i) {
      const int x0 = rt ^ ((i & 1) << 7);
      const f32x4 a0 = *(const LAS f32x4*)(rb + i * 2048 + x0), a1 = *(const LAS f32x4*)(rb + i * 2048 + (x0 ^ 16));
      const u32x4 g = sg[j][i]; u32x4 w;
      w.x = cvtpk(a0.x * bflo(g.x), a0.y * bfhi(g.x)); w.y = cvtpk(a0.z * bflo(g.y), a0.w * bfhi(g.y));
      w.z = cvtpk(a1.x * bflo(g.z), a1.y * bfhi(g.z)); w.w = cvtpk(a1.z * bflo(g.w), a1.w * bfhi(g.w));
      *(u32x4*)(OG + goff + (size_t)i * 8192 + j * 64) = w;
    }
    asm volatile("" ::: "memory");
  }
}
DI void build_btab(LAS unsigned char* lds, const float* rel_bias, int tid_) {
  LAS float* bt = (LAS float*)(lds + L_BTAB);
  for (int i = tid_; i < 16 * 192; i += 512) { const int h = i / 192, dist = i % 192 - 31;
    bt[i] = dist < 0 ? -INFINITY : (dist < 128 ? (rel_bias[(int)BKT[dist] * 16 + h] - rel_bias[31 * 16 + h]) * LOG2E : 0.f); }
}
DI unsigned causal16(int q, int hi) { unsigned m = 0;
#pragma unroll
  for (int r = 0; r < 16; ++r) m |= (kidx(r, hi) <= q) ? (1u << r) : 0u;
  return m; }

DI void dsa_unit(LAS unsigned char* lds, const Ptrs& P, int b, int qt, int wave_) {
  int tid = wave_ * 64 + lane_id_hw(); asm volatile("" : "+v"(tid));
  const int lane = tid & 63, w = __builtin_amdgcn_readfirstlane(tid >> 6), q = lane & 31, hi = lane >> 5;
  const int t0 = 32 * qt, nkt = qt + 1; const size_t rowb = (size_t)b * SEQ;
  LAS unsigned short* maskl = (LAS unsigned short*)(lds + L_MASK);
  bf16x8 qf[2][4];
#pragma unroll
  for (int j = 0; j < 2; ++j)
#pragma unroll
    for (int s = 0; s < 4; ++s) qf[j][s] = *(const bf16x8*)(P.Q + (rowb + t0 + q) * 1024 + (2 * w + j) * 64 + 16 * s + 8 * hi);
  __syncthreads();
  if (qt >= 8) {
    const bf16* ikb = P.IK + (size_t)(b * 64) * 2048 + lane * 8;
    bf16x8 ikc[4], ikn[4];
#pragma unroll
    for (int s = 0; s < 4; ++s) ikc[s] = *(const bf16x8*)(ikb + (size_t)w * 2048 + 512 * s);
    LAS float* wl = (LAS float*)(lds + L_HIST);
    { f32x4 wv = {0.f, 0.f, 0.f, 0.f}; if (tid < 64) wv = *(const f32x4*)(P.IW + (rowb + t0) * 8 + tid * 4);
      const int row = tid >> 4, ch = tid & 15; const u32x4* src = (const u32x4*)(P.IQ + (rowb + t0 + row) * 512);
#pragma unroll
      for (int c = 0; c < 4; ++c) *(LAS u32x4*)(lds + L_IQ + row * IQ_STRIDE + (ch + 16 * c) * 16) = __builtin_nontemporal_load(src + ch + 16 * c);
      if (tid < 64) *(LAS f32x4*)(wl + tid * 4) = wv; }
    __syncthreads();
    unsigned pl[4][16];
#pragma unroll
    for (int B = 0; B < 4; ++B) {
#pragma unroll
      for (int h2 = 0; h2 < 2; ++h2) {
        const int kt = w + 8 * (2 * B + h2);
        if (2 * B + h2 < 7) { const int ktn = (kt + 8 < nkt) ? kt + 8 : w;
#pragma unroll
          for (int s = 0; s < 4; ++s) ikn[s] = *(const bf16x8*)(ikb + (size_t)ktn * 2048 + 512 * s); }
        float sc[16];
        if (2 * B + h2 == 0 || kt < nkt) {
#pragma unroll
          for (int s = 0; s < 4; ++s) asm volatile("" : "+v"(ikc[s]));
#pragma unroll
          for (int r = 0; r < 16; ++r) sc[r] = 0.f;
#pragma unroll 2
          for (int hd = 0; hd < 8; ++hd) {
            f32x16 c;
#pragma unroll
            for (int r = 0; r < 16; ++r) c[r] = 0.f;
#pragma unroll
            for (int s = 0; s < 4; ++s) { const bf16x8 bq = *(const LAS bf16x8*)(lds + L_IQ + q * IQ_STRIDE + (hd * 64 + 16 * s + 8 * hi) * 2); c = MFMA32(ikc[s], bq, c); }
            const float wh = wl[q * 8 + hd];
#pragma unroll
            for (int r = 0; r < 16; ++r) { const int ci_ = __builtin_bit_cast(int, (float)c[r]); sc[r] += wh * __builtin_bit_cast(float, ci_ > 0 ? ci_ : 0); asm("" : "+v"(sc[r])); }
          }
          if (kt == qt) {
#pragma unroll
            for (int r = 0; r < 16; ++r) if (kidx(r, hi) > q) sc[r] = -INFINITY;
          }
        } else {
#pragma unroll
          for (int r = 0; r < 16; ++r) sc[r] = -INFINITY;
        }
#pragma unroll
        for (int v = 0; v < 16; ++v) {
          if (h2 == 0) pl[B][v] = __builtin_bit_cast(unsigned, __builtin_amdgcn_cvt_pkrtz(sc[v], 0.f));
          else pl[B][v] |= __builtin_bit_cast(unsigned, __builtin_amdgcn_cvt_pkrtz(0.f, sc[v]));
        }
#pragma unroll
        for (int s = 0; s < 4; ++s) ikc[s] = ikn[s];
      }
#pragma unroll
      for (int v = 0; v < 16; ++v) { const unsigned u = pl[B][v]; pl[B][v] = u ^ (((u >> 15) & 0x00010001u) * 0x7FFFu); }
#define TR_STAGE(J, MJ) _Pragma("unroll") for (int k = 0; k < 16; ++k) if ((k & (J)) == 0) { const unsigned t = ((pl[B][k] >> (J)) ^ pl[B][k + (J)]) & (MJ); pl[B][k + (J)] ^= t; pl[B][k] ^= t << (J); }
      TR_STAGE(8, 0x00FF00FFu) TR_STAGE(4, 0x0F0F0F0Fu) TR_STAGE(2, 0x33333333u) TR_STAGE(1, 0x55555555u)
#undef TR_STAGE
      pl[B][15] = ~pl[B][15];
#pragma unroll
      for (int v = 0; v < 16; ++v) asm volatile("" : "+v"(pl[B][v]));
      __builtin_amdgcn_sched_barrier(0);
    }
    LAS unsigned* cb = (LAS unsigned*)(lds + L_HIST + 32 * 257 * 4);
    if (tid < 64) cb[tid] = 0u;
    __syncthreads();
    unsigned mm[4] = {0xFFFFFFFFu, 0xFFFFFFFFu, 0xFFFFFFFFu, 0xFFFFFFFFu}, gt[4] = {0u, 0u, 0u, 0u}, Gtot = 0u, prev0 = 0u, prev1 = 0u;
#pragma unroll
    for (int bit = 15; bit >= 0; --bit) {
      unsigned t4[4]; unsigned cnt = 0u;
#pragma unroll
      for (int B = 0; B < 4; ++B) { t4[B] = mm[B] & pl[B][bit]; cnt += (unsigned)__builtin_popcount(t4[B]); }
      LAS unsigned* cw = cb + ((bit & 1) ? 32 : 0) + q;
      __hip_atomic_fetch_add(cw, cnt, __ATOMIC_RELAXED, __HIP_MEMORY_SCOPE_WORKGROUP);
      __syncthreads();
      const unsigned run = *cw; unsigned tot;
      if (bit & 1) { tot = run - prev1; prev1 = run; } else { tot = run - prev0; prev0 = run; }
      const bool acc1 = (Gtot + tot) >= 256u;
#pragma unroll
      for (int B = 0; B < 4; ++B) { if (acc1) mm[B] = t4[B]; else { gt[B] |= t4[B]; mm[B] ^= t4[B]; } }
      if (!acc1) Gtot += tot;
    }
    LAS unsigned short* tm = (LAS unsigned short*)(lds + L_HIST + 1024); LAS unsigned short* pf = (LAS unsigned short*)(lds + L_HIST + 1024 + 8192);
#pragma unroll
    for (int B = 0; B < 4; ++B) {
      tm[((w + 8 * (2 * B)) * 32 + q) * 2 + hi] = (unsigned short)(mm[B] & 0xFFFFu);
      tm[((w + 8 * (2 * B + 1)) * 32 + q) * 2 + hi] = (unsigned short)(mm[B] >> 16);
    }
    __syncthreads();
#pragma unroll
    for (int e = 0; e < 4; ++e) {
      const int qq = 4 * w + e;
      const unsigned c = (unsigned)__builtin_popcount(((const LAS unsigned*)tm)[lane * 32 + qq]);
      unsigned incl = c;
#pragma unroll
      for (int o = 1; o < 64; o <<= 1) { const unsigned t = __shfl_up(incl, o); if (lane >= o) incl += t; }
      pf[lane * 32 + qq] = (unsigned short)(incl - c);
    }
    __syncthreads();
    { const unsigned need = 256u - Gtot;
#pragma unroll
      for (int B = 0; B < 4; ++B) {
        unsigned sel = gt[B];
#pragma unroll
        for (int h2 = 0; h2 < 2; ++h2) {
          const unsigned t16 = (mm[B] >> (16 * h2)) & 0xFFFFu;
          if (t16) {
            const int kt = w + 8 * (2 * B + h2);
            const unsigned pair = ((const LAS unsigned*)tm)[kt * 32 + q], base = pf[kt * 32 + q];
            const unsigned c0 = (unsigned)__builtin_popcount(pair & 0xFFu), c1 = (unsigned)__builtin_popcount(pair & 0xFF0000u), c2 = (unsigned)__builtin_popcount(pair & 0xFF00u);
            const unsigned offL = base + (hi ? c0 : 0u), offH = base + (hi ? c0 + c1 + c2 : c0 + c1);
            unsigned rem = t16;
            while (rem) { const int pos = __builtin_ctz(rem); rem &= rem - 1u;
              const unsigned below = (unsigned)__builtin_popcount(t16 & ((1u << pos) - 1u) & (pos >= 8 ? 0xFF00u : 0xFFu));
              if ((pos >= 8 ? offH : offL) + below < need) sel |= 1u << (pos + 16 * h2); }
          }
        }
        if (w + 8 * (2 * B) < nkt) maskl[(w + 8 * (2 * B)) * 64 + lane] = (unsigned short)(sel & 0xFFFFu);
        if (w + 8 * (2 * B + 1) < nkt) maskl[(w + 8 * (2 * B + 1)) * 64 + lane] = (unsigned short)(sel >> 16);
      } }
  } else {
    const unsigned cm = causal16(q, hi);
#pragma unroll
    for (int i = 0; i < 8; ++i) { const int kt = w + 8 * i; if (kt < nkt) maskl[kt * 64 + lane] = (unsigned short)(kt == qt ? cm : 0xFFFFu); }
  }
  __syncthreads();
  const int g = w >> 1;
  const bf16* img = P.KV + (size_t)(b * 64) * 16384;
  const unsigned lds0 = (unsigned)(uintptr_t)lds;
#pragma unroll
  for (int j = 0; j < 2; ++j)
#pragma unroll
    for (int s = 0; s < 4; ++s) asm volatile("" : "+v"(qf[j][s]));
  f32x16 O[2][2]; float l[2] = {0.f, 0.f};
#pragma unroll
  for (int j = 0; j < 2; ++j)
#pragma unroll
    for (int dt = 0; dt < 2; ++dt)
#pragma unroll
      for (int r = 0; r < 16; ++r) O[j][dt][r] = 0.f;
  const LAS float* bt0 = (const LAS float*)(lds + L_BTAB) + (2 * w) * 192;
  LAS unsigned char* ringp = lds + 65536 + w * 8192;
  const char* ksrc = (const char*)img + g * 4096; const unsigned voff = (unsigned)lane * 16u;
  const unsigned kring = lds0 + (unsigned)w * 8192u; const LAS unsigned char* kl = lds + w * 8192 + lane * 16;
#define TSRC(t_) (ksrc + (size_t)((t_) < nkt ? (t_) : nkt - 1) * 32768)
  bf16x8 vA[4], vB[4]; f32x16 cA[2], cB[2];
  k_dma(TSRC(0), voff, kring); v_load(vA, TSRC(0) + 16384, voff); k_dma(TSRC(1), voff, kring + 4096u);
  kv_wait(vA);
  qk_tile(cA, kl, qf);
#pragma unroll 1
  for (int kt = 0; ; kt += 2) {
    k_dma(TSRC(kt + 2), voff, kring); v_load(vB, TSRC(kt + 1) + 16384, voff);
    if (qt - kt <= 4) add_bias(cA, bt0, (t0 + q) - (32 * kt + 8 * hi));
    { const unsigned m16 = maskl[kt * 64 + lane];
      qk_tile(cB, kl + 4096, qf); sm_pv<0>(O, l, cA, vA, m16); }
    kv_wait(vB);
    if (kt + 1 >= nkt) break;
    k_dma(TSRC(kt + 3), voff, kring + 4096u); v_load(vA, TSRC(kt + 2) + 16384, voff);
    if (qt - (kt + 1) <= 4) add_bias(cB, bt0, (t0 + q) - (32 * (kt + 1) + 8 * hi));
    { const unsigned m16 = maskl[(kt + 1) * 64 + lane];
      qk_tile(cA, kl, qf); sm_pv<0>(O, l, cB, vB, m16); }
    kv_wait(vA);
    if (kt + 2 >= nkt) break;
  }
#undef TSRC
  { int tid2 = lane_id_hw(); asm volatile("" : "+v"(tid2)); const int lane2 = tid2 & 63;
    attn_store(O, l, P.SG, P.OG, rowb + t0, 2 * w, ringp, lane2); }
}

DI void moba_unit(LAS unsigned char* lds, const Ptrs& P, int b, int qt, int wave_) {
  int tid = wave_ * 64 + lane_id_hw(); asm volatile("" : "+v"(tid));
  const int lane = tid & 63, w = __builtin_amdgcn_readfirstlane(tid >> 6), q = lane & 31, hi = lane >> 5;
  const int t0 = 32 * qt, ob = qt >> 3; const size_t rowb = (size_t)b * SEQ;
  LAS unsigned char* selm = lds + L_SELM; LAS unsigned* blkw = (LAS unsigned*)(lds + L_BLK);
  bf16x8 qf[2][4];
#pragma unroll
  for (int j = 0; j < 2; ++j)
#pragma unroll
    for (int s = 0; s < 4; ++s) qf[j][s] = *(const bf16x8*)(P.Q + (rowb + t0 + q) * 1024 + (2 * w + j) * 64 + 16 * s + 8 * hi);
  __syncthreads();
  if (tid == 0) blkw[0] = 0u;
  __syncthreads();
  if (ob > 0) {
    const int qq = tid & 31, gg = (tid >> 5) & 3, part = tid >> 7;
    float gs[7];
#pragma unroll
    for (int n = 0; n < 7; ++n) gs[n] = 0.f;
    const bf16* qp = P.Q + (rowb + t0 + qq) * 1024 + gg * 256 + part * 16;
#pragma unroll
    for (int c = 0; c < 2; ++c) {
      float qs[8];
#pragma unroll
      for (int e = 0; e < 8; ++e) qs[e] = 0.f;
#pragma unroll
      for (int j = 0; j < 4; ++j) { const u32x4 v = *(const u32x4*)(qp + j * 64 + c * 8);
        qs[0] += bflo(v.x); qs[1] += bfhi(v.x); qs[2] += bflo(v.y); qs[3] += bfhi(v.y); qs[4] += bflo(v.z); qs[5] += bfhi(v.z); qs[6] += bflo(v.w); qs[7] += bfhi(v.w); }
#pragma unroll
      for (int n = 0; n < 7; ++n) if (n < ob) { const f32x4* km = (const f32x4*)(P.KM + ((size_t)(b * 4 + gg) * 8 + n) * 64 + part * 16 + c * 8); const f32x4 k0 = km[0], k1 = km[1];
        gs[n] += (qs[0] * k0.x + qs[1] * k0.y + qs[2] * k0.z + qs[3] * k0.w) + (qs[4] * k1.x + qs[5] * k1.y + qs[6] * k1.z + qs[7] * k1.w); }
    }
    LAS float* gp = (LAS float*)lds + (size_t)(part * 128 + gg * 32 + qq) * 8;
#pragma unroll
    for (int n = 0; n < 7; ++n) gp[n] = gs[n];
  }
  __syncthreads();
  if (tid < 128) {
    const int qq = tid & 31, gg = tid >> 5; unsigned sel = 0;
    if (ob > 0) {
      float gs[7]; const LAS float* gp = (const LAS float*)lds + (size_t)(gg * 32 + qq) * 8;
#pragma unroll
      for (int n = 0; n < 7; ++n) gs[n] = (n < ob) ? ((gp[n] + gp[1024 + n]) + (gp[2048 + n] + gp[3072 + n])) : -INFINITY;
#pragma unroll
      for (int n = 0; n < 7; ++n) { if (n < ob) { int rank = 0;
#pragma unroll
          for (int m = 0; m < 7; ++m) if (m != n && m < ob) rank += ((gs[m] > gs[n]) || (gs[m] == gs[n] && m < n)) ? 1 : 0;
          if (rank < 3) sel |= 1u << n; } }
    }
    selm[gg * 32 + qq] = (unsigned char)sel;
    if (sel) __hip_atomic_fetch_or(blkw, sel, __ATOMIC_RELAXED, __HIP_MEMORY_SCOPE_WORKGROUP);
  }
  __syncthreads();
  const int g = w >> 1;
  const unsigned mysel = selm[g * 32 + q];
  const unsigned blk = (unsigned)__builtin_amdgcn_readfirstlane(blkw[0]) | (1u << ob);
  const bf16* img = P.KV + (size_t)(b * 64) * 16384;
  const unsigned lds0 = (unsigned)(uintptr_t)lds;
#pragma unroll
  for (int j = 0; j < 2; ++j)
#pragma unroll
    for (int s = 0; s < 4; ++s) asm volatile("" : "+v"(qf[j][s]));
  f32x16 O[2][2]; float l[2] = {0.f, 0.f};
#pragma unroll
  for (int j = 0; j < 2; ++j)
#pragma unroll
    for (int dt = 0; dt < 2; ++dt)
#pragma unroll
      for (int r = 0; r < 16; ++r) O[j][dt][r] = 0.f;
  const LAS float* bt0 = (const LAS float*)(lds + L_BTAB) + (2 * w) * 192;
#define NEXT_TILE(kt_, out_) do { int kn_ = (kt_) + 1; if (kn_ > qt) kn_ = -1; else if (((blk >> (kn_ >> 3)) & 1u) == 0u) kn_ = 8 * ((kn_ >> 3) + __builtin_ctz(blk >> (kn_ >> 3))); (out_) = kn_; } while (0)
  LAS unsigned char* ringp = lds + 65536 + w * 8192;
  const char* ksrc = (const char*)img + g * 4096; const unsigned voff = (unsigned)lane * 16u;
  const unsigned kring = lds0 + (unsigned)w * 8192u; const LAS unsigned char* kl = lds + w * 8192 + lane * 16;
  int ta = 8 * __builtin_ctz(blk), tb, tc, td;
  NEXT_TILE(ta, tb); tc = -1; if (tb >= 0) NEXT_TILE(tb, tc);
  const int tfirst = ta;
#define TSRC(t_) (ksrc + (size_t)((t_) >= 0 ? (t_) : tfirst) * 32768)
#define MOBA_SM(C, VF, KT) do { const int n_ = (KT) >> 3; const unsigned lm_ = (n_ < ob) ? (0u - ((mysel >> n_) & 1u)) : 0xFFFFFFFFu; sm_pv<1>(O, l, C, VF, lm_); } while (0)
  bf16x8 vA[4], vB[4]; f32x16 cA[2], cB[2];
  k_dma(TSRC(ta), voff, kring); v_load(vA, TSRC(ta) + 16384, voff); k_dma(TSRC(tb), voff, kring + 4096u);
  kv_wait(vA);
  qk_tile(cA, kl, qf);
#pragma unroll 1
  while (true) {
    k_dma(TSRC(tc), voff, kring); v_load(vB, TSRC(tb) + 16384, voff);
    if (qt - ta <= 4) add_bias(cA, bt0, (t0 + q) - (32 * ta + 8 * hi));
    qk_tile(cB, kl + 4096, qf); MOBA_SM(cA, vA, ta);
    kv_wait(vB);
    if (tb < 0) break;
    td = -1; if (tc >= 0) NEXT_TILE(tc, td);
    k_dma(TSRC(td), voff, kring + 4096u); v_load(vA, TSRC(tc) + 16384, voff);
    if (qt - tb <= 4) add_bias(cB, bt0, (t0 + q) - (32 * tb + 8 * hi));
    qk_tile(cA, kl, qf); MOBA_SM(cB, vB, tb);
    kv_wait(vA);
    if (tc < 0) break;
    ta = tc; tb = td; tc = -1; if (tb >= 0) NEXT_TILE(tb, tc);
  }
#undef MOBA_SM
#undef TSRC
#undef NEXT_TILE
  { int tid2 = lane_id_hw(); asm volatile("" : "+v"(tid2)); const int lane2 = tid2 & 63;
    attn_store(O, l, P.SG, P.OG, rowb + t0, 2 * w, ringp, lane2); }
}

__global__ void __launch_bounds__(512, 2) fwd(Args args) {
  extern __shared__ __attribute__((aligned(16))) unsigned char lds_raw[];
  LAS unsigned char* lds = (LAS unsigned char*)lds_raw;
  const int wave = __builtin_amdgcn_readfirstlane((int)threadIdx.x >> 6);
#define FRESH_TID(t_) int t_ = wave * 64 + lane_id_hw(); asm volatile("" : "+v"(t_))
  const int G = gridDim.x, bx = blockIdx.x;
  const int vcu = (G % 8 == 0) ? (bx % 8) * (G / 8) + bx / 8 : bx;
  LAS unsigned long long* ptab = (LAS unsigned long long*)(lds + L_MISC + 64);
  { FRESH_TID(tid0);
    if (tid0 < 16) { const unsigned long long* ka = (const unsigned long long*)__builtin_amdgcn_kernarg_segment_ptr(); ptab[tid0] = ka[tid0]; ((LAS unsigned*)(lds + L_MISC))[tid0] = 0u; }
    __syncthreads(); }
#define TABPTR(k) ((unsigned char*)(__attribute__((address_space(1))) unsigned char*)(((unsigned long long)(unsigned)__builtin_amdgcn_readfirstlane((int)(ptab[(k)] >> 32)) << 32) | (unsigned long long)(unsigned)__builtin_amdgcn_readfirstlane((int)(unsigned)ptab[(k)])))
#define LOAD_PTRS() Ptrs P; { asm volatile("" ::: "memory"); unsigned char* ws = TABPTR(15); \
  P.x = (const float*)TABPTR(0); P.norm_a_g = (const float*)TABPTR(1); P.w_in_a = (const float*)TABPTR(2); P.qn_a_g = (const float*)TABPTR(3); P.kn_a_g = (const float*)TABPTR(4); P.w_out_a = (const float*)TABPTR(5); P.rel_bias = (const float*)TABPTR(6); \
  P.norm_kv_g = (const float*)TABPTR(7); P.w_kv = (const float*)TABPTR(8); P.kn_b_g = (const float*)TABPTR(9); P.norm_b_g = (const float*)TABPTR(10); P.w_in_b = (const float*)TABPTR(11); P.qn_b_g = (const float*)TABPTR(12); P.w_out_b = (const float*)TABPTR(13); \
  P.out = (float*)TABPTR(14); \
  P.WtA = (bf16*)(ws + WS_WA); P.WtOA = (bf16*)(ws + WS_WOA); P.WtB = (bf16*)(ws + WS_WB); P.WtOB = (bf16*)(ws + WS_WOB); \
  P.XN = (bf16*)(ws + WS_XN); P.Q = (bf16*)(ws + WS_Q); P.KV = (bf16*)(ws + WS_K); P.SG = (bf16*)(ws + WS_SG); \
  P.IQ = (bf16*)(ws + WS_IQ); P.IK = (bf16*)(ws + WS_IK); P.OG = (bf16*)(ws + WS_OG); \
  P.IW = (float*)(ws + WS_IW); P.KM = (float*)(ws + WS_KM); P.RINV = (float*)(ws + WS_KM + 524288); P.SSQ = (float*)(ws + WS_H1); }
  const int lo = args.ph_lo, hi = args.ph_hi;
#ifndef PH_MASK
#define PH_MASK 0x1ff
#endif
#ifndef REP_MASK
#define REP_MASK 0
#endif
#define IN(k) (((PH_MASK >> (k)) & 1) && lo <= (k) && (k) < hi)
#define NREP(k) ((((REP_MASK) >> (k)) & 1) ? 2 : 1)
#if MK_N_LAUNCHES == 1
  const bool grouped = (G == 256);
  XcdBarrier xbar = xcd_barrier_post((unsigned*)TABPTR(15), (volatile LAS unsigned*)(lds + L_MISC), wave == 0 && lane_id_hw() == 0, (unsigned)G);
  XcdBarrier xbarL = xcd_barrier_post((unsigned*)(TABPTR(15) + 16384 * (1 + (bx & 7))), (volatile LAS unsigned*)(lds + L_MISC) + 2, wave == 0 && lane_id_hw() == 0, (unsigned)(G / 8));
#define SEAM(k) do { if (IN(k) && (hi > (k) + 1)) { if ((k) == 0 || !grouped) xcd_barrier(xbar, wave == 0 && lane_id_hw() == 0); else xcd_barrier(xbarL, wave == 0 && lane_id_hw() == 0); } } while (0)
#else
#define SEAM(k) do { } while (0)
#endif
  const int gw = vcu * 8 + wave, NGW = G * 8;

  if (IN(0)) {
    LOAD_PTRS();
    FRESH_TID(tid); const int lane = tid & 63;
    LAS float* scr = (LAS float*)(lds + wave * 8448);
    constexpr int I_A = 16 * (NCOL_A / 32), I_O = 16 * 32, I_KV = 16 * 16, I_B = 16 * 64;
    constexpr int NITEMS = I_A + I_O + I_KV + I_B + I_O;
    for (int it = gw; it < NITEMS; it += NGW) {
      int r = it;
      if (r < I_A) { trans_item(P.w_in_a, 3144, P.norm_a_g, P.WtA, r, NCOL_A / 32, 1, scr, lane); continue; } r -= I_A;
      if (r < I_O) { trans_item(P.w_out_a, 1024, nullptr, P.WtOA, r, 32, 0, scr, lane); continue; } r -= I_O;
      if (r < I_KV) { trans_item(P.w_kv, 512, P.norm_kv_g, P.WtB, r, 16, 0, scr, lane); continue; } r -= I_KV;
      if (r < I_B) { trans_item(P.w_in_b, 2048, P.norm_b_g, P.WtB + (size_t)512 * 1024, r, 64, 0, scr, lane); continue; } r -= I_B;
      trans_item(P.w_out_b, 1024, nullptr, P.WtOB, r, 32, 0, scr, lane);
    }
    for (int m = gw; m < MTOK; m += 4 * NGW) {
      f32x4 v[4][4]; float ss[4];
#pragma unroll
      for (int u = 0; u < 4; ++u) { const int mm = m + u * NGW; const f32x4* xr = (const f32x4*)(P.x + (size_t)(mm < MTOK ? mm : m) * 1024) + lane;
#pragma unroll
        for (int j = 0; j < 4; ++j) v[u][j] = __builtin_nontemporal_load(xr + 64 * j); }
#pragma unroll
      for (int u = 0; u < 4; ++u) { float a = 0.f;
#pragma unroll
        for (int j = 0; j < 4; ++j) a += (v[u][j].x * v[u][j].x + v[u][j].y * v[u][j].y) + (v[u][j].z * v[u][j].z + v[u][j].w * v[u][j].w);
        ss[u] = a; }
#pragma unroll
      for (int o = 1; o < 64; o <<= 1) {
#pragma unroll
        for (int u = 0; u < 4; ++u) ss[u] += __shfl_xor(ss[u], o); }
#pragma unroll
      for (int u = 0; u < 4; ++u) { const int mm = m + u * NGW; if (mm < MTOK) {
          u32x2* o8 = (u32x2*)(P.XN + (size_t)mm * 1024) + lane;
#pragma unroll
          for (int j = 0; j < 4; ++j) { u32x2 w; w.x = cvtpk(v[u][j].x, v[u][j].y); w.y = cvtpk(v[u][j].z, v[u][j].w); o8[64 * j] = w; }
          if (lane == 0) P.RINV[mm] = rsqrtf(ss[u] * (1.0f / 1024.0f) + EPS); } }
    }
    for (int i = gw * 64 + lane; i < NBATCH * 4 * 8 * 64; i += NGW * 64) P.KM[i] = 0.f;
    __syncthreads();
  }
  SEAM(0);
  if (IN(1)) for (int rep_ = 0; rep_ < NREP(1); ++rep_) {
    LOAD_PTRS();
    pg8::Gemm g{P.XN, P.WtA, MTOK, NCOL_A, 1024}; pg8::StaticOrder S; S.init(MTOK, NCOL_A, G, bx);
    EpiA E{P.Q, P.KV, P.SG, P.IQ, P.IK, P.IW, P.qn_a_g, P.kn_a_g, P.RINV};
    pg8::gemm_phase<EpiA, pg8::StaticOrder, true, true>(lds, g, S, E, wave);
    __syncthreads();
  }
  SEAM(1);
  if (IN(2)) for (int rep_ = 0; rep_ < NREP(2); ++rep_) {
    LOAD_PTRS();
    { FRESH_TID(tidb); build_btab(lds, P.rel_bias, tidb); }
#pragma unroll 1
    for (int i = 0; ; ++i) { int b, qt;
      if (G == 256) { if (i >= 4) break; const int c = vcu & 31; b = 2 * (vcu >> 5) + (i >> 1); qt = (i & 1) ? c : 63 - c; }
      else { const int u = vcu + i * G; if (u >= 1024) break; b = u >> 6; qt = 63 - (u & 63); }
      dsa_unit(lds, P, b, qt, wave); }
    __syncthreads();
  }
  SEAM(2);
  if (IN(3)) for (int rep_ = 0; rep_ < NREP(3); ++rep_) {
    LOAD_PTRS();
    pg8::Gemm g{P.OG, P.WtOA, MTOK, 1024, 1024}; pg8::StaticOrder S; S.init(MTOK, 1024, G, bx);
    EpiRes2 E{P.XN, P.SSQ};
    pg8::gemm_phase<EpiRes2, pg8::StaticOrder, true, true>(lds, g, S, E, wave);
    __syncthreads();
  }
  SEAM(3);
  if (IN(4)) { LOAD_PTRS(); FRESH_TID(tidr);
    if (G == 256) { if (tidr < 128) { const int r = 4096 * (bx & 7) + 128 * (bx >> 3) + tidr; P.RINV[r] = row_rinv(P.SSQ, r); } }
    else for (int r = bx * 512 + tidr; r < MTOK; r += G * 512) P.RINV[r] = row_rinv(P.SSQ, r); }
  SEAM(4);
  if (IN(5)) for (int rep_ = 0; rep_ < NREP(5); ++rep_) {
    LOAD_PTRS();
    pg8::Gemm g{P.XN, P.WtB, MTOK, NCOL_B, 1024}; pg8::StaticOrder S; S.init(MTOK, NCOL_B, G, bx);
    EpiB E{P.Q, P.KV, P.SG, P.qn_b_g, P.kn_b_g, P.RINV, P.KM};
    pg8::gemm_phase<EpiB, pg8::StaticOrder, true, true>(lds, g, S, E, wave);
    __syncthreads();
  }
  SEAM(5);
  if (IN(7)) for (int rep_ = 0; rep_ < NREP(7); ++rep_) {
    LOAD_PTRS();
    { FRESH_TID(tidb); build_btab(lds, P.rel_bias, tidb); }
#pragma unroll 1
    for (int i = 0; ; ++i) { int b, qt;
      if (G == 256) { if (i >= 4) break; const int c = vcu & 31; b = 2 * (vcu >> 5) + (i >> 1); qt = (i & 1) ? c : 63 - c; }
      else { const int u = vcu + i * G; if (u >= 1024) break; b = u >> 6; qt = 63 - (u & 63); }
      moba_unit(lds, P, b, qt, wave); }
    __syncthreads();
  }
  SEAM(7);
  if (IN(8)) for (int rep_ = 0; rep_ < NREP(8); ++rep_) {
    LOAD_PTRS();
    pg8::Gemm g{P.OG, P.WtOB, MTOK, 1024, 1024}; pg8::StaticOrder S; S.init(MTOK, 1024, G, bx);
    EpiRes E{P.XN, P.out, lds + L_EPI};
    pg8::gemm_phase<EpiRes, pg8::StaticOrder, true, true>(lds, g, S, E, wave);
  }
#undef IN
#undef SEAM
}

extern "C" void kernel_launch(void* const* d_in, const int* in_sizes, int n_in, void* d_out, int out_size, void* d_ws, size_t ws_size, hipStream_t stream) {
  static int grid = 0;
  if (grid == 0) {
    if (n_in != 14 || out_size != MTOK * DM || ws_size < WS_END) { fprintf(stderr, "kernel_launch: unexpected problem (n_in %d, out %d, ws %zu)\n", n_in, out_size, ws_size); grid = -1; return; }
    int dev = 0, cus = 0, per_cu = 0;
    if (hipGetDevice(&dev) != hipSuccess || hipDeviceGetAttribute(&cus, hipDeviceAttributeMultiprocessorCount, dev) != hipSuccess) { grid = -1; return; }
    if (hipFuncSetAttribute((const void*)fwd, hipFuncAttributeMaxDynamicSharedMemorySize, LDS_BYTES) != hipSuccess) { fprintf(stderr, "kernel_launch: hipFuncSetAttribute failed\n"); grid = -1; return; }
    if (hipOccupancyMaxActiveBlocksPerMultiprocessor(&per_cu, (const void*)fwd, 512, LDS_BYTES) != hipSuccess || per_cu < 1) { fprintf(stderr, "kernel_launch: occupancy query says %d\n", per_cu); per_cu = 1; }
    (void)hipGetLastError();
    grid = cus;
  }
  if (grid < 0) return;
  Args a{};
  for (int i = 0; i < 14; ++i) a.in[i] = (const float*)d_in[i];
  a.out = (float*)d_out; a.ws = (unsigned char*)d_ws;
#if MK_N_LAUNCHES == 1
  if (hipMemsetAsync(d_ws, 0, 16384 * 9, stream) != hipSuccess) { fprintf(stderr, "kernel_launch: memset of the barrier words failed\n"); return; }
  a.ph_lo = 0; a.ph_hi = NPHASE;
  void* kargs[] = {&a};
  hipError_t e = hipLaunchCooperativeKernel((const void*)fwd, dim3(grid), dim3(512), kargs, LDS_BYTES, stream);
  if (e != hipSuccess) fprintf(stderr, "kernel_launch: cooperative launch failed: %s\n", hipGetErrorString(e));
#else
#ifndef HOST_REP_MASK
#define HOST_REP_MASK 0
#endif
  for (int p = 0; p < NPHASE; ++p) { a.ph_lo = p; a.ph_hi = p + 1; for (int r = 0; r < (((HOST_REP_MASK >> p) & 1) ? 2 : 1); ++r) hipLaunchKernelGGL(fwd, dim3(grid), dim3(512), LDS_BYTES, stream, a); }
#endif
}
```

```cpp
#include <hip/hip_runtime.h>
#include <hip/hip_cooperative_groups.h>
#include <cstdio>
#include <cstdint>
__device__ __forceinline__ int lane_id_hw() { unsigned z = 0u; asm volatile("" : "+v"(z)); return (int)__builtin_amdgcn_mbcnt_hi(~0u, __builtin_amdgcn_mbcnt_lo(~0u, z)); }
namespace pg8 {
#define PG8_LAS __attribute__((address_space(3)))
typedef unsigned short bf16_t;
typedef short bf16x8 __attribute__((ext_vector_type(8)));
typedef float f32x4 __attribute__((ext_vector_type(4)));
typedef unsigned u32x4 __attribute__((ext_vector_type(4)));
constexpr int BM = 256, BK = 64, HALF = 128, HTB = HALF * BK * 2  , STAGE_BYTES = 8 * HTB, NXCD = 8, WGM = 8;

__host__ __device__ __forceinline__ int lds_byte(int r, int c) { const int st = (r >> 4) * 2 + (c >> 5), rr = r & 15, cc = c & 31, ob = rr * 64 + cc * 2; return st * 1024 + (ob ^ (((ob >> 9) & 1) << 5)); }
__host__ __device__ __forceinline__ void stage_rc(int b, int& R, int& C) { const int st = b / 1024, sb = b % 1024, swz = sb ^ (((sb >> 9) & 1) << 5); R = (st >> 1) * 16 + swz / 64; C = (st & 1) * 32 + (swz % 64) / 2; }
__host__ __device__ __forceinline__ int perm32(int rho) { const int n = rho >> 4, i = rho & 15; return 8 * (i >> 2) + 4 * n + (i & 3); }

struct Unit { int pm, pn; };
struct Gemm { const bf16_t* A; const bf16_t* Bt; int M, N, K; };

struct StaticOrder {
    int nM, nN, nwg, G, c;
    __host__ __device__ void init(int M, int N, int G_, int c_) { nM = M / BM; nN = N / BM; nwg = nM * nN; G = G_; c = c_; }
    __host__ __device__ bool next(int i, Unit& u) const {
        const long L = (long)i * G + c; if (L >= nwg) return false;
        int wgid = (int)L; { const int q = nwg / NXCD, r = nwg % NXCD, xcd = wgid % NXCD, off = wgid / NXCD; wgid = (xcd < r ? xcd * (q + 1) : r * (q + 1) + (xcd - r) * q) + off; }
        const int nig = WGM * nN, gid = wgid / nig, fm = gid * WGM, gsz = (nM - fm) < WGM ? (nM - fm) : WGM;
        u.pm = fm + ((wgid % nig) % gsz); u.pn = (wgid % nig) / gsz; return true;
    }
    __device__ __forceinline__ void a_ready(const Unit&) const {}
    __device__ __forceinline__ void done(const Unit&) const {}
};

template <class Epi, class Sched, bool ALIGN_EPI = false, bool SP2 = false>
__device__ __forceinline__ void gemm_phase(PG8_LAS unsigned char* lds, const Gemm g, const Sched& S, const Epi& E, int wave_) {
    const int tid = wave_ * 64 + lane_id_hw(), wid = __builtin_amdgcn_readfirstlane(tid >> 6), lane = tid & 63, wr = wid >> 2, wc = wid & 3, fr = lane & 15, fq = lane >> 4;
    const int K = g.K, nt = K / BK;
    unsigned voffA[2], voffB[2];
#pragma unroll
    for (int i = 0; i < 2; ++i) { int R, C; stage_rc(tid * 16 + i * 8192, R, C); const int Rb = Epi::PERM ? ((R & ~31) + perm32(R & 31)) : R;
        voffA[i] = (unsigned)(R * K + C) * 2u; voffB[i] = (unsigned)(Rb * K + C) * 2u; }
    const size_t kstep = (size_t)(BK * 2);
    const size_t hstep = (size_t)HALF * K * 2;
    const size_t tstep = 2 * hstep;
    const unsigned ldsw = (unsigned)wid * 1024u;
    const int aoff = lds_byte(wr * 64 + fr, fq * 8), boff = lds_byte(wc * 32 + fr, fq * 8);
#define PG8_SA(b, h) (((b) * 2 + (h)) * HTB)
#define PG8_SB(b, h) ((4 + (b) * 2 + (h)) * HTB)
#define PG8_STAGE(bufoff, gbase, voff) do { _Pragma("unroll") for (int _i = 0; _i < 2; ++_i) \
        __builtin_amdgcn_global_load_lds((const unsigned*)((const char*)(gbase) + (voff)[_i]), (PG8_LAS unsigned*)(lds + (bufoff) + ldsw + _i * 8192), 16, 0, 0); } while (0)
#define PG8_LDA(dst, b, h) do { _Pragma("unroll") for (int m = 0; m < 4; ++m) _Pragma("unroll") for (int k = 0; k < 2; ++k) dst[m][k] = *(const PG8_LAS bf16x8*)(lds + PG8_SA(b, h) + aoff + m * 2048 + k * 1024); } while (0)
#define PG8_LDB(dst, b, h) do { _Pragma("unroll") for (int n = 0; n < 2; ++n) _Pragma("unroll") for (int k = 0; k < 2; ++k) dst[n][k] = *(const PG8_LAS bf16x8*)(lds + PG8_SB(b, h) + boff + n * 2048 + k * 1024); } while (0)
#define PG8_MMA(ai, bj, At, Bt) do { __builtin_amdgcn_s_setprio(1); _Pragma("unroll") for (int m = 0; m < 4; ++m) _Pragma("unroll") for (int n = 0; n < 2; ++n) _Pragma("unroll") for (int k = 0; k < 2; ++k) \
        acc[ai][bj][m][n] = __builtin_amdgcn_mfma_f32_16x16x32_bf16(Bt[n][k], At[m][k], acc[ai][bj][m][n], 0, 0, 0); __builtin_amdgcn_s_setprio(0); } while (0)
#define PG8_WAIT_V(n) asm volatile("s_waitcnt vmcnt(" #n ")" ::: "memory")
#define PG8_WAIT_L(n) asm volatile("s_waitcnt lgkmcnt(" #n ")" ::: "memory")
#define PG8_BAR __builtin_amdgcn_s_barrier()
#define PG8_SCHED __builtin_amdgcn_sched_barrier(0)
    Unit cur, nxt; int ui = 0;
    if (!S.next(0, cur)) return;
    f32x4 acc[2][2][4][2];
#pragma unroll
    for (int a = 0; a < 2; ++a)
#pragma unroll
        for (int b = 0; b < 2; ++b)
#pragma unroll
            for (int m = 0; m < 4; ++m)
#pragma unroll
                for (int n = 0; n < 2; ++n) acc[a][b][m][n] = (f32x4){0.f, 0.f, 0.f, 0.f};
    bf16x8 At[4][2], B0[2][2], B1[2][2];
    const char* cA = (const char*)g.A + (size_t)cur.pm * tstep; const char* cB = (const char*)g.Bt + (size_t)cur.pn * tstep;
    S.a_ready(cur);
    if constexpr (SP2) {
        PG8_STAGE(PG8_SB(0, 0), cB, voffB); PG8_STAGE(PG8_SB(0, 1), cB + hstep, voffB); PG8_STAGE(PG8_SA(0, 0), cA, voffA); PG8_STAGE(PG8_SA(0, 1), cA + hstep, voffA);
        if (wr == 1) PG8_BAR;
        PG8_WAIT_V(2); PG8_BAR;
        PG8_STAGE(PG8_SB(1, 0), cB + kstep, voffB); PG8_STAGE(PG8_SA(1, 0), cA + kstep, voffA); PG8_STAGE(PG8_SB(1, 1), cB + hstep + kstep, voffB);
        PG8_WAIT_V(6); PG8_BAR;
    } else {
        PG8_STAGE(PG8_SB(0, 0), cB, voffB); PG8_STAGE(PG8_SA(0, 0), cA, voffA); PG8_STAGE(PG8_SB(0, 1), cB + hstep, voffB); PG8_STAGE(PG8_SA(0, 1), cA + hstep, voffA);
        if (wr == 1) PG8_BAR;
        PG8_WAIT_V(4); PG8_BAR;
        PG8_STAGE(PG8_SB(1, 0), cB + kstep, voffB); PG8_STAGE(PG8_SA(1, 0), cA + kstep, voffA); PG8_STAGE(PG8_SB(1, 1), cB + hstep + kstep, voffB);
        PG8_WAIT_V(6); PG8_BAR;
    }
    for (;;) {
        const bool has_next = S.next(ui + 1, nxt);
        const char* nA = has_next ? (const char*)g.A + (size_t)nxt.pm * tstep : cA; const char* nB = has_next ? (const char*)g.Bt + (size_t)nxt.pn * tstep : cB;
        for (int t = 0; t < nt; t += 2) {
            const bool last = (t == nt - 2);
            const char* a1 = cA + (size_t)(t + 1) * kstep;
            const char* a2 = last ? nA : cA + (size_t)(t + 2) * kstep; const char* b2 = last ? nB : cB + (size_t)(t + 2) * kstep;
            const char* a3 = a2 + kstep; const char* b3 = b2 + kstep;
            if (last && has_next) S.a_ready(nxt);
            if constexpr (SP2) {
            PG8_LDB(B0, 0, 0); PG8_LDB(B1, 0, 1); PG8_SCHED; PG8_LDA(At, 0, 0); PG8_STAGE(PG8_SA(1, 1), a1 + hstep, voffA);
            PG8_WAIT_V(8); PG8_WAIT_L(0); PG8_BAR; PG8_MMA(0, 0, At, B0); PG8_MMA(0, 1, At, B1); PG8_BAR; PG8_SCHED;
            PG8_LDA(At, 0, 1); PG8_STAGE(PG8_SB(0, 0), b2, voffB); PG8_STAGE(PG8_SB(0, 1), b2 + hstep, voffB); PG8_STAGE(PG8_SA(0, 0), a2, voffA);
            PG8_WAIT_V(8); PG8_WAIT_L(0); PG8_BAR; PG8_MMA(1, 0, At, B0); PG8_MMA(1, 1, At, B1); PG8_BAR; PG8_SCHED;
            PG8_LDB(B0, 1, 0); PG8_LDB(B1, 1, 1); PG8_SCHED; PG8_LDA(At, 1, 0); PG8_STAGE(PG8_SA(0, 1), a2 + hstep, voffA);
            PG8_WAIT_V(8); PG8_WAIT_L(0); PG8_BAR; PG8_MMA(0, 0, At, B0); PG8_MMA(0, 1, At, B1); PG8_BAR; PG8_SCHED;
            PG8_LDA(At, 1, 1); PG8_STAGE(PG8_SB(1, 0), b3, voffB); PG8_STAGE(PG8_SB(1, 1), b3 + hstep, voffB); PG8_STAGE(PG8_SA(1, 0), a3, voffA);
            PG8_WAIT_V(8); PG8_WAIT_L(0); PG8_BAR; PG8_MMA(1, 0, At, B0); PG8_MMA(1, 1, At, B1); PG8_BAR; PG8_SCHED;
            } else {
            PG8_LDB(B0, 0, 0); PG8_SCHED; PG8_LDA(At, 0, 0); PG8_STAGE(PG8_SA(1, 1), a1 + hstep, voffA);
            PG8_WAIT_L(8); PG8_BAR; PG8_WAIT_L(0); PG8_MMA(0, 0, At, B0); PG8_BAR; PG8_SCHED;
            PG8_LDB(B1, 0, 1); PG8_STAGE(PG8_SB(0, 0), b2, voffB);
            PG8_BAR; PG8_WAIT_L(0); PG8_MMA(0, 1, At, B1); PG8_BAR;
            PG8_LDA(At, 0, 1); PG8_STAGE(PG8_SA(0, 0), a2, voffA);
            PG8_BAR; PG8_WAIT_L(0); PG8_MMA(1, 0, At, B0); PG8_BAR; PG8_SCHED;
            PG8_STAGE(PG8_SB(0, 1), b2 + hstep, voffB);
            PG8_WAIT_V(6); PG8_BAR; PG8_MMA(1, 1, At, B1); PG8_BAR;
            PG8_LDB(B0, 1, 0); PG8_SCHED; PG8_LDA(At, 1, 0); PG8_STAGE(PG8_SA(0, 1), a2 + hstep, voffA);
            PG8_WAIT_L(8); PG8_BAR; PG8_WAIT_L(0); PG8_MMA(0, 0, At, B0); PG8_BAR; PG8_SCHED;
            PG8_LDB(B1, 1, 1); PG8_STAGE(PG8_SB(1, 0), b3, voffB);
            PG8_BAR; PG8_WAIT_L(0); PG8_MMA(0, 1, At, B1); PG8_BAR;
            PG8_LDA(At, 1, 1); PG8_STAGE(PG8_SA(1, 0), a3, voffA);
            PG8_BAR; PG8_WAIT_L(0); PG8_MMA(1, 0, At, B0); PG8_BAR; PG8_SCHED;
            PG8_STAGE(PG8_SB(1, 1), b3 + hstep, voffB);
            PG8_WAIT_V(6); PG8_BAR; PG8_MMA(1, 1, At, B1); PG8_BAR;
            }
        }
        if constexpr (ALIGN_EPI) { if (wr == 0) PG8_BAR; }
        if constexpr (!Epi::AFTER_DRAIN) { E(acc, cur, wr, wc, fr, fq); S.done(cur); }
        if (!has_next) break;
#pragma unroll
        for (int a = 0; a < 2; ++a)
#pragma unroll
            for (int b = 0; b < 2; ++b)
#pragma unroll
                for (int m = 0; m < 4; ++m)
#pragma unroll
                    for (int n = 0; n < 2; ++n) acc[a][b][m][n] = (f32x4){0.f, 0.f, 0.f, 0.f};
        cur = nxt; cA = nA; cB = nB; ++ui;
        if constexpr (ALIGN_EPI) { if (wr == 1) PG8_BAR; }
    }
    PG8_WAIT_V(0);
    if constexpr (!ALIGN_EPI) { if (wr == 0) PG8_BAR; }
    PG8_BAR;
    if constexpr (Epi::AFTER_DRAIN) { E.fused(acc, cur, wr, wc, fr, fq, lds, wid, lane); S.done(cur); }
#undef PG8_SA
#undef PG8_SB
#undef PG8_STAGE
#undef PG8_LDA
#undef PG8_LDB
#undef PG8_MMA
#undef PG8_WAIT_V
#undef PG8_WAIT_L
#undef PG8_BAR
#undef PG8_SCHED
}
}

#ifndef MK_N_LAUNCHES
#define MK_N_LAUNCHES 1
#endif
namespace cg = cooperative_groups;
#define DI __device__ __forceinline__
#define LAS __attribute__((address_space(3)))
typedef unsigned short bf16;
typedef short bf16x8 __attribute__((ext_vector_type(8)));
typedef float f32x4 __attribute__((ext_vector_type(4)));
typedef float f32x16 __attribute__((ext_vector_type(16)));
typedef unsigned u32x4 __attribute__((ext_vector_type(4)));
typedef unsigned u32x2 __attribute__((ext_vector_type(2)));
typedef float f32x2_t __attribute__((ext_vector_type(2)));
typedef __bf16 bf16x2_t __attribute__((ext_vector_type(2)));
typedef short s16x2 __attribute__((ext_vector_type(2)));
typedef unsigned short u16x2 __attribute__((ext_vector_type(2)));

constexpr int SEQ = 2048, DM = 1024, NBATCH = 16, MTOK = NBATCH * SEQ;
constexpr int NCOL_A = 3328, NCOL_B = 2560;
constexpr float EPS = 1e-6f;
constexpr float LOG2E = 1.4426950408889634f;
constexpr float C2 = 0.125f * LOG2E;
constexpr int NPHASE = 9;

constexpr size_t MiB = 1u << 20;
constexpr size_t WS_WA = 1 * MiB, WS_WOA = 8 * MiB, WS_WB = 10 * MiB, WS_WOB = 15 * MiB, WS_KM = 17 * MiB, WS_IW = 18 * MiB, WS_IK = 19 * MiB;
constexpr size_t WS_XN = 24 * MiB, WS_Q = 88 * MiB, WS_K = 152 * MiB, WS_VT = 168 * MiB, WS_SG = 184 * MiB, WS_IQ = 248 * MiB, WS_OG = 280 * MiB, WS_H1 = 344 * MiB, WS_END = 472 * MiB;

constexpr int LDS_BYTES = 153600;
constexpr int IQ_STRIDE = 1040;
constexpr int L_IQ = 0, L_HIST = 33280, L_SEL = 131072, L_MASK = L_SEL + 512, L_BTAB = L_MASK + 8192, L_SELM = L_BTAB + 12288, L_BLK = L_SELM + 128, L_END = L_BLK + 16;
static_assert(L_HIST + 32 * 257 * 4 + 256 <= L_SEL, "selection scratch inside the ring");
constexpr int L_EPI = 131072;
static_assert(L_EPI + 8 * 2304 <= 152320, "epilogue staging");
constexpr int L_MISC = 152320;
static_assert(L_END <= L_MISC && L_MISC + 64 + 128 <= LDS_BYTES && LDS_BYTES <= 163840, "LDS map");

__device__ const unsigned char BKT[128] = {
  0, 1, 2, 3, 4, 5, 6, 7, 8, 9, 10, 11, 12, 13, 14, 15, 16, 16, 16, 17, 17, 18, 18, 18, 19, 19, 19, 20, 20, 20, 20, 21,
  21, 21, 21, 22, 22, 22, 22, 22, 23, 23, 23, 23, 23, 23, 24, 24, 24, 24, 24, 24, 25, 25, 25, 25, 25, 25, 25, 26, 26, 26, 26, 26,
  26, 26, 26, 27, 27, 27, 27, 27, 27, 27, 27, 27, 27, 28, 28, 28, 28, 28, 28, 28, 28, 28, 28, 29, 29, 29, 29, 29, 29, 29, 29, 29,
  29, 29, 29, 30, 30, 30, 30, 30, 30, 30, 30, 30, 30, 30, 30, 30, 30, 31, 31, 31, 31, 31, 31, 31, 31, 31, 31, 31, 31, 31, 31, 31};

struct Args { const float* in[14]; float* out; unsigned char* ws; int ph_lo, ph_hi; };

struct Ptrs {
  const float *x, *norm_a_g, *w_in_a, *qn_a_g, *kn_a_g, *w_out_a, *rel_bias, *norm_kv_g, *w_kv, *kn_b_g, *norm_b_g, *w_in_b, *qn_b_g, *w_out_b;
  float* out;
  bf16 *WtA, *WtOA, *WtB, *WtOB, *XN, *Q, *KV, *SG, *IQ, *IK, *OG;
  float *IW, *KM, *RINV, *SSQ;
};

DI unsigned cvtpk(float lo, float hi) { f32x2_t v = {lo, hi}; bf16x2_t b = __builtin_convertvector(v, bf16x2_t); return __builtin_bit_cast(unsigned, b); }
DI float bflo(unsigned u) { return __uint_as_float(u << 16); }
DI float bfhi(unsigned u) { return __uint_as_float(u & 0xffff0000u); }
DI float wave_sum(float v) {
#pragma unroll
  for (int o = 1; o < 64; o <<= 1) v += __shfl_xor(v, o);
  return v;
}
DI float silu_f(float v) { return v * __builtin_amdgcn_rcpf(1.0f + __expf(-v)); }
#define MFMA32(a, b, c) __builtin_amdgcn_mfma_f32_32x32x16_bf16((a), (b), (c), 0, 0, 0)

#define XB_TMO      128
#define XB_XCNT(j)  (256  + 64 * (j))
#define XB_XSUB(j)  (1280 + 64 * (j))
#define XB_XGEN(j)  (2304 + 64 * (j))
#define XB_TOP      3328
#define XB_TOPGEN   3392
#define XCD_BAR_WORDS 3456
#define XB_SPIN_CAP (1u << 18)

__device__ __forceinline__ unsigned xb_ld(unsigned* p)              { return __hip_atomic_load(p, __ATOMIC_RELAXED, __HIP_MEMORY_SCOPE_AGENT); }
__device__ __forceinline__ unsigned xb_add(unsigned* p, unsigned v) { return __hip_atomic_fetch_add(p, v, __ATOMIC_RELAXED, __HIP_MEMORY_SCOPE_AGENT); }
__device__ __forceinline__ unsigned xb_xcc_id() { return (unsigned)__builtin_amdgcn_s_getreg((3 << 11) | 20) & 0xFu; }
#define XB_SPIN(cond, bar) do { unsigned _sp = 0; while (cond) { __builtin_amdgcn_s_sleep(1); \
    if ((++_sp & 255u) == 0u) { if (xb_ld(&(bar)[XB_TMO])) break; if (_sp > XB_SPIN_CAP) { atomicAdd(&(bar)[XB_TMO], 1u); break; } } } } while (0)

struct XcdBarrier {
    unsigned* bar; unsigned x; unsigned total;
    volatile LAS unsigned* st;
};

__device__ __forceinline__ XcdBarrier xcd_barrier_post(unsigned* bar, volatile LAS unsigned* st, bool lead_, unsigned total_) {
    XcdBarrier b; b.bar = bar; b.x = xb_xcc_id(); b.st = st; b.total = total_;
    if (lead_) (void)xb_add(&bar[XB_XCNT(b.x)], 1u);
    return b;
}
__device__ __forceinline__ void xcd_barrier_complete(unsigned* bar, unsigned x, unsigned& nloc, unsigned& nx, unsigned G) {
    unsigned sum, cnt, mine, sp = 0u;
    for (;;) {
        sum = 0u; cnt = 0u; mine = 0u;
#pragma unroll
        for (unsigned j = 0; j < 16; ++j) { const unsigned c = xb_ld(&bar[XB_XCNT(j)]); sum += c; cnt += (c > 0u) ? 1u : 0u; mine = (j == x) ? c : mine; }
        if (sum == G) break;
        __builtin_amdgcn_s_sleep(1);
        if ((++sp & 255u) == 0u) { if (xb_ld(&bar[XB_TMO])) break; if (sp > XB_SPIN_CAP) { atomicAdd(&bar[XB_TMO], 1u); break; } }
    }
    nloc = mine > 0u ? mine : 1u; nx = cnt > 0u ? cnt : 1u;
}

__device__ __forceinline__ void xcd_barrier(const XcdBarrier& b, bool lead_) {
    asm volatile("s_waitcnt vmcnt(0)" ::: "memory");
    __syncthreads();
    if (lead_) {
        unsigned* bar = b.bar;
        __builtin_amdgcn_s_waitcnt(0);
        unsigned nloc = b.st[0], nx = b.st[1];
        if (nloc == 0u) { xcd_barrier_complete(bar, b.x, nloc, nx, b.total); b.st[0] = nloc; b.st[1] = nx; }
        const unsigned old = xb_add(&bar[XB_XSUB(b.x)], 1u);
        const unsigned gen = old / nloc;
        if (old + 1u == (gen + 1u) * nloc) {
            __builtin_amdgcn_fence(__ATOMIC_RELEASE, "agent");
            asm volatile("s_waitcnt vmcnt(0)" ::: "memory");
            if (nx > 1u) {
            const unsigned og = xb_add(&bar[XB_TOP], 1u);
            const unsigned tg = og / nx;
            if (og + 1u == (tg + 1u) * nx) xb_add(&bar[XB_TOPGEN], 1u);
            else XB_SPIN(xb_ld(&bar[XB_TOPGEN]) == tg, bar);
            }
            if (nx == 1u) (void)__hip_atomic_fetch_add(&bar[XB_XGEN(b.x)], 1u, __ATOMIC_RELAXED, __HIP_MEMORY_SCOPE_AGENT);
            __builtin_amdgcn_fence(__ATOMIC_ACQUIRE, "agent");
            if (nx > 1u) xb_add(&bar[XB_XGEN(b.x)], 1u);
            asm volatile("s_waitcnt vmcnt(0)" ::: "memory");
        } else {
            XB_SPIN(xb_ld(&bar[XB_XGEN(b.x)]) == gen, bar);
            __builtin_amdgcn_fence(__ATOMIC_ACQUIRE, "agent");
            asm volatile("s_waitcnt vmcnt(0)" ::: "memory");
        }
    }
    __syncthreads();
}

DI int slot_of(int gc) { const int u = gc & 255; return (gc & ~255) + 128 * ((u >> 5) & 1) + 32 * (u >> 6) + 16 * ((u >> 2) & 1) + 4 * ((u >> 3) & 3) + (u & 3); }

typedef pg8::f32x4 accq;
DI int pi32(int r) { return (r & ~12) | ((r & 4) << 1) | ((r & 8) >> 1); }
DI size_t kv_tile_elem(int row) { return (size_t)(row >> 5) * 16384; }
DI bf16* k_piece(bf16* KV, int row, int g, int bj, int fq) {
  return KV + kv_tile_elem(row) + (size_t)(((g * 4 + 2 * bj + (fq >> 1)) * 64 + (fq & 1) * 32 + pi32(row & 31)) * 8);
}
struct OrderR : pg8::StaticOrder {
  const float* rv; unsigned ldsb; int wv; mutable int k;
  DI void a_ready(const pg8::Unit& u) const {
    if (wv == 0) { const float* src = rv + (size_t)u.pm * 256 + lane_id_hw() * 4; unsigned keep; const unsigned dst = (unsigned)__builtin_amdgcn_readfirstlane((int)(ldsb + (unsigned)(k & 1) * 1024u));
      asm volatile("s_mov_b32 %0, m0\n\ts_mov_b32 m0, %2\n\ts_nop 0\n\tglobal_load_lds_dwordx4 %1, off\n\ts_mov_b32 m0, %0\n\ts_nop 0" : "=&s"(keep) : "v"(src), "s"(dst) : "memory"); }
    ++k;
  }
};
DI void load_gain(float (&gv)[2][2][4], const float* g, int fq, float sc) {
#pragma unroll
  for (int bj = 0; bj < 2; ++bj)
#pragma unroll
    for (int n = 0; n < 2; ++n)
#pragma unroll
      for (int e = 0; e < 4; ++e) gv[bj][n][e] = g[32 * bj + 8 * fq + 4 * n + e] * sc;
}
template <int ACT  > DI void plain_store(const accq (&acc)[2][2][4][2], int ai, int m, float sc, bf16* dst) {
#pragma unroll
  for (int bj = 0; bj < 2; ++bj) {
    float v[8];
#pragma unroll
    for (int n = 0; n < 2; ++n)
#pragma unroll
      for (int e = 0; e < 4; ++e) { float t = acc[ai][bj][m][n][e] * sc; if (ACT == 1) t = silu_f(t); v[4 * n + e] = t; }
    u32x4 w; w.x = cvtpk(v[0], v[1]); w.y = cvtpk(v[2], v[3]); w.z = cvtpk(v[4], v[5]); w.w = cvtpk(v[6], v[7]);
    *(u32x4*)(dst + 32 * bj) = w;
  }
}
DI void v_store_scaled(const accq (&acc)[2][2][4][2], int ai, int m, bf16* KV, int row, int g, int fq, float sc) {
  const int i = row & 31;
  bf16* base = KV + kv_tile_elem(row) + (size_t)((16 + g * 4 + (i >> 4)) * 512 + ((i >> 3) & 1) * 256 + (i & 7));
#pragma unroll
  for (int bj = 0; bj < 2; ++bj)
#pragma unroll
    for (int n = 0; n < 2; ++n)
#pragma unroll
      for (int e = 0; e < 4; e += 2) {
        const unsigned pk = cvtpk(acc[ai][bj][m][n][e] * sc, acc[ai][bj][m][n][e + 1] * sc);
        const int r = 8 * fq + 4 * n + e;
        base[bj * 1024 + r * 8] = (bf16)(pk & 0xffffu); base[bj * 1024 + (r + 1) * 8] = (bf16)(pk >> 16);
      }
}

struct EpiA {
  static constexpr bool PERM = false, AFTER_DRAIN = false;
  bf16 *Q, *KV, *SG, *IQ, *IK; float* IW; const float *qn_g, *kn_g; const LAS float* rl; mutable int k;
  DI void operator()(const accq (&acc)[2][2][4][2], const pg8::Unit& u, int wr, int wc, int fr, int fq) const {
    const int pn = u.pn, row0 = u.pm * 256 + wr * 64 + fr; const LAS float* rinv = rl + (k & 1) * 256 - u.pm * 256; ++k;
    if (pn <= 4) {
      float gv[2][2][4]; load_gain(gv, pn < 4 ? qn_g : kn_g, fq, pn < 4 ? C2 : 1.0f);
#pragma unroll
      for (int ai = 0; ai < 2; ++ai)
#pragma unroll
        for (int m = 0; m < 4; ++m) { const int row = row0 + 128 * ai + 16 * m; const float ri = rinv[row];
          float v[2][2][4]; float ss = 0.f;
#pragma unroll
          for (int bj = 0; bj < 2; ++bj)
#pragma unroll
            for (int n = 0; n < 2; ++n)
#pragma unroll
              for (int e = 0; e < 4; ++e) { v[bj][n][e] = acc[ai][bj][m][n][e] * ri; ss += v[bj][n][e] * v[bj][n][e]; }
          ss += __shfl_xor(ss, 16); ss += __shfl_xor(ss, 32);
          const float rn = rsqrtf(ss * (1.0f / 64.0f) + EPS);
#pragma unroll
          for (int bj = 0; bj < 2; ++bj) {
            u32x4 w; w.x = cvtpk(v[bj][0][0] * rn * gv[bj][0][0], v[bj][0][1] * rn * gv[bj][0][1]); w.y = cvtpk(v[bj][0][2] * rn * gv[bj][0][2], v[bj][0][3] * rn * gv[bj][0][3]);
            w.z = cvtpk(v[bj][1][0] * rn * gv[bj][1][0], v[bj][1][1] * rn * gv[bj][1][1]); w.w = cvtpk(v[bj][1][2] * rn * gv[bj][1][2], v[bj][1][3] * rn * gv[bj][1][3]);
            bf16* dst = pn < 4 ? Q + (size_t)row * 1024 + (4 * pn + wc) * 64 + 8 * fq + 32 * bj : k_piece(KV, row, wc, bj, fq);
            *(u32x4*)dst = w; } }
    } else if (pn == 5) {
#pragma unroll
      for (int ai = 0; ai < 2; ++ai)
#pragma unroll
        for (int m = 0; m < 4; ++m) { const int row = row0 + 128 * ai + 16 * m; v_store_scaled(acc, ai, m, KV, row, wc, fq, rinv[row]); }
    } else if (pn <= 9) {
#pragma unroll
      for (int ai = 0; ai < 2; ++ai)
#pragma unroll
        for (int m = 0; m < 4; ++m) { const int row = row0 + 128 * ai + 16 * m; plain_store<1>(acc, ai, m, rinv[row], SG + (size_t)row * 1024 + 256 * (pn - 6) + 64 * wc + 8 * fq); }
    } else if (pn <= 11) {
#pragma unroll
      for (int ai = 0; ai < 2; ++ai)
#pragma unroll
        for (int m = 0; m < 4; ++m) { const int row = row0 + 128 * ai + 16 * m; plain_store<0>(acc, ai, m, 0.125f * rinv[row], IQ + (size_t)row * 512 + 256 * (pn - 10) + 64 * wc + 8 * fq); }
    } else {
      if (wc == 0) {
#pragma unroll
        for (int ai = 0; ai < 2; ++ai)
#pragma unroll
          for (int m = 0; m < 4; ++m) { const int row = row0 + 128 * ai + 16 * m; const float sc = rinv[row];
#pragma unroll
            for (int bj = 0; bj < 2; ++bj) { u32x4 w; w.x = cvtpk(acc[ai][bj][m][0][0] * sc, acc[ai][bj][m][0][1] * sc); w.y = cvtpk(acc[ai][bj][m][0][2] * sc, acc[ai][bj][m][0][3] * sc);
              w.z = cvtpk(acc[ai][bj][m][1][0] * sc, acc[ai][bj][m][1][1] * sc); w.w = cvtpk(acc[ai][bj][m][1][2] * sc, acc[ai][bj][m][1][3] * sc);
              *(u32x4*)(IK + (size_t)(row >> 5) * 2048 + (size_t)(((2 * bj + (fq >> 1)) * 64 + (fq & 1) * 32 + pi32(row & 31)) * 8)) = w; } }
      } else if (wc == 1 && fq == 0) {
#pragma unroll
        for (int ai = 0; ai < 2; ++ai)
#pragma unroll
          for (int m = 0; m < 4; ++m) { const int row = row0 + 128 * ai + 16 * m; float* d = IW + (size_t)row * 8; const float sc = 0.35355339059327373f * rinv[row];
            *(f32x4*)d = acc[ai][0][m][0] * sc; *(f32x4*)(d + 4) = acc[ai][0][m][1] * sc; }
      }
    }
  }
};
DI float row_rinv(const float* ssq, int row) {
  const f32x4* p = (const f32x4*)(ssq + (size_t)row * 16); const f32x4 a = p[0], b = p[1], c = p[2], d = p[3];
  const float t = (((a.x + a.y) + (a.z + a.w)) + ((b.x + b.y) + (b.z + b.w))) + (((c.x + c.y) + (c.z + c.w)) + ((d.x + d.y) + (d.z + d.w)));
  return rsqrtf(t * (1.0f / 1024.0f) + EPS);
}
struct EpiB {
  static constexpr bool PERM = false, AFTER_DRAIN = false;
  bf16 *Q, *KV, *SG; const float *qn_g, *kn_g; const LAS float* rl; float* KM; mutable int k;
  DI void operator()(const accq (&acc)[2][2][4][2], const pg8::Unit& u, int wr, int wc, int fr, int fq) const {
    const int pn = u.pn, row0 = u.pm * 256 + wr * 64 + fr; const LAS float* rinv2 = rl + (k & 1) * 256 - u.pm * 256; ++k;
    if (pn == 0 || (pn >= 2 && pn <= 5)) {
      float gv[2][2][4]; load_gain(gv, pn == 0 ? kn_g : qn_g, fq, pn == 0 ? 1.0f : C2);
      float cs[2][2][4];
#pragma unroll
      for (int bj = 0; bj < 2; ++bj)
#pragma unroll
        for (int n = 0; n < 2; ++n)
#pragma unroll
          for (int e = 0; e < 4; ++e) cs[bj][n][e] = 0.f;
#pragma unroll
      for (int ai = 0; ai < 2; ++ai)
#pragma unroll
        for (int m = 0; m < 4; ++m) { const int row = row0 + 128 * ai + 16 * m; const float ri = rinv2[row];
          float v[2][2][4]; float ss = 0.f;
#pragma unroll
          for (int bj = 0; bj < 2; ++bj)
#pragma unroll
            for (int n = 0; n < 2; ++n)
#pragma unroll
              for (int e = 0; e < 4; ++e) { v[bj][n][e] = acc[ai][bj][m][n][e] * ri; ss += v[bj][n][e] * v[bj][n][e]; }
          ss += __shfl_xor(ss, 16); ss += __shfl_xor(ss, 32);
          const float rn = rsqrtf(ss * (1.0f / 64.0f) + EPS);
#pragma unroll
          for (int bj = 0; bj < 2; ++bj) {
#pragma unroll
            for (int n = 0; n < 2; ++n)
#pragma unroll
              for (int e = 0; e < 4; ++e) { v[bj][n][e] = v[bj][n][e] * rn * gv[bj][n][e]; cs[bj][n][e] += v[bj][n][e]; }
            u32x4 w; w.x = cvtpk(v[bj][0][0], v[bj][0][1]); w.y = cvtpk(v[bj][0][2], v[bj][0][3]); w.z = cvtpk(v[bj][1][0], v[bj][1][1]); w.w = cvtpk(v[bj][1][2], v[bj][1][3]);
            bf16* dst = pn != 0 ? Q + (size_t)row * 1024 + (4 * (pn - 2) + wc) * 64 + 8 * fq + 32 * bj : k_piece(KV, row, wc, bj, fq);
            *(u32x4*)dst = w; } }
      if (pn == 0) {
        float* km = KM + ((size_t)((u.pm >> 3) * 4 + wc) * 8 + (u.pm & 7)) * 64 + 8 * fq;
#pragma unroll
        for (int bj = 0; bj < 2; ++bj)
#pragma unroll
          for (int n = 0; n < 2; ++n)
#pragma unroll
            for (int e = 0; e < 4; ++e) { float t = cs[bj][n][e]; t += __shfl_xor(t, 1); t += __shfl_xor(t, 2); t += __shfl_xor(t, 4); t += __shfl_xor(t, 8);
              if (fr == 0) atomicAdd(km + 32 * bj + 4 * n + e, t * (1.0f / 256.0f)); }
      }
    } else if (pn == 1) {
#pragma unroll
      for (int ai = 0; ai < 2; ++ai)
#pragma unroll
        for (int m = 0; m < 4; ++m) { const int row = row0 + 128 * ai + 16 * m; const float ri = rinv2[row];
          v_store_scaled(acc, ai, m, KV, row, wc, fq, ri); }
    } else {
#pragma unroll
      for (int ai = 0; ai < 2; ++ai)
#pragma unroll
        for (int m = 0; m < 4; ++m) { const int row = row0 + 128 * ai + 16 * m; plain_store<1>(acc, ai, m, rinv2[row], SG + (size_t)row * 1024 + 256 * (pn - 6) + 64 * wc + 8 * fq); }
    }
  }
};
DI void unpack8(const u32x4 w, float (&f)[8]) { f[0] = bflo(w.x); f[1] = bfhi(w.x); f[2] = bflo(w.y); f[3] = bfhi(w.y); f[4] = bflo(w.z); f[5] = bfhi(w.z); f[6] = bflo(w.w); f[7] = bfhi(w.w); }
struct EpiRes {
  static constexpr bool PERM = false, AFTER_DRAIN = false;
  const bf16* res; float* out; LAS unsigned char* stg0;
  DI void operator()(const accq (&acc)[2][2][4][2], const pg8::Unit& u, int wr, int wc, int fr, int fq) const {
    const int row0 = u.pm * 256 + wr * 64 + fr, col0 = u.pn * 256 + 64 * wc + 8 * fq; LAS unsigned char* stg = stg0 + (wr * 4 + wc) * 2304; const int lane = fq * 16 + fr, r8 = lane >> 3, p8 = lane & 7;
#pragma unroll
    for (int ai = 0; ai < 2; ++ai)
#pragma unroll
      for (int m = 0; m < 4; ++m) { const size_t off = (size_t)(row0 + 128 * ai + 16 * m) * 1024 + col0;
#pragma unroll
        for (int bj = 0; bj < 2; ++bj) { float f[8]; unpack8(*(const u32x4*)(res + off + 32 * bj), f);
          f32x4 o0 = acc[ai][bj][m][0], o1 = acc[ai][bj][m][1];
          o0.x += f[0]; o0.y += f[1]; o0.z += f[2]; o0.w += f[3]; o1.x += f[4]; o1.y += f[5]; o1.z += f[6]; o1.w += f[7];
          *(LAS f32x4*)(stg + fr * 144 + fq * 32) = o0; *(LAS f32x4*)(stg + fr * 144 + fq * 32 + 16) = o1;
          asm volatile("" ::: "memory");
          const f32x4 a = *(const LAS f32x4*)(stg + r8 * 144 + p8 * 16), b = *(const LAS f32x4*)(stg + (r8 + 8) * 144 + p8 * 16);
          float* ob = out + (size_t)(row0 - fr + 128 * ai + 16 * m) * 1024 + u.pn * 256 + 64 * wc + 32 * bj + 4 * p8;
          __builtin_nontemporal_store(a, (f32x4*)(ob + (size_t)r8 * 1024)); __builtin_nontemporal_store(b, (f32x4*)(ob + (size_t)(r8 + 8) * 1024));
          asm volatile("" ::: "memory"); } }
  }
};
struct EpiRes2 {
  static constexpr bool PERM = false, AFTER_DRAIN = false;
  bf16* xh; float* ssq;
  DI void operator()(const accq (&acc)[2][2][4][2], const pg8::Unit& u, int wr, int wc, int fr, int fq) const {
    const int row0 = u.pm * 256 + wr * 64 + fr, col0 = u.pn * 256 + 64 * wc + 8 * fq;
#pragma unroll
    for (int ai = 0; ai < 2; ++ai)
#pragma unroll
      for (int m = 0; m < 4; ++m) { const int row = row0 + 128 * ai + 16 * m; const size_t off = (size_t)row * 1024 + col0; float ss = 0.f;
#pragma unroll
        for (int bj = 0; bj < 2; ++bj) { float f[8]; unpack8(*(const u32x4*)(xh + off + 32 * bj), f);
#pragma unroll
          for (int n = 0; n < 2; ++n)
#pragma unroll
            for (int e = 0; e < 4; ++e) { f[4 * n + e] += acc[ai][bj][m][n][e]; ss += f[4 * n + e] * f[4 * n + e]; }
          u32x4 w; w.x = cvtpk(f[0], f[1]); w.y = cvtpk(f[2], f[3]); w.z = cvtpk(f[4], f[5]); w.w = cvtpk(f[6], f[7]);
          *(u32x4*)(xh + off + 32 * bj) = w; }
        ss += __shfl_xor(ss, 16); ss += __shfl_xor(ss, 32);
        if (fq == 0) ssq[(size_t)row * 16 + u.pn * 4 + wc] = ss; }
  }
};
DI int srccol_A(int gc) { if (gc < 3072) return gc; if (gc < 3136) return 3080 + (gc - 3072); if (gc < 3144) return 3072 + (gc - 3136); return -1; }
DI void trans_item(const float* W, int Ns, const float* gk, bf16* Wt, int item, int nblk, int kindA, LAS float* scr, int lane) {
  const int kb = item / nblk, nb = item % nblk, k0 = 64 * kb, gc0 = 32 * nb;
  const int n = lane & 31, gc = gc0 + n; const int sc = kindA ? srccol_A(gc) : gc;
#pragma unroll 8
  for (int i = 0; i < 32; ++i) { const int kk = 2 * i + (lane >> 5); float v = 0.f; if (sc >= 0) v = __builtin_nontemporal_load(W + (size_t)(k0 + kk) * Ns + sc); if (gk) v *= gk[k0 + kk]; scr[kk * 33 + n] = v; }
  asm volatile("s_waitcnt lgkmcnt(0)" ::: "memory");
  const int c = lane & 7;
#pragma unroll
  for (int j = 0; j < 4; ++j) { const int nn = (lane >> 3) + 8 * j; const LAS float* s = scr + (8 * c) * 33 + nn;
    u32x4 o; o.x = cvtpk(s[0 * 33], s[1 * 33]); o.y = cvtpk(s[2 * 33], s[3 * 33]); o.z = cvtpk(s[4 * 33], s[5 * 33]); o.w = cvtpk(s[6 * 33], s[7 * 33]);
    *(u32x4*)(Wt + (size_t)slot_of(gc0 + nn) * 1024 + k0 + 8 * c) = o; }
  asm volatile("s_waitcnt lgkmcnt(0)" ::: "memory");
}

DI int kidx(int r, int hi) { return 16 * (r >> 3) + 8 * hi + (r & 7); }
DI void k_dma(const char* ksrc  , unsigned voff  , unsigned lds_slot  ) {
  unsigned keep;
  asm volatile("s_waitcnt lgkmcnt(0)\n\ts_mov_b32 %0, m0\n\ts_mov_b32 m0, %3\n\ts_nop 0\n\t"
               "global_load_lds_dwordx4 %1, %2\n\tglobal_load_lds_dwordx4 %1, %2 offset:1024\n\tglobal_load_lds_dwordx4 %1, %2 offset:2048\n\tglobal_load_lds_dwordx4 %1, %2 offset:3072\n\t"
               "s_mov_b32 m0, %0" : "=&s"(keep) : "v"(voff), "s"(ksrc), "s"(lds_slot) : "memory");
}
DI void v_load(bf16x8 (&vf)[4], const char* vsrc  , unsigned voff) {
  asm volatile("global_load_dwordx4 %0, %4, %5\n\tglobal_load_dwordx4 %1, %4, %5 offset:1024\n\tglobal_load_dwordx4 %2, %4, %5 offset:2048\n\tglobal_load_dwordx4 %3, %4, %5 offset:3072"
               : "=&v"(vf[0]), "=&v"(vf[1]), "=&v"(vf[2]), "=&v"(vf[3]) : "v"(voff), "s"(vsrc) : "memory");
}
DI void kv_wait(bf16x8 (&vf)[4]) { asm volatile("s_waitcnt vmcnt(0)" : "+v"(vf[0]), "+v"(vf[1]), "+v"(vf[2]), "+v"(vf[3]) :: "memory"); }
DI void qk_tile(f32x16 (&c)[2], const LAS unsigned char* kslot  , const bf16x8 (&qf)[2][4]) {
  bf16x8 kf[4];
#pragma unroll
  for (int s = 0; s < 4; ++s) kf[s] = *(const LAS bf16x8*)(kslot + s * 1024);
#pragma unroll
  for (int j = 0; j < 2; ++j) {
    f32x16 z;
#pragma unroll
    for (int r = 0; r < 16; ++r) z[r] = 0.f;
    c[j] = MFMA32(kf[0], qf[j][0], z);
#pragma unroll
    for (int s = 1; s < 4; ++s) c[j] = MFMA32(kf[s], qf[j][s], c[j]);
  }
}
DI void add_bias(f32x16 (&c)[2], const LAS float* bt0, int dist0) {
#pragma unroll
  for (int j = 0; j < 2; ++j) { const LAS float* tp = bt0 + j * 192 + (dist0 + 8);
#pragma unroll
    for (int r = 0; r < 16; ++r) c[j][r] += tp[23 - (16 * (r >> 3) + (r & 7))]; }
}
template <int MODE> DI void sm_pv(f32x16 (&O)[2][2], float (&l)[2], const f32x16 (&c)[2], const bf16x8 (&vf4)[4], unsigned m) {
#pragma unroll
  for (int j = 0; j < 2; ++j) {
    float p[16]; float ls = 0.f;
#pragma unroll
    for (int r = 0; r < 16; ++r) {
      const float e = __builtin_amdgcn_exp2f(c[j][r]);
      if (MODE == 0) { const unsigned ext = (unsigned)__builtin_amdgcn_sbfe((int)m, r, 1); p[r] = __uint_as_float(__float_as_uint(e) & ext); }
      else p[r] = e;
      ls += p[r];
    }
    if (MODE == 1) ls = __uint_as_float(__float_as_uint(ls) & m);
    l[j] += ls;
    bf16x8 pk[2];
#pragma unroll
    for (int s = 0; s < 2; ++s) { u32x4 w; w.x = cvtpk(p[8 * s], p[8 * s + 1]); w.y = cvtpk(p[8 * s + 2], p[8 * s + 3]); w.z = cvtpk(p[8 * s + 4], p[8 * s + 5]); w.w = cvtpk(p[8 * s + 6], p[8 * s + 7]);
      if (MODE == 1) { w.x &= m; w.y &= m; w.z &= m; w.w &= m; }
      pk[s] = __builtin_bit_cast(bf16x8, w); }
#pragma unroll
    for (int dt = 0; dt < 2; ++dt)
#pragma unroll
      for (int s = 0; s < 2; ++s) O[j][dt] = MFMA32(vf4[dt * 2 + s], pk[s], O[j][dt]);
  }
}
DI void attn_store(const f32x16 (&O)[2][2], const float (&l)[2], const bf16* SG, bf16* OG, size_t row0, int head0, LAS unsigned char* stg, int lane) {
  const int q = lane & 31, hi = lane >> 5, rr = lane >> 3, pc = lane & 7;
  const size_t goff = (row0 + rr) * 1024 + (size_t)head0 * 64 + 8 * pc;
  u32x4 sg[2][4];
#pragma unroll
  for (int j = 0; j < 2; ++j)
#pragma unroll
    for (int i = 0; i < 4; ++i) sg[j][i] = *(const u32x4*)(SG + goff + (size_t)i * 8192 + j * 64);
  LAS unsigned char* wb = stg + q * 256; const int wt = ((q & 15) ^ hi) << 4;
  const LAS unsigned char* rb = stg + rr * 256; const int rt = ((2 * pc) ^ rr) << 4;
#pragma unroll
  for (int j = 0; j < 2; ++j) {
    const float lt = l[j] + __shfl_xor(l[j], 32); const float inv = 1.0f / lt;
#pragma unroll
    for (int dt = 0; dt < 2; ++dt)
#pragma unroll
      for (int a = 0; a < 4; ++a) {
        f32x4 v; v.x = O[j][dt][4 * a + 0] * inv; v.y = O[j][dt][4 * a + 1] * inv; v.z = O[j][dt][4 * a + 2] * inv; v.w = O[j][dt][4 * a + 3] * inv;
        *(LAS f32x4*)(wb + (wt ^ ((8 * dt + 2 * a) << 4))) = v;
      }
    asm volatile("" ::: "memory");
#pragma unroll
    for (int i = 0; i < 4; ++i) {
      const int x0 = rt ^ ((i & 1) << 7);
      const f32x4 a0 = *(const LAS f32x4*)(rb + i * 2048 + x0), a1 = *(const LAS f32x4*)(rb + i * 2048 + (x0 ^ 16));
      const u32x4 g = sg[j][i]; u32x4 w;
      w.x = cvtpk(a0.x * bflo(g.x), a0.y * bfhi(g.x)); w.y = cvtpk(a0.z * bflo(g.y), a0.w * bfhi(g.y));
      w.z = cvtpk(a1.x * bflo(g.z), a1.y * bfhi(g.z)); w.w = cvtpk(a1.z * bflo(g.w), a1.w * bfhi(g.w));
      *(u32x4*)(OG + goff + (size_t)i * 8192 + j * 64) = w;
    }
    asm volatile("" ::: "memory");
  }
}
DI void build_btab(LAS unsigned char* lds, const float* rel_bias, int tid_) {
  LAS float* bt = (LAS float*)(lds + L_BTAB);
  for (int i = tid_; i < 16 * 192; i += 512) { const int h = i / 192, dist = i % 192 - 31;
    bt[i] = dist < 0 ? -INFINITY : (dist < 128 ? (rel_bias[(int)BKT[dist] * 16 + h] - rel_bias[31 * 16 + h]) * LOG2E : 0.f); }
}
DI unsigned causal16(int q, int hi) { unsigned m = 0;
#pragma unroll
  for (int r = 0; r < 16; ++r) m |= (kidx(r, hi) <= q) ? (1u << r) : 0u;
  return m; }

DI void dsa_unit(LAS unsigned char* lds, const Ptrs& P, int b, int qt, int wave_) {
  int tid = wave_ * 64 + lane_id_hw(); asm volatile("" : "+v"(tid));
  const int lane = tid & 63, w = __builtin_amdgcn_readfirstlane(tid >> 6), q = lane & 31, hi = lane >> 5;
  const int t0 = 32 * qt, nkt = qt + 1; const size_t rowb = (size_t)b * SEQ;
  LAS unsigned short* maskl = (LAS unsigned short*)(lds + L_MASK);
  bf16x8 qf[2][4];
#pragma unroll
  for (int j = 0; j < 2; ++j)
#pragma unroll
    for (int s = 0; s < 4; ++s) qf[j][s] = *(const bf16x8*)(P.Q + (rowb + t0 + q) * 1024 + (2 * w + j) * 64 + 16 * s + 8 * hi);
  __syncthreads();
  if (qt >= 8) {
    const bf16* ikb = P.IK + (size_t)(b * 64) * 2048 + lane * 8;
    bf16x8 ikc[4], ikn[4];
#pragma unroll
    for (int s = 0; s < 4; ++s) ikc[s] = *(const bf16x8*)(ikb + (size_t)w * 2048 + 512 * s);
    LAS float* wl = (LAS float*)(lds + L_HIST);
    { f32x4 wv = {0.f, 0.f, 0.f, 0.f}; if (tid < 64) wv = *(const f32x4*)(P.IW + (rowb + t0) * 8 + tid * 4);
      const int row = tid >> 4, ch = tid & 15; const u32x4* src = (const u32x4*)(P.IQ + (rowb + t0 + row) * 512);
#pragma unroll
      for (int c = 0; c < 4; ++c) *(LAS u32x4*)(lds + L_IQ + row * IQ_STRIDE + (ch + 16 * c) * 16) = __builtin_nontemporal_load(src + ch + 16 * c);
      if (tid < 64) *(LAS f32x4*)(wl + tid * 4) = wv; }
    __syncthreads();
    unsigned pl[4][16];
#pragma unroll
    for (int B = 0; B < 4; ++B) {
#pragma unroll
      for (int h2 = 0; h2 < 2; ++h2) {
        const int kt = w + 8 * (2 * B + h2);
        if (2 * B + h2 < 7) { const int ktn = (kt + 8 < nkt) ? kt + 8 : w;
#pragma unroll
          for (int s = 0; s < 4; ++s) ikn[s] = *(const bf16x8*)(ikb + (size_t)ktn * 2048 + 512 * s); }
        float sc[16];
        if (2 * B + h2 == 0 || kt < nkt) {
#pragma unroll
          for (int s = 0; s < 4; ++s) asm volatile("" : "+v"(ikc[s]));
#pragma unroll
          for (int r = 0; r < 16; ++r) sc[r] = 0.f;
#pragma unroll 2
          for (int hd = 0; hd < 8; ++hd) {
            f32x16 c;
#pragma unroll
            for (int r = 0; r < 16; ++r) c[r] = 0.f;
#pragma unroll
            for (int s = 0; s < 4; ++s) { const bf16x8 bq = *(const LAS bf16x8*)(lds + L_IQ + q * IQ_STRIDE + (hd * 64 + 16 * s + 8 * hi) * 2); c = MFMA32(ikc[s], bq, c); }
            const float wh = wl[q * 8 + hd];
#pragma unroll
            for (int r = 0; r < 16; ++r) { const int ci_ = __builtin_bit_cast(int, (float)c[r]); sc[r] += wh * __builtin_bit_cast(float, ci_ > 0 ? ci_ : 0); asm("" : "+v"(sc[r])); }
          }
          if (kt == qt) {
#pragma unroll
            for (int r = 0; r < 16; ++r) if (kidx(r, hi) > q) sc[r] = -INFINITY;
          }
        } else {
#pragma unroll
          for (int r = 0; r < 16; ++r) sc[r] = -INFINITY;
        }
#pragma unroll
        for (int v = 0; v < 16; ++v) {
          if (h2 == 0) pl[B][v] = __builtin_bit_cast(unsigned, __builtin_amdgcn_cvt_pkrtz(sc[v], 0.f));
          else pl[B][v] |= __builtin_bit_cast(unsigned, __builtin_amdgcn_cvt_pkrtz(0.f, sc[v]));
        }
#pragma unroll
        for (int s = 0; s < 4; ++s) ikc[s] = ikn[s];
      }
#pragma unroll
      for (int v = 0; v < 16; ++v) { const unsigned u = pl[B][v]; pl[B][v] = u ^ (((u >> 15) & 0x00010001u) * 0x7FFFu); }
#define TR_STAGE(J, MJ) _Pragma("unroll") for (int k = 0; k < 16; ++k) if ((k & (J)) == 0) { const unsigned t = ((pl[B][k] >> (J)) ^ pl[B][k + (J)]) & (MJ); pl[B][k + (J)] ^= t; pl[B][k] ^= t << (J); }
      TR_STAGE(8, 0x00FF00FFu) TR_STAGE(4, 0x0F0F0F0Fu) TR_STAGE(2, 0x33333333u) TR_STAGE(1, 0x55555555u)
#undef TR_STAGE
      pl[B][15] = ~pl[B][15];
#pragma unroll
      for (int v = 0; v < 16; ++v) asm volatile("" : "+v"(pl[B][v]));
      __builtin_amdgcn_sched_barrier(0);
    }
    LAS unsigned* cb = (LAS unsigned*)(lds + L_HIST + 32 * 257 * 4);
    if (tid < 64) cb[tid] = 0u;
    __syncthreads();
    unsigned mm[4] = {0xFFFFFFFFu, 0xFFFFFFFFu, 0xFFFFFFFFu, 0xFFFFFFFFu}, gt[4] = {0u, 0u, 0u, 0u}, Gtot = 0u, prev0 = 0u, prev1 = 0u;
#pragma unroll
    for (int bit = 15; bit >= 0; --bit) {
      unsigned t4[4]; unsigned cnt = 0u;
#pragma unroll
      for (int B = 0; B < 4; ++B) { t4[B] = mm[B] & pl[B][bit]; cnt += (unsigned)__builtin_popcount(t4[B]); }
      LAS unsigned* cw = cb + ((bit & 1) ? 32 : 0) + q;
      __hip_atomic_fetch_add(cw, cnt, __ATOMIC_RELAXED, __HIP_MEMORY_SCOPE_WORKGROUP);
      __syncthreads();
      const unsigned run = *cw; unsigned tot;
      if (bit & 1) { tot = run - prev1; prev1 = run; } else { tot = run - prev0; prev0 = run; }
      const bool acc1 = (Gtot + tot) >= 256u;
#pragma unroll
      for (int B = 0; B < 4; ++B) { if (acc1) mm[B] = t4[B]; else { gt[B] |= t4[B]; mm[B] ^= t4[B]; } }
      if (!acc1) Gtot += tot;
    }
    LAS unsigned short* tm = (LAS unsigned short*)(lds + L_HIST + 1024); LAS unsigned short* pf = (LAS unsigned short*)(lds + L_HIST + 1024 + 8192);
#pragma unroll
    for (int B = 0; B < 4; ++B) {
      tm[((w + 8 * (2 * B)) * 32 + q) * 2 + hi] = (unsigned short)(mm[B] & 0xFFFFu);
      tm[((w + 8 * (2 * B + 1)) * 32 + q) * 2 + hi] = (unsigned short)(mm[B] >> 16);
    }
    __syncthreads();
#pragma unroll
    for (int e = 0; e < 4; ++e) {
      const int qq = 4 * w + e;
      const unsigned c = (unsigned)__builtin_popcount(((const LAS unsigned*)tm)[lane * 32 + qq]);
      unsigned incl = c;
#pragma unroll
      for (int o = 1; o < 64; o <<= 1) { const unsigned t = __shfl_up(incl, o); if (lane >= o) incl += t; }
      pf[lane * 32 + qq] = (unsigned short)(incl - c);
    }
    __syncthreads();
    { const unsigned need = 256u - Gtot;
#pragma unroll
      for (int B = 0; B < 4; ++B) {
        unsigned sel = gt[B];
#pragma unroll
        for (int h2 = 0; h2 < 2; ++h2) {
          const unsigned t16 = (mm[B] >> (16 * h2)) & 0xFFFFu;
          if (t16) {
            const int kt = w + 8 * (2 * B + h2);
            const unsigned pair = ((const LAS unsigned*)tm)[kt * 32 + q], base = pf[kt * 32 + q];
            const unsigned c0 = (unsigned)__builtin_popcount(pair & 0xFFu), c1 = (unsigned)__builtin_popcount(pair & 0xFF0000u), c2 = (unsigned)__builtin_popcount(pair & 0xFF00u);
            const unsigned offL = base + (hi ? c0 : 0u), offH = base + (hi ? c0 + c1 + c2 : c0 + c1);
            unsigned rem = t16;
            while (rem) { const int pos = __builtin_ctz(rem); rem &= rem - 1u;
              const unsigned below = (unsigned)__builtin_popcount(t16 & ((1u << pos) - 1u) & (pos >= 8 ? 0xFF00u : 0xFFu));
              if ((pos >= 8 ? offH : offL) + below < need) sel |= 1u << (pos + 16 * h2); }
          }
        }
        if (w + 8 * (2 * B) < nkt) maskl[(w + 8 * (2 * B)) * 64 + lane] = (unsigned short)(sel & 0xFFFFu);
        if (w + 8 * (2 * B + 1) < nkt) maskl[(w + 8 * (2 * B + 1)) * 64 + lane] = (unsigned short)(sel >> 16);
      } }
  } else {
    const unsigned cm = causal16(q, hi);
#pragma unroll
    for (int i = 0; i < 8; ++i) { const int kt = w + 8 * i; if (kt < nkt) maskl[kt * 64 + lane] = (unsigned short)(kt == qt ? cm : 0xFFFFu); }
  }
  __syncthreads();
  const int g = w >> 1;
  const bf16* img = P.KV + (size_t)(b * 64) * 16384;
  const unsigned lds0 = (unsigned)(uintptr_t)lds;
#pragma unroll
  for (int j = 0; j < 2; ++j)
#pragma unroll
    for (int s = 0; s < 4; ++s) asm volatile("" : "+v"(qf[j][s]));
  f32x16 O[2][2]; float l[2] = {0.f, 0.f};
#pragma unroll
  for (int j = 0; j < 2; ++j)
#pragma unroll
    for (int dt = 0; dt < 2; ++dt)
#pragma unroll
      for (int r = 0; r < 16; ++r) O[j][dt][r] = 0.f;
  const LAS float* bt0 = (const LAS float*)(lds + L_BTAB) + (2 * w) * 192;
  LAS unsigned char* ringp = lds + 65536 + w * 8192;
  const char* ksrc = (const char*)img + g * 4096; const unsigned voff = (unsigned)lane * 16u;
  const unsigned kring = lds0 + (unsigned)w * 8192u; const LAS unsigned char* kl = lds + w * 8192 + lane * 16;
#define TSRC(t_) (ksrc + (size_t)((t_) < nkt ? (t_) : nkt - 1) * 32768)
  bf16x8 vA[4], vB[4]; f32x16 cA[2], cB[2];
  k_dma(TSRC(0), voff, kring); v_load(vA, TSRC(0) + 16384, voff); k_dma(TSRC(1), voff, kring + 4096u);
  kv_wait(vA);
  qk_tile(cA, kl, qf);
#pragma unroll 1
  for (int kt = 0; ; kt += 2) {
    k_dma(TSRC(kt + 2), voff, kring); v_load(vB, TSRC(kt + 1) + 16384, voff);
    if (qt - kt <= 4) add_bias(cA, bt0, (t0 + q) - (32 * kt + 8 * hi));
    { const unsigned m16 = maskl[kt * 64 + lane];
      qk_tile(cB, kl + 4096, qf); sm_pv<0>(O, l, cA, vA, m16); }
    kv_wait(vB);
    if (kt + 1 >= nkt) break;
    k_dma(TSRC(kt + 3), voff, kring + 4096u); v_load(vA, TSRC(kt + 2) + 16384, voff);
    if (qt - (kt + 1) <= 4) add_bias(cB, bt0, (t0 + q) - (32 * (kt + 1) + 8 * hi));
    { const unsigned m16 = maskl[(kt + 1) * 64 + lane];
      qk_tile(cA, kl, qf); sm_pv<0>(O, l, cB, vB, m16); }
    kv_wait(vA);
    if (kt + 2 >= nkt) break;
  }
#undef TSRC
  { int tid2 = lane_id_hw(); asm volatile("" : "+v"(tid2)); const int lane2 = tid2 & 63;
    attn_store(O, l, P.SG, P.OG, rowb + t0, 2 * w, ringp, lane2); }
}

DI void moba_unit(LAS unsigned char* lds, const Ptrs& P, int b, int qt, int wave_) {
  int tid = wave_ * 64 + lane_id_hw(); asm volatile("" : "+v"(tid));
  const int lane = tid & 63, w = __builtin_amdgcn_readfirstlane(tid >> 6), q = lane & 31, hi = lane >> 5;
  const int t0 = 32 * qt, ob = qt >> 3; const size_t rowb = (size_t)b * SEQ;
  LAS unsigned char* selm = lds + L_SELM; LAS unsigned* blkw = (LAS unsigned*)(lds + L_BLK);
  bf16x8 qf[2][4];
#pragma unroll
  for (int j = 0; j < 2; ++j)
#pragma unroll
    for (int s = 0; s < 4; ++s) qf[j][s] = *(const bf16x8*)(P.Q + (rowb + t0 + q) * 1024 + (2 * w + j) * 64 + 16 * s + 8 * hi);
  __syncthreads();
  if (tid == 0) blkw[0] = 0u;
  __syncthreads();
  if (ob > 0) {
    const int qq = tid & 31, gg = (tid >> 5) & 3, part = tid >> 7;
    float gs[7];
#pragma unroll
    for (int n = 0; n < 7; ++n) gs[n] = 0.f;
    const bf16* qp = P.Q + (rowb + t0 + qq) * 1024 + gg * 256 + part * 16;
#pragma unroll
    for (int c = 0; c < 2; ++c) {
      float qs[8];
#pragma unroll
      for (int e = 0; e < 8; ++e) qs[e] = 0.f;
#pragma unroll
      for (int j = 0; j < 4; ++j) { const u32x4 v = *(const u32x4*)(qp + j * 64 + c * 8);
        qs[0] += bflo(v.x); qs[1] += bfhi(v.x); qs[2] += bflo(v.y); qs[3] += bfhi(v.y); qs[4] += bflo(v.z); qs[5] += bfhi(v.z); qs[6] += bflo(v.w); qs[7] += bfhi(v.w); }
#pragma unroll
      for (int n = 0; n < 7; ++n) if (n < ob) { const f32x4* km = (const f32x4*)(P.KM + ((size_t)(b * 4 + gg) * 8 + n) * 64 + part * 16 + c * 8); const f32x4 k0 = km[0], k1 = km[1];
        gs[n] += (qs[0] * k0.x + qs[1] * k0.y + qs[2] * k0.z + qs[3] * k0.w) + (qs[4] * k1.x + qs[5] * k1.y + qs[6] * k1.z + qs[7] * k1.w); }
    }
    LAS float* gp = (LAS float*)lds + (size_t)(part * 128 + gg * 32 + qq) * 8;
#pragma unroll
    for (int n = 0; n < 7; ++n) gp[n] = gs[n];
  }
  __syncthreads();
  if (tid < 128) {
    const int qq = tid & 31, gg = tid >> 5; unsigned sel = 0;
    if (ob > 0) {
      float gs[7]; const LAS float* gp = (const LAS float*)lds + (size_t)(gg * 32 + qq) * 8;
#pragma unroll
      for (int n = 0; n < 7; ++n) gs[n] = (n < ob) ? ((gp[n] + gp[1024 + n]) + (gp[2048 + n] + gp[3072 + n])) : -INFINITY;
#pragma unroll
      for (int n = 0; n < 7; ++n) { if (n < ob) { int rank = 0;
#pragma unroll
          for (int m = 0; m < 7; ++m) if (m != n && m < ob) rank += ((gs[m] > gs[n]) || (gs[m] == gs[n] && m < n)) ? 1 : 0;
          if (rank < 3) sel |= 1u << n; } }
    }
    selm[gg * 32 + qq] = (unsigned char)sel;
    if (sel) __hip_atomic_fetch_or(blkw, sel, __ATOMIC_RELAXED, __HIP_MEMORY_SCOPE_WORKGROUP);
  }
  __syncthreads();
  const int g = w >> 1;
  const unsigned mysel = selm[g * 32 + q];
  const unsigned blk = (unsigned)__builtin_amdgcn_readfirstlane(blkw[0]) | (1u << ob);
  const bf16* img = P.KV + (size_t)(b * 64) * 16384;
  const unsigned lds0 = (unsigned)(uintptr_t)lds;
#pragma unroll
  for (int j = 0; j < 2; ++j)
#pragma unroll
    for (int s = 0; s < 4; ++s) asm volatile("" : "+v"(qf[j][s]));
  f32x16 O[2][2]; float l[2] = {0.f, 0.f};
#pragma unroll
  for (int j = 0; j < 2; ++j)
#pragma unroll
    for (int dt = 0; dt < 2; ++dt)
#pragma unroll
      for (int r = 0; r < 16; ++r) O[j][dt][r] = 0.f;
  const LAS float* bt0 = (const LAS float*)(lds + L_BTAB) + (2 * w) * 192;
#define NEXT_TILE(kt_, out_) do { int kn_ = (kt_) + 1; if (kn_ > qt) kn_ = -1; else if (((blk >> (kn_ >> 3)) & 1u) == 0u) kn_ = 8 * ((kn_ >> 3) + __builtin_ctz(blk >> (kn_ >> 3))); (out_) = kn_; } while (0)
  LAS unsigned char* ringp = lds + 65536 + w * 8192;
  const char* ksrc = (const char*)img + g * 4096; const unsigned voff = (unsigned)lane * 16u;
  const unsigned kring = lds0 + (unsigned)w * 8192u; const LAS unsigned char* kl = lds + w * 8192 + lane * 16;
  int ta = 8 * __builtin_ctz(blk), tb, tc, td;
  NEXT_TILE(ta, tb); tc = -1; if (tb >= 0) NEXT_TILE(tb, tc);
  const int tfirst = ta;
#define TSRC(t_) (ksrc + (size_t)((t_) >= 0 ? (t_) : tfirst) * 32768)
#define MOBA_SM(C, VF, KT) do { const int n_ = (KT) >> 3; const unsigned lm_ = (n_ < ob) ? (0u - ((mysel >> n_) & 1u)) : 0xFFFFFFFFu; sm_pv<1>(O, l, C, VF, lm_); } while (0)
  bf16x8 vA[4], vB[4]; f32x16 cA[2], cB[2];
  k_dma(TSRC(ta), voff, kring); v_load(vA, TSRC(ta) + 16384, voff); k_dma(TSRC(tb), voff, kring + 4096u);
  kv_wait(vA);
  qk_tile(cA, kl, qf);
#pragma unroll 1
  while (true) {
    k_dma(TSRC(tc), voff, kring); v_load(vB, TSRC(tb) + 16384, voff);
    if (qt - ta <= 4) add_bias(cA, bt0, (t0 + q) - (32 * ta + 8 * hi));
    qk_tile(cB, kl + 4096, qf); MOBA_SM(cA, vA, ta);
    kv_wait(vB);
    if (tb < 0) break;
    td = -1; if (tc >= 0) NEXT_TILE(tc, td);
    k_dma(TSRC(td), voff, kring + 4096u); v_load(vA, TSRC(tc) + 16384, voff);
    if (qt - tb <= 4) add_bias(cB, bt0, (t0 + q) - (32 * tb + 8 * hi));
    qk_tile(cA, kl, qf); MOBA_SM(cB, vB, tb);
    kv_wait(vA);
    if (tc < 0) break;
    ta = tc; tb = td; tc = -1; if (tb >= 0) NEXT_TILE(tb, tc);
  }
#undef MOBA_SM
#undef TSRC
#undef NEXT_TILE
  { int tid2 = lane_id_hw(); asm volatile("" : "+v"(tid2)); const int lane2 = tid2 & 63;
    attn_store(O, l, P.SG, P.OG, rowb + t0, 2 * w, ringp, lane2); }
}

__global__ void __launch_bounds__(512, 2) fwd(Args args) {
  extern __shared__ __attribute__((aligned(16))) unsigned char lds_raw[];
  LAS unsigned char* lds = (LAS unsigned char*)lds_raw;
  const int wave = __builtin_amdgcn_readfirstlane((int)threadIdx.x >> 6);
#define FRESH_TID(t_) int t_ = wave * 64 + lane_id_hw(); asm volatile("" : "+v"(t_))
  const int G = gridDim.x, bx = blockIdx.x;
  const int vcu = (G % 8 == 0) ? (bx % 8) * (G / 8) + bx / 8 : bx;
  LAS unsigned long long* ptab = (LAS unsigned long long*)(lds + L_MISC + 64);
  { FRESH_TID(tid0);
    if (tid0 < 16) { const unsigned long long* ka = (const unsigned long long*)__builtin_amdgcn_kernarg_segment_ptr(); ptab[tid0] = ka[tid0]; ((LAS unsigned*)(lds + L_MISC))[tid0] = 0u; }
    __syncthreads(); }
#define TABPTR(k) ((unsigned char*)(__attribute__((address_space(1))) unsigned char*)(((unsigned long long)(unsigned)__builtin_amdgcn_readfirstlane((int)(ptab[(k)] >> 32)) << 32) | (unsigned long long)(unsigned)__builtin_amdgcn_readfirstlane((int)(unsigned)ptab[(k)])))
#define LOAD_PTRS() Ptrs P; { asm volatile("" ::: "memory"); unsigned char* ws = TABPTR(15); \
  P.x = (const float*)TABPTR(0); P.norm_a_g = (const float*)TABPTR(1); P.w_in_a = (const float*)TABPTR(2); P.qn_a_g = (const float*)TABPTR(3); P.kn_a_g = (const float*)TABPTR(4); P.w_out_a = (const float*)TABPTR(5); P.rel_bias = (const float*)TABPTR(6); \
  P.norm_kv_g = (const float*)TABPTR(7); P.w_kv = (const float*)TABPTR(8); P.kn_b_g = (const float*)TABPTR(9); P.norm_b_g = (const float*)TABPTR(10); P.w_in_b = (const float*)TABPTR(11); P.qn_b_g = (const float*)TABPTR(12); P.w_out_b = (const float*)TABPTR(13); \
  P.out = (float*)TABPTR(14); \
  P.WtA = (bf16*)(ws + WS_WA); P.WtOA = (bf16*)(ws + WS_WOA); P.WtB = (bf16*)(ws + WS_WB); P.WtOB = (bf16*)(ws + WS_WOB); \
  P.XN = (bf16*)(ws + WS_XN); P.Q = (bf16*)(ws + WS_Q); P.KV = (bf16*)(ws + WS_K); P.SG = (bf16*)(ws + WS_SG); \
  P.IQ = (bf16*)(ws + WS_IQ); P.IK = (bf16*)(ws + WS_IK); P.OG = (bf16*)(ws + WS_OG); \
  P.IW = (float*)(ws + WS_IW); P.KM = (float*)(ws + WS_KM); P.RINV = (float*)(ws + WS_KM + 524288); P.SSQ = (float*)(ws + WS_H1); }
  const int lo = args.ph_lo, hi = args.ph_hi;
#ifndef PH_MASK
#define PH_MASK 0x1ff
#endif
#ifndef REP_MASK
#define REP_MASK 0
#endif
#define IN(k) (((PH_MASK >> (k)) & 1) && lo <= (k) && (k) < hi)
#define NREP(k) ((((REP_MASK) >> (k)) & 1) ? 2 : 1)
#if MK_N_LAUNCHES == 1
  const bool grouped = (G == 256);
  XcdBarrier xbar = xcd_barrier_post((unsigned*)TABPTR(15), (volatile LAS unsigned*)(lds + L_MISC), wave == 0 && lane_id_hw() == 0, (unsigned)G);
  XcdBarrier xbarL = xcd_barrier_post((unsigned*)(TABPTR(15) + 16384 * (1 + (bx & 7))), (volatile LAS unsigned*)(lds + L_MISC) + 2, wave == 0 && lane_id_hw() == 0, (unsigned)(G / 8));
#define SEAM(k) do { if (IN(k) && (hi > (k) + 1)) { if ((k) == 0 || !grouped) xcd_barrier(xbar, wave == 0 && lane_id_hw() == 0); else xcd_barrier(xbarL, wave == 0 && lane_id_hw() == 0); } } while (0)
#else
#define SEAM(k) do { } while (0)
#endif
  const int gw = vcu * 8 + wave, NGW = G * 8;

  if (IN(0)) {
    LOAD_PTRS();
    FRESH_TID(tid); const int lane = tid & 63;
    LAS float* scr = (LAS float*)(lds + wave * 8448);
    constexpr int I_A = 16 * (NCOL_A / 32), I_O = 16 * 32, I_KV = 16 * 16, I_B = 16 * 64;
    constexpr int NITEMS = I_A + I_O + I_KV + I_B + I_O;
    for (int it = gw; it < NITEMS; it += NGW) {
      int r = it;
      if (r < I_A) { trans_item(P.w_in_a, 3144, P.norm_a_g, P.WtA, r, NCOL_A / 32, 1, scr, lane); continue; } r -= I_A;
      if (r < I_O) { trans_item(P.w_out_a, 1024, nullptr, P.WtOA, r, 32, 0, scr, lane); continue; } r -= I_O;
      if (r < I_KV) { trans_item(P.w_kv, 512, P.norm_kv_g, P.WtB, r, 16, 0, scr, lane); continue; } r -= I_KV;
      if (r < I_B) { trans_item(P.w_in_b, 2048, P.norm_b_g, P.WtB + (size_t)512 * 1024, r, 64, 0, scr, lane); continue; } r -= I_B;
      trans_item(P.w_out_b, 1024, nullptr, P.WtOB, r, 32, 0, scr, lane);
    }
    for (int m = gw; m < MTOK; m += 4 * NGW) {
      f32x4 v[4][4]; float ss[4];
#pragma unroll
      for (int u = 0; u < 4; ++u) { const int mm = m + u * NGW; const f32x4* xr = (const f32x4*)(P.x + (size_t)(mm < MTOK ? mm : m) * 1024) + lane;
#pragma unroll
        for (int j = 0; j < 4; ++j) v[u][j] = __builtin_nontemporal_load(xr + 64 * j); }
#pragma unroll
      for (int u = 0; u < 4; ++u) { float a = 0.f;
#pragma unroll
        for (int j = 0; j < 4; ++j) a += (v[u][j].x * v[u][j].x + v[u][j].y * v[u][j].y) + (v[u][j].z * v[u][j].z + v[u][j].w * v[u][j].w);
        ss[u] = a; }
#pragma unroll
      for (int o = 1; o < 64; o <<= 1) {
#pragma unroll
        for (int u = 0; u < 4; ++u) ss[u] += __shfl_xor(ss[u], o); }
#pragma unroll
      for (int u = 0; u < 4; ++u) { const int mm = m + u * NGW; if (mm < MTOK) {
          u32x2* o8 = (u32x2*)(P.XN + (size_t)mm * 1024) + lane;
#pragma unroll
          for (int j = 0; j < 4; ++j) { u32x2 w; w.x = cvtpk(v[u][j].x, v[u][j].y); w.y = cvtpk(v[u][j].z, v[u][j].w); o8[64 * j] = w; }
          if (lane == 0) P.RINV[mm] = rsqrtf(ss[u] * (1.0f / 1024.0f) + EPS); } }
    }
    for (int i = gw * 64 + lane; i < NBATCH * 4 * 8 * 64; i += NGW * 64) P.KM[i] = 0.f;
    __syncthreads();
  }
  SEAM(0);
  if (IN(1)) for (int rep_ = 0; rep_ < NREP(1); ++rep_) {
    LOAD_PTRS();
    pg8::Gemm g{P.XN, P.WtA, MTOK, NCOL_A, 1024}; OrderR S; S.init(MTOK, NCOL_A, G, bx); S.rv = P.RINV; S.ldsb = (unsigned)(uintptr_t)(lds + L_EPI); S.wv = wave; S.k = 0;
    EpiA E{P.Q, P.KV, P.SG, P.IQ, P.IK, P.IW, P.qn_a_g, P.kn_a_g, (const LAS float*)(lds + L_EPI), 0};
    pg8::gemm_phase<EpiA, OrderR, true, true>(lds, g, S, E, wave);
    __syncthreads();
  }
  SEAM(1);
  if (IN(2)) for (int rep_ = 0; rep_ < NREP(2); ++rep_) {
    LOAD_PTRS();
    { FRESH_TID(tidb); build_btab(lds, P.rel_bias, tidb); }
#pragma unroll 1
    for (int i = 0; ; ++i) { int b, qt;
      if (G == 256) { if (i >= 4) break; const int c = vcu & 31; b = 2 * (vcu >> 5) + (i >> 1); qt = (i & 1) ? c : 63 - c; }
      else { const int u = vcu + i * G; if (u >= 1024) break; b = u >> 6; qt = 63 - (u & 63); }
      dsa_unit(lds, P, b, qt, wave); }
    __syncthreads();
  }
  SEAM(2);
  if (IN(3)) for (int rep_ = 0; rep_ < NREP(3); ++rep_) {
    LOAD_PTRS();
    pg8::Gemm g{P.OG, P.WtOA, MTOK, 1024, 1024}; pg8::StaticOrder S; S.init(MTOK, 1024, G, bx);
    EpiRes2 E{P.XN, P.SSQ};
    pg8::gemm_phase<EpiRes2, pg8::StaticOrder, true, true>(lds, g, S, E, wave);
    __syncthreads();
  }
  SEAM(3);
  if (IN(4)) { LOAD_PTRS(); FRESH_TID(tidr);
    if (G == 256) { if (tidr < 128) { const int r = 4096 * (bx & 7) + 128 * (bx >> 3) + tidr; P.RINV[r] = row_rinv(P.SSQ, r); } }
    else for (int r = bx * 512 + tidr; r < MTOK; r += G * 512) P.RINV[r] = row_rinv(P.SSQ, r); }
  SEAM(4);
  if (IN(5)) for (int rep_ = 0; rep_ < NREP(5); ++rep_) {
    LOAD_PTRS();
    pg8::Gemm g{P.XN, P.WtB, MTOK, NCOL_B, 1024}; OrderR S; S.init(MTOK, NCOL_B, G, bx); S.rv = P.RINV; S.ldsb = (unsigned)(uintptr_t)(lds + L_EPI); S.wv = wave; S.k = 0;
    EpiB E{P.Q, P.KV, P.SG, P.qn_b_g, P.kn_b_g, (const LAS float*)(lds + L_EPI), P.KM, 0};
    pg8::gemm_phase<EpiB, OrderR, true, true>(lds, g, S, E, wave);
    __syncthreads();
  }
  SEAM(5);
  if (IN(7)) for (int rep_ = 0; rep_ < NREP(7); ++rep_) {
    LOAD_PTRS();
    { FRESH_TID(tidb); build_btab(lds, P.rel_bias, tidb); }
#pragma unroll 1
    for (int i = 0; ; ++i) { int b, qt;
      if (G == 256) { if (i >= 4) break; const int c = vcu & 31; b = 2 * (vcu >> 5) + (i >> 1); qt = (i & 1) ? c : 63 - c; }
      else { const int u = vcu + i * G; if (u >= 1024) break; b = u >> 6; qt = 63 - (u & 63); }
      moba_unit(lds, P, b, qt, wave); }
    __syncthreads();
  }
  SEAM(7);
  if (IN(8)) for (int rep_ = 0; rep_ < NREP(8); ++rep_) {
    LOAD_PTRS();
    pg8::Gemm g{P.OG, P.WtOB, MTOK, 1024, 1024}; pg8::StaticOrder S; S.init(MTOK, 1024, G, bx);
    EpiRes E{P.XN, P.out, lds + L_EPI};
    pg8::gemm_phase<EpiRes, pg8::StaticOrder, true, true>(lds, g, S, E, wave);
  }
#undef IN
#undef SEAM
}

extern "C" void kernel_launch(void* const* d_in, const int* in_sizes, int n_in, void* d_out, int out_size, void* d_ws, size_t ws_size, hipStream_t stream) {
  static int grid = 0;
  if (grid == 0) {
    if (n_in != 14 || out_size != MTOK * DM || ws_size < WS_END) { fprintf(stderr, "kernel_launch: unexpected problem (n_in %d, out %d, ws %zu)\n", n_in, out_size, ws_size); grid = -1; return; }
    int dev = 0, cus = 0, per_cu = 0;
    if (hipGetDevice(&dev) != hipSuccess || hipDeviceGetAttribute(&cus, hipDeviceAttributeMultiprocessorCount, dev) != hipSuccess) { grid = -1; return; }
    if (hipFuncSetAttribute((const void*)fwd, hipFuncAttributeMaxDynamicSharedMemorySize, LDS_BYTES) != hipSuccess) { fprintf(stderr, "kernel_launch: hipFuncSetAttribute failed\n"); grid = -1; return; }
    if (hipOccupancyMaxActiveBlocksPerMultiprocessor(&per_cu, (const void*)fwd, 512, LDS_BYTES) != hipSuccess || per_cu < 1) { fprintf(stderr, "kernel_launch: occupancy query says %d\n", per_cu); per_cu = 1; }
    (void)hipGetLastError();
    grid = cus;
  }
  if (grid < 0) return;
  Args a{};
  for (int i = 0; i < 14; ++i) a.in[i] = (const float*)d_in[i];
  a.out = (float*)d_out; a.ws = (unsigned char*)d_ws;
#if MK_N_LAUNCHES == 1
  if (hipMemsetAsync(d_ws, 0, 16384 * 9, stream) != hipSuccess) { fprintf(stderr, "kernel_launch: memset of the barrier words failed\n"); return; }
  a.ph_lo = 0; a.ph_hi = NPHASE;
  void* kargs[] = {&a};
  hipError_t e = hipLaunchCooperativeKernel((const void*)fwd, dim3(grid), dim3(512), kargs, LDS_BYTES, stream);
  if (e != hipSuccess) fprintf(stderr, "kernel_launch: cooperative launch failed: %s\n", hipGetErrorString(e));
#else
#ifndef HOST_REP_MASK
#define HOST_REP_MASK 0
#endif
  for (int p = 0; p < NPHASE; ++p) { a.ph_lo = p; a.ph_hi = p + 1; for (int r = 0; r < (((HOST_REP_MASK >> p) & 1) ? 2 : 1); ++r) hipLaunchKernelGGL(fwd, dim3(grid), dim3(512), LDS_BYTES, stream, a); }
#endif
}
```

```cpp
#include <hip/hip_runtime.h>
#include <hip/hip_cooperative_groups.h>
#include <cstdio>
#include <cstdint>
__device__ __forceinline__ int lane_id_hw() { unsigned z = 0u; asm volatile("" : "+v"(z)); return (int)__builtin_amdgcn_mbcnt_hi(~0u, __builtin_amdgcn_mbcnt_lo(~0u, z)); }
namespace pg8 {
#define PG8_LAS __attribute__((address_space(3)))
typedef unsigned short bf16_t;
typedef short bf16x8 __attribute__((ext_vector_type(8)));
typedef float f32x4 __attribute__((ext_vector_type(4)));
typedef unsigned u32x4 __attribute__((ext_vector_type(4)));
constexpr int BM = 256, BK = 64, HALF = 128, HTB = HALF * BK * 2  , STAGE_BYTES = 8 * HTB, NXCD = 8, WGM = 8;

__host__ __device__ __forceinline__ int lds_byte(int r, int c) { const int st = (r >> 4) * 2 + (c >> 5), rr = r & 15, cc = c & 31, ob = rr * 64 + cc * 2; return st * 1024 + (ob ^ (((ob >> 9) & 1) << 5)); }
__host__ __device__ __forceinline__ void stage_rc(int b, int& R, int& C) { const int st = b / 1024, sb = b % 1024, swz = sb ^ (((sb >> 9) & 1) << 5); R = (st >> 1) * 16 + swz / 64; C = (st & 1) * 32 + (swz % 64) / 2; }
__host__ __device__ __forceinline__ int perm32(int rho) { const int n = rho >> 4, i = rho & 15; return 8 * (i >> 2) + 4 * n + (i & 3); }

struct Unit { int pm, pn; };
struct Gemm { const bf16_t* A; const bf16_t* Bt; int M, N, K; };

struct StaticOrder {
    int nM, nN, nwg, G, c;
    __host__ __device__ void init(int M, int N, int G_, int c_) { nM = M / BM; nN = N / BM; nwg = nM * nN; G = G_; c = c_; }
    __host__ __device__ bool next(int i, Unit& u) const {
        const long L = (long)i * G + c; if (L >= nwg) return false;
        int wgid = (int)L; { const int q = nwg / NXCD, r = nwg % NXCD, xcd = wgid % NXCD, off = wgid / NXCD; wgid = (xcd < r ? xcd * (q + 1) : r * (q + 1) + (xcd - r) * q) + off; }
        const int nig = WGM * nN, gid = wgid / nig, fm = gid * WGM, gsz = (nM - fm) < WGM ? (nM - fm) : WGM;
        u.pm = fm + ((wgid % nig) % gsz); u.pn = (wgid % nig) / gsz; return true;
    }
    __device__ __forceinline__ void a_ready(const Unit&) const {}
    __device__ __forceinline__ void done(const Unit&) const {}
};

template <class Epi, class Sched, bool ALIGN_EPI = false, bool SP2 = false>
__device__ __forceinline__ void gemm_phase(PG8_LAS unsigned char* lds, const Gemm g, const Sched& S, const Epi& E, int wave_) {
    const int tid = wave_ * 64 + lane_id_hw(), wid = __builtin_amdgcn_readfirstlane(tid >> 6), lane = tid & 63, wr = wid >> 2, wc = wid & 3, fr = lane & 15, fq = lane >> 4;
    const int K = g.K, nt = K / BK;
    unsigned voffA[2], voffB[2];
#pragma unroll
    for (int i = 0; i < 2; ++i) { int R, C; stage_rc(tid * 16 + i * 8192, R, C); const int Rb = Epi::PERM ? ((R & ~31) + perm32(R & 31)) : R;
        voffA[i] = (unsigned)(R * K + C) * 2u; voffB[i] = (unsigned)(Rb * K + C) * 2u; }
    const size_t kstep = (size_t)(BK * 2);
    const size_t hstep = (size_t)HALF * K * 2;
    const size_t tstep = 2 * hstep;
    const unsigned ldsw = (unsigned)wid * 1024u;
    const int aoff = lds_byte(wr * 64 + fr, fq * 8), boff = lds_byte(wc * 32 + fr, fq * 8);
#define PG8_SA(b, h) (((b) * 2 + (h)) * HTB)
#define PG8_SB(b, h) ((4 + (b) * 2 + (h)) * HTB)
#define PG8_STAGE(bufoff, gbase, voff) do { _Pragma("unroll") for (int _i = 0; _i < 2; ++_i) \
        __builtin_amdgcn_global_load_lds((const unsigned*)((const char*)(gbase) + (voff)[_i]), (PG8_LAS unsigned*)(lds + (bufoff) + ldsw + _i * 8192), 16, 0, 0); } while (0)
#define PG8_LDA(dst, b, h) do { _Pragma("unroll") for (int m = 0; m < 4; ++m) _Pragma("unroll") for (int k = 0; k < 2; ++k) dst[m][k] = *(const PG8_LAS bf16x8*)(lds + PG8_SA(b, h) + aoff + m * 2048 + k * 1024); } while (0)
#define PG8_LDB(dst, b, h) do { _Pragma("unroll") for (int n = 0; n < 2; ++n) _Pragma("unroll") for (int k = 0; k < 2; ++k) dst[n][k] = *(const PG8_LAS bf16x8*)(lds + PG8_SB(b, h) + boff + n * 2048 + k * 1024); } while (0)
#define PG8_MMA(ai, bj, At, Bt) do { __builtin_amdgcn_s_setprio(1); _Pragma("unroll") for (int m = 0; m < 4; ++m) _Pragma("unroll") for (int n = 0; n < 2; ++n) _Pragma("unroll") for (int k = 0; k < 2; ++k) \
        acc[ai][bj][m][n] = __builtin_amdgcn_mfma_f32_16x16x32_bf16(Bt[n][k], At[m][k], acc[ai][bj][m][n], 0, 0, 0); __builtin_amdgcn_s_setprio(0); } while (0)
#define PG8_WAIT_V(n) asm volatile("s_waitcnt vmcnt(" #n ")" ::: "memory")
#define PG8_WAIT_L(n) asm volatile("s_waitcnt lgkmcnt(" #n ")" ::: "memory")
#define PG8_BAR __builtin_amdgcn_s_barrier()
#define PG8_SCHED __builtin_amdgcn_sched_barrier(0)
    Unit cur, nxt; int ui = 0;
    if (!S.next(0, cur)) return;
    f32x4 acc[2][2][4][2];
#pragma unroll
    for (int a = 0; a < 2; ++a)
#pragma unroll
        for (int b = 0; b < 2; ++b)
#pragma unroll
            for (int m = 0; m < 4; ++m)
#pragma unroll
                for (int n = 0; n < 2; ++n) acc[a][b][m][n] = (f32x4){0.f, 0.f, 0.f, 0.f};
    bf16x8 At[4][2], B0[2][2], B1[2][2];
    const char* cA = (const char*)g.A + (size_t)cur.pm * tstep; const char* cB = (const char*)g.Bt + (size_t)cur.pn * tstep;
    S.a_ready(cur);
    if constexpr (SP2) {
        PG8_STAGE(PG8_SB(0, 0), cB, voffB); PG8_STAGE(PG8_SB(0, 1), cB + hstep, voffB); PG8_STAGE(PG8_SA(0, 0), cA, voffA); PG8_STAGE(PG8_SA(0, 1), cA + hstep, voffA);
        if (wr == 1) PG8_BAR;
        PG8_WAIT_V(2); PG8_BAR;
        PG8_STAGE(PG8_SB(1, 0), cB + kstep, voffB); PG8_STAGE(PG8_SA(1, 0), cA + kstep, voffA); PG8_STAGE(PG8_SB(1, 1), cB + hstep + kstep, voffB);
        PG8_WAIT_V(6); PG8_BAR;
    } else {
        PG8_STAGE(PG8_SB(0, 0), cB, voffB); PG8_STAGE(PG8_SA(0, 0), cA, voffA); PG8_STAGE(PG8_SB(0, 1), cB + hstep, voffB); PG8_STAGE(PG8_SA(0, 1), cA + hstep, voffA);
        if (wr == 1) PG8_BAR;
        PG8_WAIT_V(4); PG8_BAR;
        PG8_STAGE(PG8_SB(1, 0), cB + kstep, voffB); PG8_STAGE(PG8_SA(1, 0), cA + kstep, voffA); PG8_STAGE(PG8_SB(1, 1), cB + hstep + kstep, voffB);
        PG8_WAIT_V(6); PG8_BAR;
    }
    for (;;) {
        const bool has_next = S.next(ui + 1, nxt);
        const char* nA = has_next ? (const char*)g.A + (size_t)nxt.pm * tstep : cA; const char* nB = has_next ? (const char*)g.Bt + (size_t)nxt.pn * tstep : cB;
        for (int t = 0; t < nt; t += 2) {
            const bool last = (t == nt - 2);
            const char* a1 = cA + (size_t)(t + 1) * kstep;
            const char* a2 = last ? nA : cA + (size_t)(t + 2) * kstep; const char* b2 = last ? nB : cB + (size_t)(t + 2) * kstep;
            const char* a3 = a2 + kstep; const char* b3 = b2 + kstep;
            if (last && has_next) S.a_ready(nxt);
            if constexpr (SP2) {
            PG8_LDB(B0, 0, 0); PG8_LDB(B1, 0, 1); PG8_SCHED; PG8_LDA(At, 0, 0); PG8_STAGE(PG8_SA(1, 1), a1 + hstep, voffA);
            PG8_WAIT_V(8); PG8_WAIT_L(0); PG8_BAR; PG8_MMA(0, 0, At, B0); PG8_MMA(0, 1, At, B1); PG8_BAR; PG8_SCHED;
            PG8_LDA(At, 0, 1); PG8_STAGE(PG8_SB(0, 0), b2, voffB); PG8_STAGE(PG8_SB(0, 1), b2 + hstep, voffB); PG8_STAGE(PG8_SA(0, 0), a2, voffA);
            PG8_WAIT_V(8); PG8_WAIT_L(0); PG8_BAR; PG8_MMA(1, 0, At, B0); PG8_MMA(1, 1, At, B1); PG8_BAR; PG8_SCHED;
            PG8_LDB(B0, 1, 0); PG8_LDB(B1, 1, 1); PG8_SCHED; PG8_LDA(At, 1, 0); PG8_STAGE(PG8_SA(0, 1), a2 + hstep, voffA);
            PG8_WAIT_V(8); PG8_WAIT_L(0); PG8_BAR; PG8_MMA(0, 0, At, B0); PG8_MMA(0, 1, At, B1); PG8_BAR; PG8_SCHED;
            PG8_LDA(At, 1, 1); PG8_STAGE(PG8_SB(1, 0), b3, voffB); PG8_STAGE(PG8_SB(1, 1), b3 + hstep, voffB); PG8_STAGE(PG8_SA(1, 0), a3, voffA);
            PG8_WAIT_V(8); PG8_WAIT_L(0); PG8_BAR; PG8_MMA(1, 0, At, B0); PG8_MMA(1, 1, At, B1); PG8_BAR; PG8_SCHED;
            } else {
            PG8_LDB(B0, 0, 0); PG8_SCHED; PG8_LDA(At, 0, 0); PG8_STAGE(PG8_SA(1, 1), a1 + hstep, voffA);
            PG8_WAIT_L(8); PG8_BAR; PG8_WAIT_L(0); PG8_MMA(0, 0, At, B0); PG8_BAR; PG8_SCHED;
            PG8_LDB(B1, 0, 1); PG8_STAGE(PG8_SB(0, 0), b2, voffB);
            PG8_BAR; PG8_WAIT_L(0); PG8_MMA(0, 1, At, B1); PG8_BAR;
            PG8_LDA(At, 0, 1); PG8_STAGE(PG8_SA(0, 0), a2, voffA);
            PG8_BAR; PG8_WAIT_L(0); PG8_MMA(1, 0, At, B0); PG8_BAR; PG8_SCHED;
            PG8_STAGE(PG8_SB(0, 1), b2 + hstep, voffB);
            PG8_WAIT_V(6); PG8_BAR; PG8_MMA(1, 1, At, B1); PG8_BAR;
            PG8_LDB(B0, 1, 0); PG8_SCHED; PG8_LDA(At, 1, 0); PG8_STAGE(PG8_SA(0, 1), a2 + hstep, voffA);
            PG8_WAIT_L(8); PG8_BAR; PG8_WAIT_L(0); PG8_MMA(0, 0, At, B0); PG8_BAR; PG8_SCHED;
            PG8_LDB(B1, 1, 1); PG8_STAGE(PG8_SB(1, 0), b3, voffB);
            PG8_BAR; PG8_WAIT_L(0); PG8_MMA(0, 1, At, B1); PG8_BAR;
            PG8_LDA(At, 1, 1); PG8_STAGE(PG8_SA(1, 0), a3, voffA);
            PG8_BAR; PG8_WAIT_L(0); PG8_MMA(1, 0, At, B0); PG8_BAR; PG8_SCHED;
            PG8_STAGE(PG8_SB(1, 1), b3 + hstep, voffB);
            PG8_WAIT_V(6); PG8_BAR; PG8_MMA(1, 1, At, B1); PG8_BAR;
            }
        }
        if constexpr (ALIGN_EPI) { if (wr == 0) PG8_BAR; }
        if constexpr (!Epi::AFTER_DRAIN) { E(acc, cur, wr, wc, fr, fq); S.done(cur); }
        if (!has_next) break;
#pragma unroll
        for (int a = 0; a < 2; ++a)
#pragma unroll
            for (int b = 0; b < 2; ++b)
#pragma unroll
                for (int m = 0; m < 4; ++m)
#pragma unroll
                    for (int n = 0; n < 2; ++n) acc[a][b][m][n] = (f32x4){0.f, 0.f, 0.f, 0.f};
        cur = nxt; cA = nA; cB = nB; ++ui;
        if constexpr (ALIGN_EPI) { if (wr == 1) PG8_BAR; }
    }
    PG8_WAIT_V(0);
    if constexpr (!ALIGN_EPI) { if (wr == 0) PG8_BAR; }
    PG8_BAR;
    if constexpr (Epi::AFTER_DRAIN) { E.fused(acc, cur, wr, wc, fr, fq, lds, wid, lane); S.done(cur); }
#undef PG8_SA
#undef PG8_SB
#undef PG8_STAGE
#undef PG8_LDA
#undef PG8_LDB
#undef PG8_MMA
#undef PG8_WAIT_V
#undef PG8_WAIT_L
#undef PG8_BAR
#undef PG8_SCHED
}
}

#ifndef MK_N_LAUNCHES
#define MK_N_LAUNCHES 1
#endif
namespace cg = cooperative_groups;
#define DI __device__ __forceinline__
#define LAS __attribute__((address_space(3)))
typedef unsigned short bf16;
typedef short bf16x8 __attribute__((ext_vector_type(8)));
typedef float f32x4 __attribute__((ext_vector_type(4)));
typedef float f32x16 __attribute__((ext_vector_type(16)));
typedef unsigned u32x4 __attribute__((ext_vector_type(4)));
typedef unsigned u32x2 __attribute__((ext_vector_type(2)));
typedef float f32x2_t __attribute__((ext_vector_type(2)));
typedef __bf16 bf16x2_t __attribute__((ext_vector_type(2)));
typedef short s16x2 __attribute__((ext_vector_type(2)));
typedef unsigned short u16x2 __attribute__((ext_vector_type(2)));

constexpr int SEQ = 2048, DM = 1024, NBATCH = 16, MTOK = NBATCH * SEQ;
constexpr int NCOL_A = 3328, NCOL_B = 2560;
constexpr float EPS = 1e-6f;
constexpr float LOG2E = 1.4426950408889634f;
constexpr float C2 = 0.125f * LOG2E;
constexpr int NPHASE = 9;

constexpr size_t MiB = 1u << 20;
constexpr size_t WS_WA = 1 * MiB, WS_WOA = 8 * MiB, WS_WB = 10 * MiB, WS_WOB = 15 * MiB, WS_KM = 17 * MiB, WS_IW = 18 * MiB, WS_IK = 19 * MiB;
constexpr size_t WS_XN = 24 * MiB, WS_Q = 88 * MiB, WS_K = 152 * MiB, WS_VT = 168 * MiB, WS_SG = 184 * MiB, WS_IQ = 248 * MiB, WS_OG = 280 * MiB, WS_H1 = 344 * MiB, WS_END = 472 * MiB;

constexpr int LDS_BYTES = 153600;
constexpr int IQ_STRIDE = 1040;
constexpr int L_IQ = 0, L_HIST = 33280, L_SEL = 131072, L_MASK = L_SEL + 512, L_BTAB = L_MASK + 8192, L_SELM = L_BTAB + 12288, L_BLK = L_SELM + 128, L_END = L_BLK + 16;
static_assert(L_HIST + 32 * 257 * 4 + 256 <= L_SEL, "selection scratch inside the ring");
constexpr int L_EPI = 131072;
static_assert(L_EPI + 8 * 2304 <= 152320, "epilogue staging");
constexpr int L_MISC = 152320;
static_assert(L_END <= L_MISC && L_MISC + 64 + 128 <= LDS_BYTES && LDS_BYTES <= 163840, "LDS map");

__device__ const unsigned char BKT[128] = {
  0, 1, 2, 3, 4, 5, 6, 7, 8, 9, 10, 11, 12, 13, 14, 15, 16, 16, 16, 17, 17, 18, 18, 18, 19, 19, 19, 20, 20, 20, 20, 21,
  21, 21, 21, 22, 22, 22, 22, 22, 23, 23, 23, 23, 23, 23, 24, 24, 24, 24, 24, 24, 25, 25, 25, 25, 25, 25, 25, 26, 26, 26, 26, 26,
  26, 26, 26, 27, 27, 27, 27, 27, 27, 27, 27, 27, 27, 28, 28, 28, 28, 28, 28, 28, 28, 28, 28, 29, 29, 29, 29, 29, 29, 29, 29, 29,
  29, 29, 29, 30, 30, 30, 30, 30, 30, 30, 30, 30, 30, 30, 30, 30, 30, 31, 31, 31, 31, 31, 31, 31, 31, 31, 31, 31, 31, 31, 31, 31};

struct Args { const float* in[14]; float* out; unsigned char* ws; int ph_lo, ph_hi; };

struct Ptrs {
  const float *x, *norm_a_g, *w_in_a, *qn_a_g, *kn_a_g, *w_out_a, *rel_bias, *norm_kv_g, *w_kv, *kn_b_g, *norm_b_g, *w_in_b, *qn_b_g, *w_out_b;
  float* out;
  bf16 *WtA, *WtOA, *WtB, *WtOB, *XN, *Q, *KV, *SG, *IQ, *IK, *OG;
  float *IW, *KM, *RINV, *SSQ;
};

DI unsigned cvtpk(float lo, float hi) { f32x2_t v = {lo, hi}; bf16x2_t b = __builtin_convertvector(v, bf16x2_t); return __builtin_bit_cast(unsigned, b); }
DI float bflo(unsigned u) { return __uint_as_float(u << 16); }
DI float bfhi(unsigned u) { return __uint_as_float(u & 0xffff0000u); }
DI float wave_sum(float v) {
#pragma unroll
  for (int o = 1; o < 64; o <<= 1) v += __shfl_xor(v, o);
  return v;
}
DI float silu_f(float v) { return v * __builtin_amdgcn_rcpf(1.0f + __expf(-v)); }
#define MFMA32(a, b, c) __builtin_amdgcn_mfma_f32_32x32x16_bf16((a), (b), (c), 0, 0, 0)

#define XB_TMO      128
#define XB_XCNT(j)  (256  + 64 * (j))
#define XB_XSUB(j)  (1280 + 64 * (j))
#define XB_XGEN(j)  (2304 + 64 * (j))
#define XB_TOP      3328
#define XB_TOPGEN   3392
#define XCD_BAR_WORDS 3456
#define XB_SPIN_CAP (1u << 18)

__device__ __forceinline__ unsigned xb_ld(unsigned* p)              { return __hip_atomic_load(p, __ATOMIC_RELAXED, __HIP_MEMORY_SCOPE_AGENT); }
__device__ __forceinline__ unsigned xb_add(unsigned* p, unsigned v) { return __hip_atomic_fetch_add(p, v, __ATOMIC_RELAXED, __HIP_MEMORY_SCOPE_AGENT); }
__device__ __forceinline__ unsigned xb_xcc_id() { return (unsigned)__builtin_amdgcn_s_getreg((3 << 11) | 20) & 0xFu; }
#define XB_SPIN(cond, bar) do { unsigned _sp = 0; while (cond) { __builtin_amdgcn_s_sleep(1); \
    if ((++_sp & 255u) == 0u) { if (xb_ld(&(bar)[XB_TMO])) break; if (_sp > XB_SPIN_CAP) { atomicAdd(&(bar)[XB_TMO], 1u); break; } } } } while (0)

struct XcdBarrier {
    unsigned* bar; unsigned x; unsigned total;
    volatile LAS unsigned* st;
};

__device__ __forceinline__ XcdBarrier xcd_barrier_post(unsigned* bar, volatile LAS unsigned* st, bool lead_, unsigned total_) {
    XcdBarrier b; b.bar = bar; b.x = xb_xcc_id(); b.st = st; b.total = total_;
    if (lead_) (void)xb_add(&bar[XB_XCNT(b.x)], 1u);
    return b;
}
__device__ __forceinline__ void xcd_barrier_complete(unsigned* bar, unsigned x, unsigned& nloc, unsigned& nx, unsigned G) {
    unsigned sum, cnt, mine, sp = 0u;
    for (;;) {
        sum = 0u; cnt = 0u; mine = 0u;
#pragma unroll
        for (unsigned j = 0; j < 16; ++j) { const unsigned c = xb_ld(&bar[XB_XCNT(j)]); sum += c; cnt += (c > 0u) ? 1u : 0u; mine = (j == x) ? c : mine; }
        if (sum == G) break;
        __builtin_amdgcn_s_sleep(1);
        if ((++sp & 255u) == 0u) { if (xb_ld(&bar[XB_TMO])) break; if (sp > XB_SPIN_CAP) { atomicAdd(&bar[XB_TMO], 1u); break; } }
    }
    nloc = mine > 0u ? mine : 1u; nx = cnt > 0u ? cnt : 1u;
}

__device__ __forceinline__ void xcd_barrier(const XcdBarrier& b, bool lead_) {
    asm volatile("s_waitcnt vmcnt(0)" ::: "memory");
    __syncthreads();
    if (lead_) {
        unsigned* bar = b.bar;
        __builtin_amdgcn_s_waitcnt(0);
        unsigned nloc = b.st[0], nx = b.st[1];
        if (nloc == 0u) { xcd_barrier_complete(bar, b.x, nloc, nx, b.total); b.st[0] = nloc; b.st[1] = nx; }
        const unsigned old = xb_add(&bar[XB_XSUB(b.x)], 1u);
        const unsigned gen = old / nloc;
        if (old + 1u == (gen + 1u) * nloc) {
            __builtin_amdgcn_fence(__ATOMIC_RELEASE, "agent");
            asm volatile("s_waitcnt vmcnt(0)" ::: "memory");
            if (nx > 1u) {
            const unsigned og = xb_add(&bar[XB_TOP], 1u);
            const unsigned tg = og / nx;
            if (og + 1u == (tg + 1u) * nx) xb_add(&bar[XB_TOPGEN], 1u);
            else XB_SPIN(xb_ld(&bar[XB_TOPGEN]) == tg, bar);
            }
            if (nx == 1u) (void)__hip_atomic_fetch_add(&bar[XB_XGEN(b.x)], 1u, __ATOMIC_RELAXED, __HIP_MEMORY_SCOPE_AGENT);
            __builtin_amdgcn_fence(__ATOMIC_ACQUIRE, "agent");
            if (nx > 1u) xb_add(&bar[XB_XGEN(b.x)], 1u);
            asm volatile("s_waitcnt vmcnt(0)" ::: "memory");
        } else {
            XB_SPIN(xb_ld(&bar[XB_XGEN(b.x)]) == gen, bar);
            __builtin_amdgcn_fence(__ATOMIC_ACQUIRE, "agent");
            asm volatile("s_waitcnt vmcnt(0)" ::: "memory");
        }
    }
    __syncthreads();
}

DI int slot_of(int gc) { const int u = gc & 255; return (gc & ~255) + 128 * ((u >> 5) & 1) + 32 * (u >> 6) + 16 * ((u >> 2) & 1) + 4 * ((u >> 3) & 3) + (u & 3); }

typedef pg8::f32x4 accq;
DI int pi32(int r) { return (r & ~12) | ((r & 4) << 1) | ((r & 8) >> 1); }
DI size_t kv_tile_elem(int row) { return (size_t)(row >> 5) * 16384; }
DI bf16* k_piece(bf16* KV, int row, int g, int bj, int fq) {
  return KV + kv_tile_elem(row) + (size_t)(((g * 4 + 2 * bj + (fq >> 1)) * 64 + (fq & 1) * 32 + pi32(row & 31)) * 8);
}
struct OrderR : pg8::StaticOrder {
  const float* rv; unsigned ldsb; int wv; mutable int k;
  DI void a_ready(const pg8::Unit& u) const {
    if (wv == 0) { const float* src = rv + (size_t)u.pm * 256 + lane_id_hw() * 4; unsigned keep; const unsigned dst = (unsigned)__builtin_amdgcn_readfirstlane((int)(ldsb + (unsigned)(k & 1) * 1024u));
      asm volatile("s_mov_b32 %0, m0\n\ts_mov_b32 m0, %2\n\ts_nop 0\n\tglobal_load_lds_dwordx4 %1, off\n\ts_mov_b32 m0, %0\n\ts_nop 0" : "=&s"(keep) : "v"(src), "s"(dst) : "memory"); }
    ++k;
  }
};
DI void load_gain(float (&gv)[2][2][4], const float* g, int fq, float sc) {
#pragma unroll
  for (int bj = 0; bj < 2; ++bj)
#pragma unroll
    for (int n = 0; n < 2; ++n)
#pragma unroll
      for (int e = 0; e < 4; ++e) gv[bj][n][e] = g[32 * bj + 8 * fq + 4 * n + e] * sc;
}
template <int ACT  > DI void plain_store(const accq (&acc)[2][2][4][2], int ai, int m, float sc, bf16* dst) {
#pragma unroll
  for (int bj = 0; bj < 2; ++bj) {
    float v[8];
#pragma unroll
    for (int n = 0; n < 2; ++n)
#pragma unroll
      for (int e = 0; e < 4; ++e) { float t = acc[ai][bj][m][n][e] * sc; if (ACT == 1) t = silu_f(t); v[4 * n + e] = t; }
    u32x4 w; w.x = cvtpk(v[0], v[1]); w.y = cvtpk(v[2], v[3]); w.z = cvtpk(v[4], v[5]); w.w = cvtpk(v[6], v[7]);
    *(u32x4*)(dst + 32 * bj) = w;
  }
}
DI void v_store_scaled(const accq (&acc)[2][2][4][2], int ai, int m, bf16* KV, int row, int g, int fq, float sc) {
  const int i = row & 31;
  bf16* base = KV + kv_tile_elem(row) + (size_t)((16 + g * 4 + (i >> 4)) * 512 + ((i >> 3) & 1) * 256 + (i & 7));
#pragma unroll
  for (int bj = 0; bj < 2; ++bj)
#pragma unroll
    for (int n = 0; n < 2; ++n)
#pragma unroll
      for (int e = 0; e < 4; e += 2) {
        const unsigned pk = cvtpk(acc[ai][bj][m][n][e] * sc, acc[ai][bj][m][n][e + 1] * sc);
        const int r = 8 * fq + 4 * n + e;
        base[bj * 1024 + r * 8] = (bf16)(pk & 0xffffu); base[bj * 1024 + (r + 1) * 8] = (bf16)(pk >> 16);
      }
}

struct EpiA {
  static constexpr bool PERM = false, AFTER_DRAIN = false;
  bf16 *Q, *KV, *SG, *IQ, *IK; float* IW; const float *qn_g, *kn_g; const LAS float* rl; mutable int k;
  DI void operator()(const accq (&acc)[2][2][4][2], const pg8::Unit& u, int wr, int wc, int fr, int fq) const {
    const int pn = u.pn, row0 = u.pm * 256 + wr * 64 + fr; const LAS float* rinv = rl + (k & 1) * 256 - u.pm * 256; ++k;
    if (pn <= 4) {
      float gv[2][2][4]; load_gain(gv, pn < 4 ? qn_g : kn_g, fq, pn < 4 ? C2 : 1.0f);
#pragma unroll
      for (int ai = 0; ai < 2; ++ai)
#pragma unroll
        for (int m = 0; m < 4; ++m) { const int row = row0 + 128 * ai + 16 * m; const float ri = rinv[row];
          float v[2][2][4]; float ss = 0.f;
#pragma unroll
          for (int bj = 0; bj < 2; ++bj)
#pragma unroll
            for (int n = 0; n < 2; ++n)
#pragma unroll
              for (int e = 0; e < 4; ++e) { v[bj][n][e] = acc[ai][bj][m][n][e] * ri; ss += v[bj][n][e] * v[bj][n][e]; }
          ss += __shfl_xor(ss, 16); ss += __shfl_xor(ss, 32);
          const float rn = rsqrtf(ss * (1.0f / 64.0f) + EPS);
#pragma unroll
          for (int bj = 0; bj < 2; ++bj) {
            u32x4 w; w.x = cvtpk(v[bj][0][0] * rn * gv[bj][0][0], v[bj][0][1] * rn * gv[bj][0][1]); w.y = cvtpk(v[bj][0][2] * rn * gv[bj][0][2], v[bj][0][3] * rn * gv[bj][0][3]);
            w.z = cvtpk(v[bj][1][0] * rn * gv[bj][1][0], v[bj][1][1] * rn * gv[bj][1][1]); w.w = cvtpk(v[bj][1][2] * rn * gv[bj][1][2], v[bj][1][3] * rn * gv[bj][1][3]);
            bf16* dst = pn < 4 ? Q + (size_t)row * 1024 + (4 * pn + wc) * 64 + 8 * fq + 32 * bj : k_piece(KV, row, wc, bj, fq);
            *(u32x4*)dst = w; } }
    } else if (pn == 5) {
#pragma unroll
      for (int ai = 0; ai < 2; ++ai)
#pragma unroll
        for (int m = 0; m < 4; ++m) { const int row = row0 + 128 * ai + 16 * m; v_store_scaled(acc, ai, m, KV, row, wc, fq, rinv[row]); }
    } else if (pn <= 9) {
#pragma unroll
      for (int ai = 0; ai < 2; ++ai)
#pragma unroll
        for (int m = 0; m < 4; ++m) { const int row = row0 + 128 * ai + 16 * m; plain_store<1>(acc, ai, m, rinv[row], SG + (size_t)row * 1024 + 256 * (pn - 6) + 64 * wc + 8 * fq); }
    } else if (pn <= 11) {
#pragma unroll
      for (int ai = 0; ai < 2; ++ai)
#pragma unroll
        for (int m = 0; m < 4; ++m) { const int row = row0 + 128 * ai + 16 * m; plain_store<0>(acc, ai, m, 0.125f * rinv[row], IQ + (size_t)row * 512 + 256 * (pn - 10) + 64 * wc + 8 * fq); }
    } else {
      if (wc == 0) {
#pragma unroll
        for (int ai = 0; ai < 2; ++ai)
#pragma unroll
          for (int m = 0; m < 4; ++m) { const int row = row0 + 128 * ai + 16 * m; const float sc = rinv[row];
#pragma unroll
            for (int bj = 0; bj < 2; ++bj) { u32x4 w; w.x = cvtpk(acc[ai][bj][m][0][0] * sc, acc[ai][bj][m][0][1] * sc); w.y = cvtpk(acc[ai][bj][m][0][2] * sc, acc[ai][bj][m][0][3] * sc);
              w.z = cvtpk(acc[ai][bj][m][1][0] * sc, acc[ai][bj][m][1][1] * sc); w.w = cvtpk(acc[ai][bj][m][1][2] * sc, acc[ai][bj][m][1][3] * sc);
              *(u32x4*)(IK + (size_t)(row >> 5) * 2048 + (size_t)(((2 * bj + (fq >> 1)) * 64 + (fq & 1) * 32 + pi32(row & 31)) * 8)) = w; } }
      } else if (wc == 1 && fq == 0) {
#pragma unroll
        for (int ai = 0; ai < 2; ++ai)
#pragma unroll
          for (int m = 0; m < 4; ++m) { const int row = row0 + 128 * ai + 16 * m; float* d = IW + (size_t)row * 8; const float sc = 0.35355339059327373f * rinv[row];
            *(f32x4*)d = acc[ai][0][m][0] * sc; *(f32x4*)(d + 4) = acc[ai][0][m][1] * sc; }
      }
    }
  }
};
DI float row_rinv(const float* ssq, int row) {
  const f32x4* p = (const f32x4*)(ssq + (size_t)row * 16); const f32x4 a = p[0], b = p[1], c = p[2], d = p[3];
  const float t = (((a.x + a.y) + (a.z + a.w)) + ((b.x + b.y) + (b.z + b.w))) + (((c.x + c.y) + (c.z + c.w)) + ((d.x + d.y) + (d.z + d.w)));
  return rsqrtf(t * (1.0f / 1024.0f) + EPS);
}
struct EpiB {
  static constexpr bool PERM = false, AFTER_DRAIN = false;
  bf16 *Q, *KV, *SG; const float *qn_g, *kn_g; const LAS float* rl; float* KM; mutable int k;
  DI void operator()(const accq (&acc)[2][2][4][2], const pg8::Unit& u, int wr, int wc, int fr, int fq) const {
    const int pn = u.pn, row0 = u.pm * 256 + wr * 64 + fr; const LAS float* rinv2 = rl + (k & 1) * 256 - u.pm * 256; ++k;
    if (pn == 0 || (pn >= 2 && pn <= 5)) {
      float gv[2][2][4]; load_gain(gv, pn == 0 ? kn_g : qn_g, fq, pn == 0 ? 1.0f : C2);
      float cs[2][2][4];
#pragma unroll
      for (int bj = 0; bj < 2; ++bj)
#pragma unroll
        for (int n = 0; n < 2; ++n)
#pragma unroll
          for (int e = 0; e < 4; ++e) cs[bj][n][e] = 0.f;
#pragma unroll
      for (int ai = 0; ai < 2; ++ai)
#pragma unroll
        for (int m = 0; m < 4; ++m) { const int row = row0 + 128 * ai + 16 * m; const float ri = rinv2[row];
          float v[2][2][4]; float ss = 0.f;
#pragma unroll
          for (int bj = 0; bj < 2; ++bj)
#pragma unroll
            for (int n = 0; n < 2; ++n)
#pragma unroll
              for (int e = 0; e < 4; ++e) { v[bj][n][e] = acc[ai][bj][m][n][e] * ri; ss += v[bj][n][e] * v[bj][n][e]; }
          ss += __shfl_xor(ss, 16); ss += __shfl_xor(ss, 32);
          const float rn = rsqrtf(ss * (1.0f / 64.0f) + EPS);
#pragma unroll
          for (int bj = 0; bj < 2; ++bj) {
#pragma unroll
            for (int n = 0; n < 2; ++n)
#pragma unroll
              for (int e = 0; e < 4; ++e) { v[bj][n][e] = v[bj][n][e] * rn * gv[bj][n][e]; cs[bj][n][e] += v[bj][n][e]; }
            u32x4 w; w.x = cvtpk(v[bj][0][0], v[bj][0][1]); w.y = cvtpk(v[bj][0][2], v[bj][0][3]); w.z = cvtpk(v[bj][1][0], v[bj][1][1]); w.w = cvtpk(v[bj][1][2], v[bj][1][3]);
            bf16* dst = pn != 0 ? Q + (size_t)row * 1024 + (4 * (pn - 2) + wc) * 64 + 8 * fq + 32 * bj : k_piece(KV, row, wc, bj, fq);
            *(u32x4*)dst = w; } }
      if (pn == 0) {
        float* km = KM + ((size_t)((u.pm >> 3) * 4 + wc) * 8 + (u.pm & 7)) * 64 + 8 * fq;
#pragma unroll
        for (int bj = 0; bj < 2; ++bj)
#pragma unroll
          for (int n = 0; n < 2; ++n)
#pragma unroll
            for (int e = 0; e < 4; ++e) { float t = cs[bj][n][e]; t += __shfl_xor(t, 1); t += __shfl_xor(t, 2); t += __shfl_xor(t, 4); t += __shfl_xor(t, 8);
              if (fr == 0) atomicAdd(km + 32 * bj + 4 * n + e, t * (1.0f / 256.0f)); }
      }
    } else if (pn == 1) {
#pragma unroll
      for (int ai = 0; ai < 2; ++ai)
#pragma unroll
        for (int m = 0; m < 4; ++m) { const int row = row0 + 128 * ai + 16 * m; const float ri = rinv2[row];
          v_store_scaled(acc, ai, m, KV, row, wc, fq, ri); }
    } else {
#pragma unroll
      for (int ai = 0; ai < 2; ++ai)
#pragma unroll
        for (int m = 0; m < 4; ++m) { const int row = row0 + 128 * ai + 16 * m; plain_store<1>(acc, ai, m, rinv2[row], SG + (size_t)row * 1024 + 256 * (pn - 6) + 64 * wc + 8 * fq); }
    }
  }
};
DI void unpack8(const u32x4 w, float (&f)[8]) { f[0] = bflo(w.x); f[1] = bfhi(w.x); f[2] = bflo(w.y); f[3] = bfhi(w.y); f[4] = bflo(w.z); f[5] = bfhi(w.z); f[6] = bflo(w.w); f[7] = bfhi(w.w); }
struct EpiRes {
  static constexpr bool PERM = false, AFTER_DRAIN = false;
  const bf16* res; float* out; LAS unsigned char* stg0;
  DI void operator()(const accq (&acc)[2][2][4][2], const pg8::Unit& u, int wr, int wc, int fr, int fq) const {
    const int row0 = u.pm * 256 + wr * 64 + fr, col0 = u.pn * 256 + 64 * wc + 8 * fq; LAS unsigned char* stg = stg0 + (wr * 4 + wc) * 2304; const int lane = fq * 16 + fr, r8 = lane >> 3, p8 = lane & 7;
#pragma unroll
    for (int ai = 0; ai < 2; ++ai)
#pragma unroll
      for (int m = 0; m < 4; ++m) { const size_t off = (size_t)(row0 + 128 * ai + 16 * m) * 1024 + col0;
#pragma unroll
        for (int bj = 0; bj < 2; ++bj) { float f[8]; unpack8(*(const u32x4*)(res + off + 32 * bj), f);
          f32x4 o0 = acc[ai][bj][m][0], o1 = acc[ai][bj][m][1];
          o0.x += f[0]; o0.y += f[1]; o0.z += f[2]; o0.w += f[3]; o1.x += f[4]; o1.y += f[5]; o1.z += f[6]; o1.w += f[7];
          *(LAS f32x4*)(stg + fr * 144 + fq * 32) = o0; *(LAS f32x4*)(stg + fr * 144 + fq * 32 + 16) = o1;
          asm volatile("" ::: "memory");
          const f32x4 a = *(const LAS f32x4*)(stg + r8 * 144 + p8 * 16), b = *(const LAS f32x4*)(stg + (r8 + 8) * 144 + p8 * 16);
          float* ob = out + (size_t)(row0 - fr + 128 * ai + 16 * m) * 1024 + u.pn * 256 + 64 * wc + 32 * bj + 4 * p8;
          __builtin_nontemporal_store(a, (f32x4*)(ob + (size_t)r8 * 1024)); __builtin_nontemporal_store(b, (f32x4*)(ob + (size_t)(r8 + 8) * 1024));
          asm volatile("" ::: "memory"); } }
  }
};
struct EpiRes2 {
  static constexpr bool PERM = false, AFTER_DRAIN = false;
  bf16* xh; float* ssq;
  DI void operator()(const accq (&acc)[2][2][4][2], const pg8::Unit& u, int wr, int wc, int fr, int fq) const {
    const int row0 = u.pm * 256 + wr * 64 + fr, col0 = u.pn * 256 + 64 * wc + 8 * fq;
#pragma unroll
    for (int ai = 0; ai < 2; ++ai)
#pragma unroll
      for (int m = 0; m < 4; ++m) { const int row = row0 + 128 * ai + 16 * m; const size_t off = (size_t)row * 1024 + col0; float ss = 0.f;
#pragma unroll
        for (int bj = 0; bj < 2; ++bj) { float f[8]; unpack8(*(const u32x4*)(xh + off + 32 * bj), f);
#pragma unroll
          for (int n = 0; n < 2; ++n)
#pragma unroll
            for (int e = 0; e < 4; ++e) { f[4 * n + e] += acc[ai][bj][m][n][e]; ss += f[4 * n + e] * f[4 * n + e]; }
          u32x4 w; w.x = cvtpk(f[0], f[1]); w.y = cvtpk(f[2], f[3]); w.z = cvtpk(f[4], f[5]); w.w = cvtpk(f[6], f[7]);
          *(u32x4*)(xh + off + 32 * bj) = w; }
        ss += __shfl_xor(ss, 16); ss += __shfl_xor(ss, 32);
        if (fq == 0) ssq[(size_t)row * 16 + u.pn * 4 + wc] = ss; }
  }
};
DI int srccol_A(int gc) { if (gc < 3072) return gc; if (gc < 3136) return 3080 + (gc - 3072); if (gc < 3144) return 3072 + (gc - 3136); return -1; }
DI void trans_item(const float* W, int Ns, const float* gk, bf16* Wt, int item, int nblk, int kindA, LAS float* scr, int lane) {
  const int kb = item / nblk, nb = item % nblk, k0 = 64 * kb, gc0 = 32 * nb;
  const int n = lane & 31, gc = gc0 + n; const int sc = kindA ? srccol_A(gc) : gc;
#pragma unroll 8
  for (int i = 0; i < 32; ++i) { const int kk = 2 * i + (lane >> 5); float v = 0.f; if (sc >= 0) v = __builtin_nontemporal_load(W + (size_t)(k0 + kk) * Ns + sc); if (gk) v *= gk[k0 + kk]; scr[kk * 33 + n] = v; }
  asm volatile("s_waitcnt lgkmcnt(0)" ::: "memory");
  const int c = lane & 7;
#pragma unroll
  for (int j = 0; j < 4; ++j) { const int nn = (lane >> 3) + 8 * j; const LAS float* s = scr + (8 * c) * 33 + nn;
    u32x4 o; o.x = cvtpk(s[0 * 33], s[1 * 33]); o.y = cvtpk(s[2 * 33], s[3 * 33]); o.z = cvtpk(s[4 * 33], s[5 * 33]); o.w = cvtpk(s[6 * 33], s[7 * 33]);
    *(u32x4*)(Wt + (size_t)slot_of(gc0 + nn) * 1024 + k0 + 8 * c) = o; }
  asm volatile("s_waitcnt lgkmcnt(0)" ::: "memory");
}

DI int kidx(int r, int hi) { return 16 * (r >> 3) + 8 * hi + (r & 7); }
DI void k_dma(const char* ksrc  , unsigned voff  , unsigned lds_slot  ) {
  unsigned keep;
  asm volatile("s_waitcnt lgkmcnt(0)\n\ts_mov_b32 %0, m0\n\ts_mov_b32 m0, %3\n\ts_nop 0\n\t"
               "global_load_lds_dwordx4 %1, %2\n\tglobal_load_lds_dwordx4 %1, %2 offset:1024\n\tglobal_load_lds_dwordx4 %1, %2 offset:2048\n\tglobal_load_lds_dwordx4 %1, %2 offset:3072\n\t"
               "s_mov_b32 m0, %0" : "=&s"(keep) : "v"(voff), "s"(ksrc), "s"(lds_slot) : "memory");
}
DI void v_load(bf16x8 (&vf)[4], const char* vsrc  , unsigned voff) {
  asm volatile("global_load_dwordx4 %0, %4, %5\n\tglobal_load_dwordx4 %1, %4, %5 offset:1024\n\tglobal_load_dwordx4 %2, %4, %5 offset:2048\n\tglobal_load_dwordx4 %3, %4, %5 offset:3072"
               : "=&v"(vf[0]), "=&v"(vf[1]), "=&v"(vf[2]), "=&v"(vf[3]) : "v"(voff), "s"(vsrc) : "memory");
}
DI void kv_wait(bf16x8 (&vf)[4]) { asm volatile("s_waitcnt vmcnt(0)" : "+v"(vf[0]), "+v"(vf[1]), "+v"(vf[2]), "+v"(vf[3]) :: "memory"); }
DI void qk_tile(f32x16 (&c)[2], const LAS unsigned char* kslot  , const bf16x8 (&qf)[2][4]) {
  bf16x8 kf[4];
#pragma unroll
  for (int s = 0; s < 4; ++s) kf[s] = *(const LAS bf16x8*)(kslot + s * 1024);
#pragma unroll
  for (int j = 0; j < 2; ++j) {
    f32x16 z;
#pragma unroll
    for (int r = 0; r < 16; ++r) z[r] = 0.f;
    c[j] = MFMA32(kf[0], qf[j][0], z);
#pragma unroll
    for (int s = 1; s < 4; ++s) c[j] = MFMA32(kf[s], qf[j][s], c[j]);
  }
}
DI void add_bias(f32x16 (&c)[2], const LAS float* bt0, int dist0) {
#pragma unroll
  for (int j = 0; j < 2; ++j) { const LAS float* tp = bt0 + j * 192 + (dist0 + 8);
#pragma unroll
    for (int r = 0; r < 16; ++r) c[j][r] += tp[23 - (16 * (r >> 3) + (r & 7))]; }
}
template <int MODE> DI void sm_pv(f32x16 (&O)[2][2], float (&l)[2], const f32x16 (&c)[2], const bf16x8 (&vf4)[4], unsigned m) {
#pragma unroll
  for (int j = 0; j < 2; ++j) {
    float p[16]; float ls = 0.f;
#pragma unroll
    for (int r = 0; r < 16; ++r) {
      const float e = __builtin_amdgcn_exp2f(c[j][r]);
      if (MODE == 0) { const unsigned ext = (unsigned)__builtin_amdgcn_sbfe((int)m, r, 1); p[r] = __uint_as_float(__float_as_uint(e) & ext); }
      else p[r] = e;
      ls += p[r];
    }
    if (MODE == 1) ls = __uint_as_float(__float_as_uint(ls) & m);
    l[j] += ls;
    bf16x8 pk[2];
#pragma unroll
    for (int s = 0; s < 2; ++s) { u32x4 w; w.x = cvtpk(p[8 * s], p[8 * s + 1]); w.y = cvtpk(p[8 * s + 2], p[8 * s + 3]); w.z = cvtpk(p[8 * s + 4], p[8 * s + 5]); w.w = cvtpk(p[8 * s + 6], p[8 * s + 7]);
      if (MODE == 1) { w.x &= m; w.y &= m; w.z &= m; w.w &= m; }
      pk[s] = __builtin_bit_cast(bf16x8, w); }
#pragma unroll
    for (int dt = 0; dt < 2; ++dt)
#pragma unroll
      for (int s = 0; s < 2; ++s) O[j][dt] = MFMA32(vf4[dt * 2 + s], pk[s], O[j][dt]);
  }
}
DI void attn_store(const f32x16 (&O)[2][2], const float (&l)[2], const bf16* SG, bf16* OG, size_t row0, int head0, LAS unsigned char* stg, int lane) {
  const int q = lane & 31, hi = lane >> 5, rr = lane >> 3, pc = lane & 7;
  const size_t goff = (row0 + rr) * 1024 + (size_t)head0 * 64 + 8 * pc;
  u32x4 sg[2][4];
#pragma unroll
  for (int j = 0; j < 2; ++j)
#pragma unroll
    for (int i = 0; i < 4; ++i) sg[j][i] = *(const u32x4*)(SG + goff + (size_t)i * 8192 + j * 64);
  LAS unsigned char* wb = stg + q * 256; const int wt = ((q & 15) ^ hi) << 4;
  const LAS unsigned char* rb = stg + rr * 256; const int rt = ((2 * pc) ^ rr) << 4;
#pragma unroll
  for (int j = 0; j < 2; ++j) {
    const float lt = l[j] + __shfl_xor(l[j], 32); const float inv = 1.0f / lt;
#pragma unroll
    for (int dt = 0; dt < 2; ++dt)
#pragma unroll
      for (int a = 0; a < 4; ++a) {
        f32x4 v; v.x = O[j][dt][4 * a + 0] * inv; v.y = O[j][dt][4 * a + 1] * inv; v.z = O[j][dt][4 * a + 2] * inv; v.w = O[j][dt][4 * a + 3] * inv;
        *(LAS f32x4*)(wb + (wt ^ ((8 * dt + 2 * a) << 4))) = v;
      }
    asm volatile("" ::: "memory");
#pragma unroll
    for (int i = 0; i < 4; ++i) {
      const int x0 = rt ^ ((i & 1) << 7);
      const f32x4 a0 = *(const LAS f32x4*)(rb + i * 2048 + x0), a1 = *(const LAS f32x4*)(rb + i * 2048 + (x0 ^ 16));
      const u32x4 g = sg[j][i]; u32x4 w;
      w.x = cvtpk(a0.x * bflo(g.x), a0.y * bfhi(g.x)); w.y = cvtpk(a0.z * bflo(g.y), a0.w * bfhi(g.y));
      w.z = cvtpk(a1.x * bflo(g.z), a1.y * bfhi(g.z)); w.w = cvtpk(a1.z * bflo(g.w), a1.w * bfhi(g.w));
      *(u32x4*)(OG + goff + (size_t)i * 8192 + j * 64) = w;
    }
    asm volatile("" ::: "memory");
  }
}
DI void build_btab(LAS unsigned char* lds, const float* rel_bias, int tid_) {
  LAS float* bt = (LAS float*)(lds + L_BTAB);
  for (int i = tid_; i < 16 * 192; i += 512) { const int h = i / 192, dist = i % 192 - 31;
    bt[i] = dist < 0 ? -INFINITY : (dist < 128 ? (rel_bias[(int)BKT[dist] * 16 + h] - rel_bias[31 * 16 + h]) * LOG2E : 0.f); }
}
DI unsigned causal16(int q, int hi) { unsigned m = 0;
#pragma unroll
  for (int r = 0; r < 16; ++r) m |= (kidx(r, hi) <= q) ? (1u << r) : 0u;
  return m; }

DI void dsa_unit(LAS unsigned char* lds, const Ptrs& P, int b, int qt, int wave_) {
  int tid = wave_ * 64 + lane_id_hw(); asm volatile("" : "+v"(tid));
  const int lane = tid & 63, w = __builtin_amdgcn_readfirstlane(tid >> 6), q = lane & 31, hi = lane >> 5;
  const int t0 = 32 * qt, nkt = qt + 1; const size_t rowb = (size_t)b * SEQ;
  LAS unsigned short* maskl = (LAS unsigned short*)(lds + L_MASK);
  bf16x8 qf[2][4];
#pragma unroll
  for (int j = 0; j < 2; ++j)
#pragma unroll
    for (int s = 0; s < 4; ++s) qf[j][s] = *(const bf16x8*)(P.Q + (rowb + t0 + q) * 1024 + (2 * w + j) * 64 + 16 * s + 8 * hi);
  __syncthreads();
  if (qt >= 8) {
    const bf16* ikb = P.IK + (size_t)(b * 64) * 2048 + lane * 8;
    bf16x8 ikc[4], ikn[4];
#pragma unroll
    for (int s = 0; s < 4; ++s) ikc[s] = *(const bf16x8*)(ikb + (size_t)w * 2048 + 512 * s);
    LAS float* wl = (LAS float*)(lds + L_HIST);
    { f32x4 wv = {0.f, 0.f, 0.f, 0.f}; if (tid < 64) wv = *(const f32x4*)(P.IW + (rowb + t0) * 8 + tid * 4);
      const int row = tid >> 4, ch = tid & 15; const u32x4* src = (const u32x4*)(P.IQ + (rowb + t0 + row) * 512);
#pragma unroll
      for (int c = 0; c < 4; ++c) *(LAS u32x4*)(lds + L_IQ + row * IQ_STRIDE + (ch + 16 * c) * 16) = __builtin_nontemporal_load(src + ch + 16 * c);
      if (tid < 64) *(LAS f32x4*)(wl + tid * 4) = wv; }
    __syncthreads();
    unsigned pl[4][16];
#pragma unroll
    for (int B = 0; B < 4; ++B) {
#pragma unroll
      for (int h2 = 0; h2 < 2; ++h2) {
        const int kt = w + 8 * (2 * B + h2);
        if (2 * B + h2 < 7) { const int ktn = (kt + 8 < nkt) ? kt + 8 : w;
#pragma unroll
          for (int s = 0; s < 4; ++s) ikn[s] = *(const bf16x8*)(ikb + (size_t)ktn * 2048 + 512 * s); }
        float sc[16];
        if (2 * B + h2 == 0 || kt < nkt) {
#pragma unroll
          for (int s = 0; s < 4; ++s) asm volatile("" : "+v"(ikc[s]));
#pragma unroll
          for (int r = 0; r < 16; ++r) sc[r] = 0.f;
#pragma unroll 2
          for (int hd = 0; hd < 8; ++hd) {
            f32x16 c;
#pragma unroll
            for (int r = 0; r < 16; ++r) c[r] = 0.f;
#pragma unroll
            for (int s = 0; s < 4; ++s) { const bf16x8 bq = *(const LAS bf16x8*)(lds + L_IQ + q * IQ_STRIDE + (hd * 64 + 16 * s + 8 * hi) * 2); c = MFMA32(ikc[s], bq, c); }
            const float wh = wl[q * 8 + hd];
#pragma unroll
            for (int r = 0; r < 16; ++r) { const int ci_ = __builtin_bit_cast(int, (float)c[r]); sc[r] += wh * __builtin_bit_cast(float, ci_ > 0 ? ci_ : 0); asm("" : "+v"(sc[r])); }
          }
          if (kt == qt) {
#pragma unroll
            for (int r = 0; r < 16; ++r) if (kidx(r, hi) > q) sc[r] = -INFINITY;
          }
        } else {
#pragma unroll
          for (int r = 0; r < 16; ++r) sc[r] = -INFINITY;
        }
#pragma unroll
        for (int v = 0; v < 16; ++v) {
          if (h2 == 0) pl[B][v] = __builtin_bit_cast(unsigned, __builtin_amdgcn_cvt_pkrtz(sc[v], 0.f));
          else pl[B][v] |= __builtin_bit_cast(unsigned, __builtin_amdgcn_cvt_pkrtz(0.f, sc[v]));
        }
#pragma unroll
        for (int s = 0; s < 4; ++s) ikc[s] = ikn[s];
      }
#pragma unroll
      for (int v = 0; v < 16; ++v) { const unsigned u = pl[B][v]; pl[B][v] = u ^ (((u >> 15) & 0x00010001u) * 0x7FFFu); }
#define TR_STAGE(J, MJ) _Pragma("unroll") for (int k = 0; k < 16; ++k) if ((k & (J)) == 0) { const unsigned t = ((pl[B][k] >> (J)) ^ pl[B][k + (J)]) & (MJ); pl[B][k + (J)] ^= t; pl[B][k] ^= t << (J); }
      TR_STAGE(8, 0x00FF00FFu) TR_STAGE(4, 0x0F0F0F0Fu) TR_STAGE(2, 0x33333333u) TR_STAGE(1, 0x55555555u)
#undef TR_STAGE
      pl[B][15] = ~pl[B][15];
#pragma unroll
      for (int v = 0; v < 16; ++v) asm volatile("" : "+v"(pl[B][v]));
      __builtin_amdgcn_sched_barrier(0);
    }
    LAS unsigned* cb = (LAS unsigned*)(lds + L_HIST + 32 * 257 * 4);
    if (tid < 64) cb[tid] = 0u;
    __syncthreads();
    unsigned mm[4] = {0xFFFFFFFFu, 0xFFFFFFFFu, 0xFFFFFFFFu, 0xFFFFFFFFu}, gt[4] = {0u, 0u, 0u, 0u}, Gtot = 0u, prev0 = 0u, prev1 = 0u;
#pragma unroll
    for (int bit = 15; bit >= 0; --bit) {
      unsigned t4[4]; unsigned cnt = 0u;
#pragma unroll
      for (int B = 0; B < 4; ++B) { t4[B] = mm[B] & pl[B][bit]; cnt += (unsigned)__builtin_popcount(t4[B]); }
      LAS unsigned* cw = cb + ((bit & 1) ? 32 : 0) + q;
      __hip_atomic_fetch_add(cw, cnt, __ATOMIC_RELAXED, __HIP_MEMORY_SCOPE_WORKGROUP);
      __syncthreads();
      const unsigned run = *cw; unsigned tot;
      if (bit & 1) { tot = run - prev1; prev1 = run; } else { tot = run - prev0; prev0 = run; }
      const bool acc1 = (Gtot + tot) >= 256u;
#pragma unroll
      for (int B = 0; B < 4; ++B) { if (acc1) mm[B] = t4[B]; else { gt[B] |= t4[B]; mm[B] ^= t4[B]; } }
      if (!acc1) Gtot += tot;
    }
    LAS unsigned short* tm = (LAS unsigned short*)(lds + L_HIST + 1024); LAS unsigned short* pf = (LAS unsigned short*)(lds + L_HIST + 1024 + 8192);
#pragma unroll
    for (int B = 0; B < 4; ++B) {
      tm[((w + 8 * (2 * B)) * 32 + q) * 2 + hi] = (unsigned short)(mm[B] & 0xFFFFu);
      tm[((w + 8 * (2 * B + 1)) * 32 + q) * 2 + hi] = (unsigned short)(mm[B] >> 16);
    }
    __syncthreads();
#pragma unroll
    for (int e = 0; e < 4; ++e) {
      const int qq = 4 * w + e;
      const unsigned c = (unsigned)__builtin_popcount(((const LAS unsigned*)tm)[lane * 32 + qq]);
      unsigned incl = c;
#pragma unroll
      for (int o = 1; o < 64; o <<= 1) { const unsigned t = __shfl_up(incl, o); if (lane >= o) incl += t; }
      pf[lane * 32 + qq] = (unsigned short)(incl - c);
    }
    __syncthreads();
    { const unsigned need = 256u - Gtot;
#pragma unroll
      for (int B = 0; B < 4; ++B) {
        unsigned sel = gt[B];
#pragma unroll
        for (int h2 = 0; h2 < 2; ++h2) {
          const unsigned t16 = (mm[B] >> (16 * h2)) & 0xFFFFu;
          if (t16) {
            const int kt = w + 8 * (2 * B + h2);
            const unsigned pair = ((const LAS unsigned*)tm)[kt * 32 + q], base = pf[kt * 32 + q];
            const unsigned c0 = (unsigned)__builtin_popcount(pair & 0xFFu), c1 = (unsigned)__builtin_popcount(pair & 0xFF0000u), c2 = (unsigned)__builtin_popcount(pair & 0xFF00u);
            const unsigned offL = base + (hi ? c0 : 0u), offH = base + (hi ? c0 + c1 + c2 : c0 + c1);
            unsigned rem = t16;
            while (rem) { const int pos = __builtin_ctz(rem); rem &= rem - 1u;
              const unsigned below = (unsigned)__builtin_popcount(t16 & ((1u << pos) - 1u) & (pos >= 8 ? 0xFF00u : 0xFFu));
              if ((pos >= 8 ? offH : offL) + below < need) sel |= 1u << (pos + 16 * h2); }
          }
        }
        if (w + 8 * (2 * B) < nkt) maskl[(w + 8 * (2 * B)) * 64 + lane] = (unsigned short)(sel & 0xFFFFu);
        if (w + 8 * (2 * B + 1) < nkt) maskl[(w + 8 * (2 * B + 1)) * 64 + lane] = (unsigned short)(sel >> 16);
      } }
  } else {
    const unsigned cm = causal16(q, hi);
#pragma unroll
    for (int i = 0; i < 8; ++i) { const int kt = w + 8 * i; if (kt < nkt) maskl[kt * 64 + lane] = (unsigned short)(kt == qt ? cm : 0xFFFFu); }
  }
  __syncthreads();
  const int g = w >> 1;
  const bf16* img = P.KV + (size_t)(b * 64) * 16384;
  const unsigned lds0 = (unsigned)(uintptr_t)lds;
#pragma unroll
  for (int j = 0; j < 2; ++j)
#pragma unroll
    for (int s = 0; s < 4; ++s) asm volatile("" : "+v"(qf[j][s]));
  f32x16 O[2][2]; float l[2] = {0.f, 0.f};
#pragma unroll
  for (int j = 0; j < 2; ++j)
#pragma unroll
    for (int dt = 0; dt < 2; ++dt)
#pragma unroll
      for (int r = 0; r < 16; ++r) O[j][dt][r] = 0.f;
  const LAS float* bt0 = (const LAS float*)(lds + L_BTAB) + (2 * w) * 192;
  LAS unsigned char* ringp = lds + 65536 + w * 8192;
  const char* ksrc = (const char*)img + g * 4096; const unsigned voff = (unsigned)lane * 16u;
  const unsigned kring = lds0 + (unsigned)w * 8192u; const LAS unsigned char* kl = lds + w * 8192 + lane * 16;
#define TSRC(t_) (ksrc + (size_t)((t_) < nkt ? (t_) : nkt - 1) * 32768)
  bf16x8 vA[4], vB[4]; f32x16 cA[2], cB[2];
  k_dma(TSRC(0), voff, kring); v_load(vA, TSRC(0) + 16384, voff); k_dma(TSRC(1), voff, kring + 4096u);
  kv_wait(vA);
  qk_tile(cA, kl, qf);
#pragma unroll 1
  for (int kt = 0; ; kt += 2) {
    k_dma(TSRC(kt + 2), voff, kring); v_load(vB, TSRC(kt + 1) + 16384, voff);
    if (qt - kt <= 4) add_bias(cA, bt0, (t0 + q) - (32 * kt + 8 * hi));
    { const unsigned m16 = maskl[kt * 64 + lane];
      qk_tile(cB, kl + 4096, qf); sm_pv<0>(O, l, cA, vA, m16); }
    kv_wait(vB);
    if (kt + 1 >= nkt) break;
    k_dma(TSRC(kt + 3), voff, kring + 4096u); v_load(vA, TSRC(kt + 2) + 16384, voff);
    if (qt - (kt + 1) <= 4) add_bias(cB, bt0, (t0 + q) - (32 * (kt + 1) + 8 * hi));
    { const unsigned m16 = maskl[(kt + 1) * 64 + lane];
      qk_tile(cA, kl, qf); sm_pv<0>(O, l, cB, vB, m16); }
    kv_wait(vA);
    if (kt + 2 >= nkt) break;
  }
#undef TSRC
  { int tid2 = lane_id_hw(); asm volatile("" : "+v"(tid2)); const int lane2 = tid2 & 63;
    attn_store(O, l, P.SG, P.OG, rowb + t0, 2 * w, ringp, lane2); }
}

DI void moba_unit(LAS unsigned char* lds, const Ptrs& P, int b, int qt, int wave_) {
  int tid = wave_ * 64 + lane_id_hw(); asm volatile("" : "+v"(tid));
  const int lane = tid & 63, w = __builtin_amdgcn_readfirstlane(tid >> 6), q = lane & 31, hi = lane >> 5;
  const int t0 = 32 * qt, ob = qt >> 3; const size_t rowb = (size_t)b * SEQ;
  LAS unsigned char* selm = lds + L_SELM; LAS unsigned* blkw = (LAS unsigned*)(lds + L_BLK);
  bf16x8 qf[2][4];
#pragma unroll
  for (int j = 0; j < 2; ++j)
#pragma unroll
    for (int s = 0; s < 4; ++s) qf[j][s] = *(const bf16x8*)(P.Q + (rowb + t0 + q) * 1024 + (2 * w + j) * 64 + 16 * s + 8 * hi);
  __syncthreads();
  if (tid == 0) blkw[0] = 0u;
  __syncthreads();
  if (ob > 0) {
    const int qq = tid & 31, gg = (tid >> 5) & 3, part = tid >> 7;
    float gs[7];
#pragma unroll
    for (int n = 0; n < 7; ++n) gs[n] = 0.f;
    const bf16* qp = P.Q + (rowb + t0 + qq) * 1024 + gg * 256 + part * 16;
#pragma unroll
    for (int c = 0; c < 2; ++c) {
      float qs[8];
#pragma unroll
      for (int e = 0; e < 8; ++e) qs[e] = 0.f;
#pragma unroll
      for (int j = 0; j < 4; ++j) { const u32x4 v = *(const u32x4*)(qp + j * 64 + c * 8);
        qs[0] += bflo(v.x); qs[1] += bfhi(v.x); qs[2] += bflo(v.y); qs[3] += bfhi(v.y); qs[4] += bflo(v.z); qs[5] += bfhi(v.z); qs[6] += bflo(v.w); qs[7] += bfhi(v.w); }
#pragma unroll
      for (int n = 0; n < 7; ++n) if (n < ob) { const f32x4* km = (const f32x4*)(P.KM + ((size_t)(b * 4 + gg) * 8 + n) * 64 + part * 16 + c * 8); const f32x4 k0 = km[0], k1 = km[1];
        gs[n] += (qs[0] * k0.x + qs[1] * k0.y + qs[2] * k0.z + qs[3] * k0.w) + (qs[4] * k1.x + qs[5] * k1.y + qs[6] * k1.z + qs[7] * k1.w); }
    }
    LAS float* gp = (LAS float*)lds + (size_t)(part * 128 + gg * 32 + qq) * 8;
#pragma unroll
    for (int n = 0; n < 7; ++n) gp[n] = gs[n];
  }
  __syncthreads();
  if (tid < 128) {
    const int qq = tid & 31, gg = tid >> 5; unsigned sel = 0;
    if (ob > 0) {
      float gs[7]; const LAS float* gp = (const LAS float*)lds + (size_t)(gg * 32 + qq) * 8;
#pragma unroll
      for (int n = 0; n < 7; ++n) gs[n] = (n < ob) ? ((gp[n] + gp[1024 + n]) + (gp[2048 + n] + gp[3072 + n])) : -INFINITY;
#pragma unroll
      for (int n = 0; n < 7; ++n) { if (n < ob) { int rank = 0;
#pragma unroll
          for (int m = 0; m < 7; ++m) if (m != n && m < ob) rank += ((gs[m] > gs[n]) || (gs[m] == gs[n] && m < n)) ? 1 : 0;
          if (rank < 3) sel |= 1u << n; } }
    }
    selm[gg * 32 + qq] = (unsigned char)sel;
    if (sel) __hip_atomic_fetch_or(blkw, sel, __ATOMIC_RELAXED, __HIP_MEMORY_SCOPE_WORKGROUP);
  }
  __syncthreads();
  const int g = w >> 1;
  const unsigned mysel = selm[g * 32 + q];
  const unsigned blk = (unsigned)__builtin_amdgcn_readfirstlane(blkw[0]) | (1u << ob);
  const bf16* img = P.KV + (size_t)(b * 64) * 16384;
  const unsigned lds0 = (unsigned)(uintptr_t)lds;
#pragma unroll
  for (int j = 0; j < 2; ++j)
#pragma unroll
    for (int s = 0; s < 4; ++s) asm volatile("" : "+v"(qf[j][s]));
  f32x16 O[2][2]; float l[2] = {0.f, 0.f};
#pragma unroll
  for (int j = 0; j < 2; ++j)
#pragma unroll
    for (int dt = 0; dt < 2; ++dt)
#pragma unroll
      for (int r = 0; r < 16; ++r) O[j][dt][r] = 0.f;
  const LAS float* bt0 = (const LAS float*)(lds + L_BTAB) + (2 * w) * 192;
#define NEXT_TILE(kt_, out_) do { int kn_ = (kt_) + 1; if (kn_ > qt) kn_ = -1; else if (((blk >> (kn_ >> 3)) & 1u) == 0u) kn_ = 8 * ((kn_ >> 3) + __builtin_ctz(blk >> (kn_ >> 3))); (out_) = kn_; } while (0)
  LAS unsigned char* ringp = lds + 65536 + w * 8192;
  const char* ksrc = (const char*)img + g * 4096; const unsigned voff = (unsigned)lane * 16u;
  const unsigned kring = lds0 + (unsigned)w * 8192u; const LAS unsigned char* kl = lds + w * 8192 + lane * 16;
  int ta = 8 * __builtin_ctz(blk), tb, tc, td;
  NEXT_TILE(ta, tb); tc = -1; if (tb >= 0) NEXT_TILE(tb, tc);
  const int tfirst = ta;
#define TSRC(t_) (ksrc + (size_t)((t_) >= 0 ? (t_) : tfirst) * 32768)
#define MOBA_SM(C, VF, KT) do { const int n_ = (KT) >> 3; const unsigned lm_ = (n_ < ob) ? (0u - ((mysel >> n_) & 1u)) : 0xFFFFFFFFu; sm_pv<1>(O, l, C, VF, lm_); } while (0)
  bf16x8 vA[4], vB[4]; f32x16 cA[2], cB[2];
  k_dma(TSRC(ta), voff, kring); v_load(vA, TSRC(ta) + 16384, voff); k_dma(TSRC(tb), voff, kring + 4096u);
  kv_wait(vA);
  qk_tile(cA, kl, qf);
#pragma unroll 1
  while (true) {
    k_dma(TSRC(tc), voff, kring); v_load(vB, TSRC(tb) + 16384, voff);
    if (qt - ta <= 4) add_bias(cA, bt0, (t0 + q) - (32 * ta + 8 * hi));
    qk_tile(cB, kl + 4096, qf); MOBA_SM(cA, vA, ta);
    kv_wait(vB);
    if (tb < 0) break;
    td = -1; if (tc >= 0) NEXT_TILE(tc, td);
    k_dma(TSRC(td), voff, kring + 4096u); v_load(vA, TSRC(tc) + 16384, voff);
    if (qt - tb <= 4) add_bias(cB, bt0, (t0 + q) - (32 * tb + 8 * hi));
    qk_tile(cA, kl, qf); MOBA_SM(cB, vB, tb);
    kv_wait(vA);
    if (tc < 0) break;
    ta = tc; tb = td; tc = -1; if (tb >= 0) NEXT_TILE(tb, tc);
  }
#undef MOBA_SM
#undef TSRC
#undef NEXT_TILE
  { int tid2 = lane_id_hw(); asm volatile("" : "+v"(tid2)); const int lane2 = tid2 & 63;
    attn_store(O, l, P.SG, P.OG, rowb + t0, 2 * w, ringp, lane2); }
}

__global__ void __launch_bounds__(512, 2) fwd(Args args) {
  extern __shared__ __attribute__((aligned(16))) unsigned char lds_raw[];
  LAS unsigned char* lds = (LAS unsigned char*)lds_raw;
  const int wave = __builtin_amdgcn_readfirstlane((int)threadIdx.x >> 6);
#define FRESH_TID(t_) int t_ = wave * 64 + lane_id_hw(); asm volatile("" : "+v"(t_))
  const int G = gridDim.x, bx = blockIdx.x;
  const int vcu = (G % 8 == 0) ? (bx % 8) * (G / 8) + bx / 8 : bx;
  LAS unsigned long long* ptab = (LAS unsigned long long*)(lds + L_MISC + 64);
  { FRESH_TID(tid0);
    if (tid0 < 16) { const unsigned long long* ka = (const unsigned long long*)__builtin_amdgcn_kernarg_segment_ptr(); ptab[tid0] = ka[tid0]; ((LAS unsigned*)(lds + L_MISC))[tid0] = 0u; }
    __syncthreads(); }
#define TABPTR(k) ((unsigned char*)(__attribute__((address_space(1))) unsigned char*)(((unsigned long long)(unsigned)__builtin_amdgcn_readfirstlane((int)(ptab[(k)] >> 32)) << 32) | (unsigned long long)(unsigned)__builtin_amdgcn_readfirstlane((int)(unsigned)ptab[(k)])))
#define LOAD_PTRS() Ptrs P; { asm volatile("" ::: "memory"); unsigned char* ws = TABPTR(15); \
  P.x = (const float*)TABPTR(0); P.norm_a_g = (const float*)TABPTR(1); P.w_in_a = (const float*)TABPTR(2); P.qn_a_g = (const float*)TABPTR(3); P.kn_a_g = (const float*)TABPTR(4); P.w_out_a = (const float*)TABPTR(5); P.rel_bias = (const float*)TABPTR(6); \
  P.norm_kv_g = (const float*)TABPTR(7); P.w_kv = (const float*)TABPTR(8); P.kn_b_g = (const float*)TABPTR(9); P.norm_b_g = (const float*)TABPTR(10); P.w_in_b = (const float*)TABPTR(11); P.qn_b_g = (const float*)TABPTR(12); P.w_out_b = (const float*)TABPTR(13); \
  P.out = (float*)TABPTR(14); \
  P.WtA = (bf16*)(ws + WS_WA); P.WtOA = (bf16*)(ws + WS_WOA); P.WtB = (bf16*)(ws + WS_WB); P.WtOB = (bf16*)(ws + WS_WOB); \
  P.XN = (bf16*)(ws + WS_XN); P.Q = (bf16*)(ws + WS_Q); P.KV = (bf16*)(ws + WS_K); P.SG = (bf16*)(ws + WS_SG); \
  P.IQ = (bf16*)(ws + WS_IQ); P.IK = (bf16*)(ws + WS_IK); P.OG = (bf16*)(ws + WS_OG); \
  P.IW = (float*)(ws + WS_IW); P.KM = (float*)(ws + WS_KM); P.RINV = (float*)(ws + WS_KM + 524288); P.SSQ = (float*)(ws + WS_H1); }
  const int lo = args.ph_lo, hi = args.ph_hi;
#ifndef PH_MASK
#define PH_MASK 0x1ff
#endif
#ifndef REP_MASK
#define REP_MASK 0
#endif
#define IN(k) (((PH_MASK >> (k)) & 1) && lo <= (k) && (k) < hi)
#define NREP(k) ((((REP_MASK) >> (k)) & 1) ? 2 : 1)
#if MK_N_LAUNCHES == 1
  const bool grouped = (G == 256);
  XcdBarrier xbar = xcd_barrier_post((unsigned*)TABPTR(15), (volatile LAS unsigned*)(lds + L_MISC), wave == 0 && lane_id_hw() == 0, (unsigned)G);
  XcdBarrier xbarL = xcd_barrier_post((unsigned*)(TABPTR(15) + 16384 * (1 + (bx & 7))), (volatile LAS unsigned*)(lds + L_MISC) + 2, wave == 0 && lane_id_hw() == 0, (unsigned)(G / 8));
#define SEAM(k) do { if (IN(k) && (hi > (k) + 1)) { if ((k) == 0 || !grouped) xcd_barrier(xbar, wave == 0 && lane_id_hw() == 0); else xcd_barrier(xbarL, wave == 0 && lane_id_hw() == 0); } } while (0)
#else
#define SEAM(k) do { } while (0)
#endif
  const int gw = vcu * 8 + wave, NGW = G * 8;

  if (IN(0)) {
    LOAD_PTRS();
    FRESH_TID(tid); const int lane = tid & 63;
    LAS float* scr = (LAS float*)(lds + wave * 8448);
    constexpr int I_A = 16 * (NCOL_A / 32), I_O = 16 * 32, I_KV = 16 * 16, I_B = 16 * 64;
    constexpr int NITEMS = I_A + I_O + I_KV + I_B + I_O;
#define P0_ITEM(it_) do { int r = (it_); \
      if (r < I_A) { trans_item(P.w_in_a, 3144, P.norm_a_g, P.WtA, r, NCOL_A / 32, 1, scr, lane); break; } r -= I_A; \
      if (r < I_O) { trans_item(P.w_out_a, 1024, nullptr, P.WtOA, r, 32, 0, scr, lane); break; } r -= I_O; \
      if (r < I_KV) { trans_item(P.w_kv, 512, P.norm_kv_g, P.WtB, r, 16, 0, scr, lane); break; } r -= I_KV; \
      if (r < I_B) { trans_item(P.w_in_b, 2048, P.norm_b_g, P.WtB + (size_t)512 * 1024, r, 64, 0, scr, lane); break; } r -= I_B; \
      trans_item(P.w_out_b, 1024, nullptr, P.WtOB, r, 32, 0, scr, lane); } while (0)
    int itw = gw;
    for (int m = gw; m < MTOK; m += 4 * NGW) {
      f32x4 v[4][4]; float ss[4];
#pragma unroll
      for (int u = 0; u < 4; ++u) { const int mm = m + u * NGW; const f32x4* xr = (const f32x4*)(P.x + (size_t)(mm < MTOK ? mm : m) * 1024) + lane;
#pragma unroll
        for (int j = 0; j < 4; ++j) v[u][j] = __builtin_nontemporal_load(xr + 64 * j); }
      if (itw < NITEMS) { P0_ITEM(itw); itw += NGW; }
#pragma unroll
      for (int u = 0; u < 4; ++u) { float a = 0.f;
#pragma unroll
        for (int j = 0; j < 4; ++j) a += (v[u][j].x * v[u][j].x + v[u][j].y * v[u][j].y) + (v[u][j].z * v[u][j].z + v[u][j].w * v[u][j].w);
        ss[u] = a; }
#pragma unroll
      for (int o = 1; o < 64; o <<= 1) {
#pragma unroll
        for (int u = 0; u < 4; ++u) ss[u] += __shfl_xor(ss[u], o); }
#pragma unroll
      for (int u = 0; u < 4; ++u) { const int mm = m + u * NGW; if (mm < MTOK) {
          u32x2* o8 = (u32x2*)(P.XN + (size_t)mm * 1024) + lane;
#pragma unroll
          for (int j = 0; j < 4; ++j) { u32x2 w; w.x = cvtpk(v[u][j].x, v[u][j].y); w.y = cvtpk(v[u][j].z, v[u][j].w); o8[64 * j] = w; }
          if (lane == 0) P.RINV[mm] = rsqrtf(ss[u] * (1.0f / 1024.0f) + EPS); } }
    }
    for (; itw < NITEMS; itw += NGW) P0_ITEM(itw);
#undef P0_ITEM
    for (int i = gw * 64 + lane; i < NBATCH * 4 * 8 * 64; i += NGW * 64) P.KM[i] = 0.f;
    __syncthreads();
  }
  SEAM(0);
  if (IN(1)) for (int rep_ = 0; rep_ < NREP(1); ++rep_) {
    LOAD_PTRS();
    pg8::Gemm g{P.XN, P.WtA, MTOK, NCOL_A, 1024}; OrderR S; S.init(MTOK, NCOL_A, G, bx); S.rv = P.RINV; S.ldsb = (unsigned)(uintptr_t)(lds + L_EPI); S.wv = wave; S.k = 0;
    EpiA E{P.Q, P.KV, P.SG, P.IQ, P.IK, P.IW, P.qn_a_g, P.kn_a_g, (const LAS float*)(lds + L_EPI), 0};
    pg8::gemm_phase<EpiA, OrderR, true, true>(lds, g, S, E, wave);
    __syncthreads();
  }
  SEAM(1);
  if (IN(2)) for (int rep_ = 0; rep_ < NREP(2); ++rep_) {
    LOAD_PTRS();
    { FRESH_TID(tidb); build_btab(lds, P.rel_bias, tidb); }
#pragma unroll 1
    for (int i = 0; ; ++i) { int b, qt;
      if (G == 256) { if (i >= 4) break; const int c = vcu & 31; b = 2 * (vcu >> 5) + (i >> 1); qt = (i & 1) ? c : 63 - c; }
      else { const int u = vcu + i * G; if (u >= 1024) break; b = u >> 6; qt = 63 - (u & 63); }
      dsa_unit(lds, P, b, qt, wave); }
    __syncthreads();
  }
  SEAM(2);
  if (IN(3)) for (int rep_ = 0; rep_ < NREP(3); ++rep_) {
    LOAD_PTRS();
    pg8::Gemm g{P.OG, P.WtOA, MTOK, 1024, 1024}; pg8::StaticOrder S; S.init(MTOK, 1024, G, bx);
    EpiRes2 E{P.XN, P.SSQ};
    pg8::gemm_phase<EpiRes2, pg8::StaticOrder, true, true>(lds, g, S, E, wave);
    __syncthreads();
  }
  SEAM(3);
  if (IN(4)) { LOAD_PTRS(); FRESH_TID(tidr);
    if (G == 256) { if (tidr < 128) { const int r = 4096 * (bx & 7) + 128 * (bx >> 3) + tidr; P.RINV[r] = row_rinv(P.SSQ, r); } }
    else for (int r = bx * 512 + tidr; r < MTOK; r += G * 512) P.RINV[r] = row_rinv(P.SSQ, r); }
  SEAM(4);
  if (IN(5)) for (int rep_ = 0; rep_ < NREP(5); ++rep_) {
    LOAD_PTRS();
    pg8::Gemm g{P.XN, P.WtB, MTOK, NCOL_B, 1024}; OrderR S; S.init(MTOK, NCOL_B, G, bx); S.rv = P.RINV; S.ldsb = (unsigned)(uintptr_t)(lds + L_EPI); S.wv = wave; S.k = 0;
    EpiB E{P.Q, P.KV, P.SG, P.qn_b_g, P.kn_b_g, (const LAS float*)(lds + L_EPI), P.KM, 0};
    pg8::gemm_phase<EpiB, OrderR, true, true>(lds, g, S, E, wave);
    __syncthreads();
  }
  SEAM(5);
  if (IN(7)) for (int rep_ = 0; rep_ < NREP(7); ++rep_) {
    LOAD_PTRS();
    { FRESH_TID(tidb); build_btab(lds, P.rel_bias, tidb); }
#pragma unroll 1
    for (int i = 0; ; ++i) { int b, qt;
      if (G == 256) { if (i >= 4) break; const int c = vcu & 31; b = 2 * (vcu >> 5) + (i >> 1); qt = (i & 1) ? c : 63 - c; }
      else { const int u = vcu + i * G; if (u >= 1024) break; b = u >> 6; qt = 63 - (u & 63); }
      moba_unit(lds, P, b, qt, wave); }
    __syncthreads();
  }
  SEAM(7);
  if (IN(8)) for (int rep_ = 0; rep_ < NREP(8); ++rep_) {
    LOAD_PTRS();
    pg8::Gemm g{P.OG, P.WtOB, MTOK, 1024, 1024}; pg8::StaticOrder S; S.init(MTOK, 1024, G, bx);
    EpiRes E{P.XN, P.out, lds + L_EPI};
    pg8::gemm_phase<EpiRes, pg8::StaticOrder, true, true>(lds, g, S, E, wave);
  }
#undef IN
#undef SEAM
}

extern "C" void kernel_launch(void* const* d_in, const int* in_sizes, int n_in, void* d_out, int out_size, void* d_ws, size_t ws_size, hipStream_t stream) {
  static int grid = 0;
  if (grid == 0) {
    if (n_in != 14 || out_size != MTOK * DM || ws_size < WS_END) { fprintf(stderr, "kernel_launch: unexpected problem (n_in %d, out %d, ws %zu)\n", n_in, out_size, ws_size); grid = -1; return; }
    int dev = 0, cus = 0, per_cu = 0;
    if (hipGetDevice(&dev) != hipSuccess || hipDeviceGetAttribute(&cus, hipDeviceAttributeMultiprocessorCount, dev) != hipSuccess) { grid = -1; return; }
    if (hipFuncSetAttribute((const void*)fwd, hipFuncAttributeMaxDynamicSharedMemorySize, LDS_BYTES) != hipSuccess) { fprintf(stderr, "kernel_launch: hipFuncSetAttribute failed\n"); grid = -1; return; }
    if (hipOccupancyMaxActiveBlocksPerMultiprocessor(&per_cu, (const void*)fwd, 512, LDS_BYTES) != hipSuccess || per_cu < 1) { fprintf(stderr, "kernel_launch: occupancy query says %d\n", per_cu); per_cu = 1; }
    (void)hipGetLastError();
    grid = cus;
  }
  if (grid < 0) return;
  Args a{};
  for (int i = 0; i < 14; ++i) a.in[i] = (const float*)d_in[i];
  a.out = (float*)d_out; a.ws = (unsigned char*)d_ws;
#if MK_N_LAUNCHES == 1
  if (hipMemsetAsync(d_ws, 0, 16384 * 9, stream) != hipSuccess) { fprintf(stderr, "kernel_launch: memset of the barrier words failed\n"); return; }
  a.ph_lo = 0; a.ph_hi = NPHASE;
  void* kargs[] = {&a};
  hipError_t e = hipLaunchCooperativeKernel((const void*)fwd, dim3(grid), dim3(512), kargs, LDS_BYTES, stream);
  if (e != hipSuccess) fprintf(stderr, "kernel_launch: cooperative launch failed: %s\n", hipGetErrorString(e));
#else
#ifndef HOST_REP_MASK
#define HOST_REP_MASK 0
#endif
  for (int p = 0; p < NPHASE; ++p) { a.ph_lo = p; a.ph_hi = p + 1; for (int r = 0; r < (((HOST_REP_MASK >> p) & 1) ? 2 : 1); ++r) hipLaunchKernelGGL(fwd, dim3(grid), dim3(512), LDS_BYTES, stream, a); }
#endif
}
```

```cpp
#include <hip/hip_runtime.h>
#include <hip/hip_cooperative_groups.h>
#include <cstdio>
#include <cstdint>
__device__ __forceinline__ int lane_id_hw() { unsigned z = 0u; asm volatile("" : "+v"(z)); return (int)__builtin_amdgcn_mbcnt_hi(~0u, __builtin_amdgcn_mbcnt_lo(~0u, z)); }
namespace pg8 {
#define PG8_LAS __attribute__((address_space(3)))
typedef unsigned short bf16_t;
typedef short bf16x8 __attribute__((ext_vector_type(8)));
typedef float f32x4 __attribute__((ext_vector_type(4)));
typedef unsigned u32x4 __attribute__((ext_vector_type(4)));
constexpr int BM = 256, BK = 64, HALF = 128, HTB = HALF * BK * 2  , STAGE_BYTES = 8 * HTB, NXCD = 8, WGM = 8;

__host__ __device__ __forceinline__ int lds_byte(int r, int c) { const int st = (r >> 4) * 2 + (c >> 5), rr = r & 15, cc = c & 31, ob = rr * 64 + cc * 2; return st * 1024 + (ob ^ (((ob >> 9) & 1) << 5)); }
__host__ __device__ __forceinline__ void stage_rc(int b, int& R, int& C) { const int st = b / 1024, sb = b % 1024, swz = sb ^ (((sb >> 9) & 1) << 5); R = (st >> 1) * 16 + swz / 64; C = (st & 1) * 32 + (swz % 64) / 2; }
__host__ __device__ __forceinline__ int perm32(int rho) { const int n = rho >> 4, i = rho & 15; return 8 * (i >> 2) + 4 * n + (i & 3); }

struct Unit { int pm, pn; };
struct Gemm { const bf16_t* A; const bf16_t* Bt; int M, N, K; };

struct StaticOrder {
    int nM, nN, nwg, G, c;
    __host__ __device__ void init(int M, int N, int G_, int c_) { nM = M / BM; nN = N / BM; nwg = nM * nN; G = G_; c = c_; }
    __host__ __device__ bool next(int i, Unit& u) const {
        const long L = (long)i * G + c; if (L >= nwg) return false;
        int wgid = (int)L; { const int q = nwg / NXCD, r = nwg % NXCD, xcd = wgid % NXCD, off = wgid / NXCD; wgid = (xcd < r ? xcd * (q + 1) : r * (q + 1) + (xcd - r) * q) + off; }
        const int nig = WGM * nN, gid = wgid / nig, fm = gid * WGM, gsz = (nM - fm) < WGM ? (nM - fm) : WGM;
        u.pm = fm + ((wgid % nig) % gsz); u.pn = (wgid % nig) / gsz; return true;
    }
    __device__ __forceinline__ void a_ready(const Unit&) const {}
    __device__ __forceinline__ void done(const Unit&) const {}
};

template <class Epi, class Sched, bool ALIGN_EPI = false, bool SP2 = false>
__device__ __forceinline__ void gemm_phase(PG8_LAS unsigned char* lds, const Gemm g, const Sched& S, const Epi& E, int wave_) {
    const int tid = wave_ * 64 + lane_id_hw(), wid = __builtin_amdgcn_readfirstlane(tid >> 6), lane = tid & 63, wr = wid >> 2, wc = wid & 3, fr = lane & 15, fq = lane >> 4;
    const int K = g.K, nt = K / BK;
    unsigned voffA[2], voffB[2];
#pragma unroll
    for (int i = 0; i < 2; ++i) { int R, C; stage_rc(tid * 16 + i * 8192, R, C); const int Rb = Epi::PERM ? ((R & ~31) + perm32(R & 31)) : R;
        voffA[i] = (unsigned)(R * K + C) * 2u; voffB[i] = (unsigned)(Rb * K + C) * 2u; }
    const size_t kstep = (size_t)(BK * 2);
    const size_t hstep = (size_t)HALF * K * 2;
    const size_t tstep = 2 * hstep;
    const unsigned ldsw = (unsigned)wid * 1024u;
    const int aoff = lds_byte(wr * 64 + fr, fq * 8), boff = lds_byte(wc * 32 + fr, fq * 8);
#define PG8_SA(b, h) (((b) * 2 + (h)) * HTB)
#define PG8_SB(b, h) ((4 + (b) * 2 + (h)) * HTB)
#define PG8_STAGE(bufoff, gbase, voff) do { _Pragma("unroll") for (int _i = 0; _i < 2; ++_i) \
        __builtin_amdgcn_global_load_lds((const unsigned*)((const char*)(gbase) + (voff)[_i]), (PG8_LAS unsigned*)(lds + (bufoff) + ldsw + _i * 8192), 16, 0, 0); } while (0)
#define PG8_LDA(dst, b, h) do { _Pragma("unroll") for (int m = 0; m < 4; ++m) _Pragma("unroll") for (int k = 0; k < 2; ++k) dst[m][k] = *(const PG8_LAS bf16x8*)(lds + PG8_SA(b, h) + aoff + m * 2048 + k * 1024); } while (0)
#define PG8_LDB(dst, b, h) do { _Pragma("unroll") for (int n = 0; n < 2; ++n) _Pragma("unroll") for (int k = 0; k < 2; ++k) dst[n][k] = *(const PG8_LAS bf16x8*)(lds + PG8_SB(b, h) + boff + n * 2048 + k * 1024); } while (0)
#define PG8_MMA(ai, bj, At, Bt) do { __builtin_amdgcn_s_setprio(1); _Pragma("unroll") for (int m = 0; m < 4; ++m) _Pragma("unroll") for (int n = 0; n < 2; ++n) _Pragma("unroll") for (int k = 0; k < 2; ++k) \
        acc[ai][bj][m][n] = __builtin_amdgcn_mfma_f32_16x16x32_bf16(Bt[n][k], At[m][k], acc[ai][bj][m][n], 0, 0, 0); __builtin_amdgcn_s_setprio(0); } while (0)
#define PG8_WAIT_V(n) asm volatile("s_waitcnt vmcnt(" #n ")" ::: "memory")
#define PG8_WAIT_L(n) asm volatile("s_waitcnt lgkmcnt(" #n ")" ::: "memory")
#define PG8_BAR __builtin_amdgcn_s_barrier()
#define PG8_SCHED __builtin_amdgcn_sched_barrier(0)
    Unit cur, nxt; int ui = 0;
    if (!S.next(0, cur)) return;
    f32x4 acc[2][2][4][2];
#pragma unroll
    for (int a = 0; a < 2; ++a)
#pragma unroll
        for (int b = 0; b < 2; ++b)
#pragma unroll
            for (int m = 0; m < 4; ++m)
#pragma unroll
                for (int n = 0; n < 2; ++n) acc[a][b][m][n] = (f32x4){0.f, 0.f, 0.f, 0.f};
    bf16x8 At[4][2], B0[2][2], B1[2][2];
    const char* cA = (const char*)g.A + (size_t)cur.pm * tstep; const char* cB = (const char*)g.Bt + (size_t)cur.pn * tstep;
    S.a_ready(cur);
    if constexpr (SP2) {
        PG8_STAGE(PG8_SB(0, 0), cB, voffB); PG8_STAGE(PG8_SB(0, 1), cB + hstep, voffB); PG8_STAGE(PG8_SA(0, 0), cA, voffA); PG8_STAGE(PG8_SA(0, 1), cA + hstep, voffA);
        if (wr == 1) PG8_BAR;
        PG8_WAIT_V(2); PG8_BAR;
        PG8_STAGE(PG8_SB(1, 0), cB + kstep, voffB); PG8_STAGE(PG8_SA(1, 0), cA + kstep, voffA); PG8_STAGE(PG8_SB(1, 1), cB + hstep + kstep, voffB);
        PG8_WAIT_V(6); PG8_BAR;
    } else {
        PG8_STAGE(PG8_SB(0, 0), cB, voffB); PG8_STAGE(PG8_SA(0, 0), cA, voffA); PG8_STAGE(PG8_SB(0, 1), cB + hstep, voffB); PG8_STAGE(PG8_SA(0, 1), cA + hstep, voffA);
        if (wr == 1) PG8_BAR;
        PG8_WAIT_V(4); PG8_BAR;
        PG8_STAGE(PG8_SB(1, 0), cB + kstep, voffB); PG8_STAGE(PG8_SA(1, 0), cA + kstep, voffA); PG8_STAGE(PG8_SB(1, 1), cB + hstep + kstep, voffB);
        PG8_WAIT_V(6); PG8_BAR;
    }
    for (;;) {
        const bool has_next = S.next(ui + 1, nxt);
        const char* nA = has_next ? (const char*)g.A + (size_t)nxt.pm * tstep : cA; const char* nB = has_next ? (const char*)g.Bt + (size_t)nxt.pn * tstep : cB;
        for (int t = 0; t < nt; t += 2) {
            const bool last = (t == nt - 2);
            const char* a1 = cA + (size_t)(t + 1) * kstep;
            const char* a2 = last ? nA : cA + (size_t)(t + 2) * kstep; const char* b2 = last ? nB : cB + (size_t)(t + 2) * kstep;
            const char* a3 = a2 + kstep; const char* b3 = b2 + kstep;
            if (last && has_next) S.a_ready(nxt);
            if constexpr (SP2) {
            PG8_LDB(B0, 0, 0); PG8_LDB(B1, 0, 1); PG8_SCHED; PG8_LDA(At, 0, 0); PG8_STAGE(PG8_SA(1, 1), a1 + hstep, voffA);
            PG8_WAIT_V(8); PG8_WAIT_L(0); PG8_BAR; PG8_MMA(0, 0, At, B0); PG8_MMA(0, 1, At, B1); PG8_BAR; PG8_SCHED;
            PG8_LDA(At, 0, 1); PG8_STAGE(PG8_SB(0, 0), b2, voffB); PG8_STAGE(PG8_SB(0, 1), b2 + hstep, voffB); PG8_STAGE(PG8_SA(0, 0), a2, voffA);
            PG8_WAIT_V(8); PG8_WAIT_L(0); PG8_BAR; PG8_MMA(1, 0, At, B0); PG8_MMA(1, 1, At, B1); PG8_BAR; PG8_SCHED;
            PG8_LDB(B0, 1, 0); PG8_LDB(B1, 1, 1); PG8_SCHED; PG8_LDA(At, 1, 0); PG8_STAGE(PG8_SA(0, 1), a2 + hstep, voffA);
            PG8_WAIT_V(8); PG8_WAIT_L(0); PG8_BAR; PG8_MMA(0, 0, At, B0); PG8_MMA(0, 1, At, B1); PG8_BAR; PG8_SCHED;
            PG8_LDA(At, 1, 1); PG8_STAGE(PG8_SB(1, 0), b3, voffB); PG8_STAGE(PG8_SB(1, 1), b3 + hstep, voffB); PG8_STAGE(PG8_SA(1, 0), a3, voffA);
            PG8_WAIT_V(8); PG8_WAIT_L(0); PG8_BAR; PG8_MMA(1, 0, At, B0); PG8_MMA(1, 1, At, B1); PG8_BAR; PG8_SCHED;
            } else {
            PG8_LDB(B0, 0, 0); PG8_SCHED; PG8_LDA(At, 0, 0); PG8_STAGE(PG8_SA(1, 1), a1 + hstep, voffA);
            PG8_WAIT_L(8); PG8_BAR; PG8_WAIT_L(0); PG8_MMA(0, 0, At, B0); PG8_BAR; PG8_SCHED;
            PG8_LDB(B1, 0, 1); PG8_STAGE(PG8_SB(0, 0), b2, voffB);
            PG8_BAR; PG8_WAIT_L(0); PG8_MMA(0, 1, At, B1); PG8_BAR;
            PG8_LDA(At, 0, 1); PG8_STAGE(PG8_SA(0, 0), a2, voffA);
            PG8_BAR; PG8_WAIT_L(0); PG8_MMA(1, 0, At, B0); PG8_BAR; PG8_SCHED;
            PG8_STAGE(PG8_SB(0, 1), b2 + hstep, voffB);
            PG8_WAIT_V(6); PG8_BAR; PG8_MMA(1, 1, At, B1); PG8_BAR;
            PG8_LDB(B0, 1, 0); PG8_SCHED; PG8_LDA(At, 1, 0); PG8_STAGE(PG8_SA(0, 1), a2 + hstep, voffA);
            PG8_WAIT_L(8); PG8_BAR; PG8_WAIT_L(0); PG8_MMA(0, 0, At, B0); PG8_BAR; PG8_SCHED;
            PG8_LDB(B1, 1, 1); PG8_STAGE(PG8_SB(1, 0), b3, voffB);
            PG8_BAR; PG8_WAIT_L(0); PG8_MMA(0, 1, At, B1); PG8_BAR;
            PG8_LDA(At, 1, 1); PG8_STAGE(PG8_SA(1, 0), a3, voffA);
            PG8_BAR; PG8_WAIT_L(0); PG8_MMA(1, 0, At, B0); PG8_BAR; PG8_SCHED;
            PG8_STAGE(PG8_SB(1, 1), b3 + hstep, voffB);
            PG8_WAIT_V(6); PG8_BAR; PG8_MMA(1, 1, At, B1); PG8_BAR;
            }
        }
        if constexpr (ALIGN_EPI) { if (wr == 0) PG8_BAR; }
        if constexpr (!Epi::AFTER_DRAIN) { E(acc, cur, wr, wc, fr, fq); S.done(cur); }
        if (!has_next) break;
#pragma unroll
        for (int a = 0; a < 2; ++a)
#pragma unroll
            for (int b = 0; b < 2; ++b)
#pragma unroll
                for (int m = 0; m < 4; ++m)
#pragma unroll
                    for (int n = 0; n < 2; ++n) acc[a][b][m][n] = (f32x4){0.f, 0.f, 0.f, 0.f};
        cur = nxt; cA = nA; cB = nB; ++ui;
        if constexpr (ALIGN_EPI) { if (wr == 1) PG8_BAR; }
    }
    PG8_WAIT_V(0);
    if constexpr (!ALIGN_EPI) { if (wr == 0) PG8_BAR; }
    PG8_BAR;
    if constexpr (Epi::AFTER_DRAIN) { E.fused(acc, cur, wr, wc, fr, fq, lds, wid, lane); S.done(cur); }
#undef PG8_SA
#undef PG8_SB
#undef PG8_STAGE
#undef PG8_LDA
#undef PG8_LDB
#undef PG8_MMA
#undef PG8_WAIT_V
#undef PG8_WAIT_L
#undef PG8_BAR
#undef PG8_SCHED
}
}

#ifndef MK_N_LAUNCHES
#define MK_N_LAUNCHES 1
#endif
namespace cg = cooperative_groups;
#define DI __device__ __forceinline__
#define LAS __attribute__((address_space(3)))
typedef unsigned short bf16;
typedef short bf16x8 __attribute__((ext_vector_type(8)));
typedef float f32x4 __attribute__((ext_vector_type(4)));
typedef float f32x16 __attribute__((ext_vector_type(16)));
typedef unsigned u32x4 __attribute__((ext_vector_type(4)));
typedef unsigned u32x2 __attribute__((ext_vector_type(2)));
typedef float f32x2_t __attribute__((ext_vector_type(2)));
typedef __bf16 bf16x2_t __attribute__((ext_vector_type(2)));
typedef short s16x2 __attribute__((ext_vector_type(2)));
typedef unsigned short u16x2 __attribute__((ext_vector_type(2)));

constexpr int SEQ = 2048, DM = 1024, NBATCH = 16, MTOK = NBATCH * SEQ;
constexpr int NCOL_A = 3328, NCOL_B = 2560;
constexpr float EPS = 1e-6f;
constexpr float LOG2E = 1.4426950408889634f;
constexpr float C2 = 0.125f * LOG2E;
constexpr int NPHASE = 9;

constexpr size_t MiB = 1u << 20;
constexpr size_t WS_WA = 1 * MiB, WS_WOA = 8 * MiB, WS_WB = 10 * MiB, WS_WOB = 15 * MiB, WS_KM = 17 * MiB, WS_IW = 18 * MiB, WS_IK = 19 * MiB;
constexpr size_t WS_XN = 24 * MiB, WS_Q = 88 * MiB, WS_K = 152 * MiB, WS_VT = 168 * MiB, WS_SG = 184 * MiB, WS_IQ = 248 * MiB, WS_OG = 280 * MiB, WS_H1 = 344 * MiB, WS_END = 472 * MiB;

constexpr int LDS_BYTES = 153600;
constexpr int IQ_STRIDE = 1040;
constexpr int L_IQ = 0, L_HIST = 33280, L_SEL = 131072, L_MASK = L_SEL + 512, L_BTAB = L_MASK + 8192, L_SELM = L_BTAB + 12288, L_BLK = L_SELM + 128, L_END = L_BLK + 16;
static_assert(L_HIST + 32 * 257 * 4 + 256 <= L_SEL, "selection scratch inside the ring");
constexpr int L_EPI = 131072;
static_assert(L_EPI + 8 * 2304 <= 152320, "epilogue staging");
constexpr int L_MISC = 152320;
static_assert(L_END <= L_MISC && L_MISC + 64 + 128 <= LDS_BYTES && LDS_BYTES <= 163840, "LDS map");

__device__ const unsigned char BKT[128] = {
  0, 1, 2, 3, 4, 5, 6, 7, 8, 9, 10, 11, 12, 13, 14, 15, 16, 16, 16, 17, 17, 18, 18, 18, 19, 19, 19, 20, 20, 20, 20, 21,
  21, 21, 21, 22, 22, 22, 22, 22, 23, 23, 23, 23, 23, 23, 24, 24, 24, 24, 24, 24, 25, 25, 25, 25, 25, 25, 25, 26, 26, 26, 26, 26,
  26, 26, 26, 27, 27, 27, 27, 27, 27, 27, 27, 27, 27, 28, 28, 28, 28, 28, 28, 28, 28, 28, 28, 29, 29, 29, 29, 29, 29, 29, 29, 29,
  29, 29, 29, 30, 30, 30, 30, 30, 30, 30, 30, 30, 30, 30, 30, 30, 30, 31, 31, 31, 31, 31, 31, 31, 31, 31, 31, 31, 31, 31, 31, 31};

struct Args { const float* in[14]; float* out; unsigned char* ws; int ph_lo, ph_hi; };

struct Ptrs {
  const float *x, *norm_a_g, *w_in_a, *qn_a_g, *kn_a_g, *w_out_a, *rel_bias, *norm_kv_g, *w_kv, *kn_b_g, *norm_b_g, *w_in_b, *qn_b_g, *w_out_b;
  float* out;
  bf16 *WtA, *WtOA, *WtB, *WtOB, *XN, *Q, *KV, *SG, *IQ, *IK, *OG;
  float *IW, *KM, *RINV, *SSQ;
};

DI unsigned cvtpk(float lo, float hi) { f32x2_t v = {lo, hi}; bf16x2_t b = __builtin_convertvector(v, bf16x2_t); return __builtin_bit_cast(unsigned, b); }
DI float bflo(unsigned u) { return __uint_as_float(u << 16); }
DI float bfhi(unsigned u) { return __uint_as_float(u & 0xffff0000u); }
DI float wave_sum(float v) {
#pragma unroll
  for (int o = 1; o < 64; o <<= 1) v += __shfl_xor(v, o);
  return v;
}
DI float silu_f(float v) { return v * __builtin_amdgcn_rcpf(1.0f + __expf(-v)); }
#define MFMA32(a, b, c) __builtin_amdgcn_mfma_f32_32x32x16_bf16((a), (b), (c), 0, 0, 0)

#define XB_TMO      128
#define XB_XCNT(j)  (256  + 64 * (j))
#define XB_XSUB(j)  (1280 + 64 * (j))
#define XB_XGEN(j)  (2304 + 64 * (j))
#define XB_TOP      3328
#define XB_TOPGEN   3392
#define XCD_BAR_WORDS 3456
#define XB_SPIN_CAP (1u << 18)

__device__ __forceinline__ unsigned xb_ld(unsigned* p)              { return __hip_atomic_load(p, __ATOMIC_RELAXED, __HIP_MEMORY_SCOPE_AGENT); }
__device__ __forceinline__ unsigned xb_add(unsigned* p, unsigned v) { return __hip_atomic_fetch_add(p, v, __ATOMIC_RELAXED, __HIP_MEMORY_SCOPE_AGENT); }
__device__ __forceinline__ unsigned xb_xcc_id() { return (unsigned)__builtin_amdgcn_s_getreg((3 << 11) | 20) & 0xFu; }
#define XB_SPIN(cond, bar) do { unsigned _sp = 0; while (cond) { __builtin_amdgcn_s_sleep(1); \
    if ((++_sp & 255u) == 0u) { if (xb_ld(&(bar)[XB_TMO])) break; if (_sp > XB_SPIN_CAP) { atomicAdd(&(bar)[XB_TMO], 1u); break; } } } } while (0)

struct XcdBarrier {
    unsigned* bar; unsigned x; unsigned total;
    volatile LAS unsigned* st;
};

__device__ __forceinline__ XcdBarrier xcd_barrier_post(unsigned* bar, volatile LAS unsigned* st, bool lead_, unsigned total_) {
    XcdBarrier b; b.bar = bar; b.x = xb_xcc_id(); b.st = st; b.total = total_;
    if (lead_) (void)xb_add(&bar[XB_XCNT(b.x)], 1u);
    return b;
}
__device__ __forceinline__ void xcd_barrier_complete(unsigned* bar, unsigned x, unsigned& nloc, unsigned& nx, unsigned G) {
    unsigned sum, cnt, mine, sp = 0u;
    for (;;) {
        sum = 0u; cnt = 0u; mine = 0u;
#pragma unroll
        for (unsigned j = 0; j < 16; ++j) { const unsigned c = xb_ld(&bar[XB_XCNT(j)]); sum += c; cnt += (c > 0u) ? 1u : 0u; mine = (j == x) ? c : mine; }
        if (sum == G) break;
        __builtin_amdgcn_s_sleep(1);
        if ((++sp & 255u) == 0u) { if (xb_ld(&bar[XB_TMO])) break; if (sp > XB_SPIN_CAP) { atomicAdd(&bar[XB_TMO], 1u); break; } }
    }
    nloc = mine > 0u ? mine : 1u; nx = cnt > 0u ? cnt : 1u;
}

__device__ __forceinline__ void xcd_barrier(const XcdBarrier& b, bool lead_) {
    asm volatile("s_waitcnt vmcnt(0)" ::: "memory");
    __syncthreads();
    if (lead_) {
        unsigned* bar = b.bar;
        __builtin_amdgcn_s_waitcnt(0);
        unsigned nloc = b.st[0], nx = b.st[1];
        if (nloc == 0u) { xcd_barrier_complete(bar, b.x, nloc, nx, b.total); b.st[0] = nloc; b.st[1] = nx; }
        const unsigned old = xb_add(&bar[XB_XSUB(b.x)], 1u);
        const unsigned gen = old / nloc;
        if (old + 1u == (gen + 1u) * nloc) {
            __builtin_amdgcn_fence(__ATOMIC_RELEASE, "agent");
            asm volatile("s_waitcnt vmcnt(0)" ::: "memory");
            if (nx > 1u) {
            const unsigned og = xb_add(&bar[XB_TOP], 1u);
            const unsigned tg = og / nx;
            if (og + 1u == (tg + 1u) * nx) xb_add(&bar[XB_TOPGEN], 1u);
            else XB_SPIN(xb_ld(&bar[XB_TOPGEN]) == tg, bar);
            }
            if (nx == 1u) (void)__hip_atomic_fetch_add(&bar[XB_XGEN(b.x)], 1u, __ATOMIC_RELAXED, __HIP_MEMORY_SCOPE_AGENT);
            __builtin_amdgcn_fence(__ATOMIC_ACQUIRE, "agent");
            if (nx > 1u) xb_add(&bar[XB_XGEN(b.x)], 1u);
            asm volatile("s_waitcnt vmcnt(0)" ::: "memory");
        } else {
            XB_SPIN(xb_ld(&bar[XB_XGEN(b.x)]) == gen, bar);
            __builtin_amdgcn_fence(__ATOMIC_ACQUIRE, "agent");
            asm volatile("s_waitcnt vmcnt(0)" ::: "memory");
        }
    }
    __syncthreads();
}

DI int slot_of(int gc) { const int u = gc & 255; return (gc & ~255) + 128 * ((u >> 5) & 1) + 32 * (u >> 6) + 16 * ((u >> 2) & 1) + 4 * ((u >> 3) & 3) + (u & 3); }

typedef pg8::f32x4 accq;
DI int pi32(int r) { return (r & ~12) | ((r & 4) << 1) | ((r & 8) >> 1); }
DI size_t kv_tile_elem(int row) { return (size_t)(row >> 5) * 16384; }
DI bf16* k_piece(bf16* KV, int row, int g, int bj, int fq) {
  return KV + kv_tile_elem(row) + (size_t)(((g * 4 + 2 * bj + (fq >> 1)) * 64 + (fq & 1) * 32 + pi32(row & 31)) * 8);
}
struct OrderR : pg8::StaticOrder {
  const float* rv; unsigned ldsb; int wv; mutable int k;
  DI void a_ready(const pg8::Unit& u) const {
    if (wv == 0) { const float* src = rv + (size_t)u.pm * 256 + lane_id_hw() * 4; unsigned keep; const unsigned dst = (unsigned)__builtin_amdgcn_readfirstlane((int)(ldsb + (unsigned)(k & 1) * 1024u));
      asm volatile("s_mov_b32 %0, m0\n\ts_mov_b32 m0, %2\n\ts_nop 0\n\tglobal_load_lds_dwordx4 %1, off\n\ts_mov_b32 m0, %0\n\ts_nop 0" : "=&s"(keep) : "v"(src), "s"(dst) : "memory"); }
    ++k;
  }
};
DI void load_gain(float (&gv)[2][2][4], const float* g, int fq, float sc) {
#pragma unroll
  for (int bj = 0; bj < 2; ++bj)
#pragma unroll
    for (int n = 0; n < 2; ++n)
#pragma unroll
      for (int e = 0; e < 4; ++e) gv[bj][n][e] = g[32 * bj + 8 * fq + 4 * n + e] * sc;
}
template <int ACT  > DI void plain_store(const accq (&acc)[2][2][4][2], int ai, int m, float sc, bf16* dst) {
#pragma unroll
  for (int bj = 0; bj < 2; ++bj) {
    float v[8];
#pragma unroll
    for (int n = 0; n < 2; ++n)
#pragma unroll
      for (int e = 0; e < 4; ++e) { float t = acc[ai][bj][m][n][e] * sc; if (ACT == 1) t = silu_f(t); v[4 * n + e] = t; }
    u32x4 w; w.x = cvtpk(v[0], v[1]); w.y = cvtpk(v[2], v[3]); w.z = cvtpk(v[4], v[5]); w.w = cvtpk(v[6], v[7]);
    *(u32x4*)(dst + 32 * bj) = w;
  }
}
DI void v_store_scaled(const accq (&acc)[2][2][4][2], int ai, int m, bf16* KV, int row, int g, int fq, float sc) {
  const int i = row & 31;
  bf16* base = KV + kv_tile_elem(row) + (size_t)((16 + g * 4 + (i >> 4)) * 512 + ((i >> 3) & 1) * 256 + (i & 7));
#pragma unroll
  for (int bj = 0; bj < 2; ++bj)
#pragma unroll
    for (int n = 0; n < 2; ++n)
#pragma unroll
      for (int e = 0; e < 4; e += 2) {
        const unsigned pk = cvtpk(acc[ai][bj][m][n][e] * sc, acc[ai][bj][m][n][e + 1] * sc);
        const int r = 8 * fq + 4 * n + e;
        base[bj * 1024 + r * 8] = (bf16)(pk & 0xffffu); base[bj * 1024 + (r + 1) * 8] = (bf16)(pk >> 16);
      }
}

struct EpiA {
  static constexpr bool PERM = false, AFTER_DRAIN = false;
  bf16 *Q, *KV, *SG, *IQ, *IK; float* IW; const float *qn_g, *kn_g; const LAS float* rl; mutable int k;
  DI void operator()(const accq (&acc)[2][2][4][2], const pg8::Unit& u, int wr, int wc, int fr, int fq) const {
    const int pn = u.pn, row0 = u.pm * 256 + wr * 64 + fr; const LAS float* rinv = rl + (k & 1) * 256 - u.pm * 256; ++k;
    if (pn <= 4) {
      float gv[2][2][4]; load_gain(gv, pn < 4 ? qn_g : kn_g, fq, pn < 4 ? C2 : 1.0f);
#pragma unroll
      for (int ai = 0; ai < 2; ++ai)
#pragma unroll
        for (int m = 0; m < 4; ++m) { const int row = row0 + 128 * ai + 16 * m; const float ri = rinv[row];
          float v[2][2][4]; float ss = 0.f;
#pragma unroll
          for (int bj = 0; bj < 2; ++bj)
#pragma unroll
            for (int n = 0; n < 2; ++n)
#pragma unroll
              for (int e = 0; e < 4; ++e) { v[bj][n][e] = acc[ai][bj][m][n][e] * ri; ss += v[bj][n][e] * v[bj][n][e]; }
          ss += __shfl_xor(ss, 16); ss += __shfl_xor(ss, 32);
          const float rn = rsqrtf(ss * (1.0f / 64.0f) + EPS);
#pragma unroll
          for (int bj = 0; bj < 2; ++bj) {
            u32x4 w; w.x = cvtpk(v[bj][0][0] * rn * gv[bj][0][0], v[bj][0][1] * rn * gv[bj][0][1]); w.y = cvtpk(v[bj][0][2] * rn * gv[bj][0][2], v[bj][0][3] * rn * gv[bj][0][3]);
            w.z = cvtpk(v[bj][1][0] * rn * gv[bj][1][0], v[bj][1][1] * rn * gv[bj][1][1]); w.w = cvtpk(v[bj][1][2] * rn * gv[bj][1][2], v[bj][1][3] * rn * gv[bj][1][3]);
            bf16* dst = pn < 4 ? Q + (size_t)row * 1024 + (4 * pn + wc) * 64 + 8 * fq + 32 * bj : k_piece(KV, row, wc, bj, fq);
            *(u32x4*)dst = w; } }
    } else if (pn == 5) {
#pragma unroll
      for (int ai = 0; ai < 2; ++ai)
#pragma unroll
        for (int m = 0; m < 4; ++m) { const int row = row0 + 128 * ai + 16 * m; v_store_scaled(acc, ai, m, KV, row, wc, fq, rinv[row]); }
    } else if (pn <= 9) {
#pragma unroll
      for (int ai = 0; ai < 2; ++ai)
#pragma unroll
        for (int m = 0; m < 4; ++m) { const int row = row0 + 128 * ai + 16 * m; plain_store<1>(acc, ai, m, rinv[row], SG + (size_t)row * 1024 + 256 * (pn - 6) + 64 * wc + 8 * fq); }
    } else if (pn <= 11) {
#pragma unroll
      for (int ai = 0; ai < 2; ++ai)
#pragma unroll
        for (int m = 0; m < 4; ++m) { const int row = row0 + 128 * ai + 16 * m; plain_store<0>(acc, ai, m, 0.125f * rinv[row], IQ + (size_t)row * 512 + 256 * (pn - 10) + 64 * wc + 8 * fq); }
    } else {
      if (wc == 0) {
#pragma unroll
        for (int ai = 0; ai < 2; ++ai)
#pragma unroll
          for (int m = 0; m < 4; ++m) { const int row = row0 + 128 * ai + 16 * m; const float sc = rinv[row];
#pragma unroll
            for (int bj = 0; bj < 2; ++bj) { u32x4 w; w.x = cvtpk(acc[ai][bj][m][0][0] * sc, acc[ai][bj][m][0][1] * sc); w.y = cvtpk(acc[ai][bj][m][0][2] * sc, acc[ai][bj][m][0][3] * sc);
              w.z = cvtpk(acc[ai][bj][m][1][0] * sc, acc[ai][bj][m][1][1] * sc); w.w = cvtpk(acc[ai][bj][m][1][2] * sc, acc[ai][bj][m][1][3] * sc);
              *(u32x4*)(IK + (size_t)(row >> 5) * 2048 + (size_t)(((2 * bj + (fq >> 1)) * 64 + (fq & 1) * 32 + pi32(row & 31)) * 8)) = w; } }
      } else if (wc == 1 && fq == 0) {
#pragma unroll
        for (int ai = 0; ai < 2; ++ai)
#pragma unroll
          for (int m = 0; m < 4; ++m) { const int row = row0 + 128 * ai + 16 * m; float* d = IW + (size_t)row * 8; const float sc = 0.35355339059327373f * rinv[row];
            *(f32x4*)d = acc[ai][0][m][0] * sc; *(f32x4*)(d + 4) = acc[ai][0][m][1] * sc; }
      }
    }
  }
};
DI float row_rinv(const float* ssq, int row) {
  const f32x4* p = (const f32x4*)(ssq + (size_t)row * 16); const f32x4 a = p[0], b = p[1], c = p[2], d = p[3];
  const float t = (((a.x + a.y) + (a.z + a.w)) + ((b.x + b.y) + (b.z + b.w))) + (((c.x + c.y) + (c.z + c.w)) + ((d.x + d.y) + (d.z + d.w)));
  return rsqrtf(t * (1.0f / 1024.0f) + EPS);
}
struct EpiB {
  static constexpr bool PERM = false, AFTER_DRAIN = false;
  bf16 *Q, *KV, *SG; const float *qn_g, *kn_g; const LAS float* rl; float* KM; mutable int k;
  DI void operator()(const accq (&acc)[2][2][4][2], const pg8::Unit& u, int wr, int wc, int fr, int fq) const {
    const int pn = u.pn, row0 = u.pm * 256 + wr * 64 + fr; const LAS float* rinv2 = rl + (k & 1) * 256 - u.pm * 256; ++k;
    if (pn == 0 || (pn >= 2 && pn <= 5)) {
      float gv[2][2][4]; load_gain(gv, pn == 0 ? kn_g : qn_g, fq, pn == 0 ? 1.0f : C2);
      float cs[2][2][4];
#pragma unroll
      for (int bj = 0; bj < 2; ++bj)
#pragma unroll
        for (int n = 0; n < 2; ++n)
#pragma unroll
          for (int e = 0; e < 4; ++e) cs[bj][n][e] = 0.f;
#pragma unroll
      for (int ai = 0; ai < 2; ++ai)
#pragma unroll
        for (int m = 0; m < 4; ++m) { const int row = row0 + 128 * ai + 16 * m; const float ri = rinv2[row];
          float v[2][2][4]; float ss = 0.f;
#pragma unroll
          for (int bj = 0; bj < 2; ++bj)
#pragma unroll
            for (int n = 0; n < 2; ++n)
#pragma unroll
              for (int e = 0; e < 4; ++e) { v[bj][n][e] = acc[ai][bj][m][n][e] * ri; ss += v[bj][n][e] * v[bj][n][e]; }
          ss += __shfl_xor(ss, 16); ss += __shfl_xor(ss, 32);
          const float rn = rsqrtf(ss * (1.0f / 64.0f) + EPS);
#pragma unroll
          for (int bj = 0; bj < 2; ++bj) {
#pragma unroll
            for (int n = 0; n < 2; ++n)
#pragma unroll
              for (int e = 0; e < 4; ++e) { v[bj][n][e] = v[bj][n][e] * rn * gv[bj][n][e]; cs[bj][n][e] += v[bj][n][e]; }
            u32x4 w; w.x = cvtpk(v[bj][0][0], v[bj][0][1]); w.y = cvtpk(v[bj][0][2], v[bj][0][3]); w.z = cvtpk(v[bj][1][0], v[bj][1][1]); w.w = cvtpk(v[bj][1][2], v[bj][1][3]);
            bf16* dst = pn != 0 ? Q + (size_t)row * 1024 + (4 * (pn - 2) + wc) * 64 + 8 * fq + 32 * bj : k_piece(KV, row, wc, bj, fq);
            *(u32x4*)dst = w; } }
      if (pn == 0) {
        float* km = KM + ((size_t)((u.pm >> 3) * 4 + wc) * 8 + (u.pm & 7)) * 64 + 8 * fq;
#pragma unroll
        for (int bj = 0; bj < 2; ++bj)
#pragma unroll
          for (int n = 0; n < 2; ++n)
#pragma unroll
            for (int e = 0; e < 4; ++e) { float t = cs[bj][n][e]; t += __shfl_xor(t, 1); t += __shfl_xor(t, 2); t += __shfl_xor(t, 4); t += __shfl_xor(t, 8);
              if (fr == 0) atomicAdd(km + 32 * bj + 4 * n + e, t * (1.0f / 256.0f)); }
      }
    } else if (pn == 1) {
#pragma unroll
      for (int ai = 0; ai < 2; ++ai)
#pragma unroll
        for (int m = 0; m < 4; ++m) { const int row = row0 + 128 * ai + 16 * m; const float ri = rinv2[row];
          v_store_scaled(acc, ai, m, KV, row, wc, fq, ri); }
    } else {
#pragma unroll
      for (int ai = 0; ai < 2; ++ai)
#pragma unroll
        for (int m = 0; m < 4; ++m) { const int row = row0 + 128 * ai + 16 * m; plain_store<1>(acc, ai, m, rinv2[row], SG + (size_t)row * 1024 + 256 * (pn - 6) + 64 * wc + 8 * fq); }
    }
  }
};
DI void unpack8(const u32x4 w, float (&f)[8]) { f[0] = bflo(w.x); f[1] = bfhi(w.x); f[2] = bflo(w.y); f[3] = bfhi(w.y); f[4] = bflo(w.z); f[5] = bfhi(w.z); f[6] = bflo(w.w); f[7] = bfhi(w.w); }
struct EpiRes {
  static constexpr bool PERM = false, AFTER_DRAIN = false;
  const bf16* res; float* out; LAS unsigned char* stg0;
  DI void operator()(const accq (&acc)[2][2][4][2], const pg8::Unit& u, int wr, int wc, int fr, int fq) const {
    const int row0 = u.pm * 256 + wr * 64 + fr, col0 = u.pn * 256 + 64 * wc + 8 * fq; LAS unsigned char* stg = stg0 + (wr * 4 + wc) * 2304; const int lane = fq * 16 + fr, r8 = lane >> 3, p8 = lane & 7;
#pragma unroll
    for (int ai = 0; ai < 2; ++ai)
#pragma unroll
      for (int m = 0; m < 4; ++m) { const size_t off = (size_t)(row0 + 128 * ai + 16 * m) * 1024 + col0;
#pragma unroll
        for (int bj = 0; bj < 2; ++bj) { float f[8]; unpack8(*(const u32x4*)(res + off + 32 * bj), f);
          f32x4 o0 = acc[ai][bj][m][0], o1 = acc[ai][bj][m][1];
          o0.x += f[0]; o0.y += f[1]; o0.z += f[2]; o0.w += f[3]; o1.x += f[4]; o1.y += f[5]; o1.z += f[6]; o1.w += f[7];
          *(LAS f32x4*)(stg + fr * 144 + fq * 32) = o0; *(LAS f32x4*)(stg + fr * 144 + fq * 32 + 16) = o1;
          asm volatile("" ::: "memory");
          const f32x4 a = *(const LAS f32x4*)(stg + r8 * 144 + p8 * 16), b = *(const LAS f32x4*)(stg + (r8 + 8) * 144 + p8 * 16);
          float* ob = out + (size_t)(row0 - fr + 128 * ai + 16 * m) * 1024 + u.pn * 256 + 64 * wc + 32 * bj + 4 * p8;
          __builtin_nontemporal_store(a, (f32x4*)(ob + (size_t)r8 * 1024)); __builtin_nontemporal_store(b, (f32x4*)(ob + (size_t)(r8 + 8) * 1024));
          asm volatile("" ::: "memory"); } }
  }
};
struct EpiRes2 {
  static constexpr bool PERM = false, AFTER_DRAIN = false;
  bf16* xh; float* ssq;
  DI void operator()(const accq (&acc)[2][2][4][2], const pg8::Unit& u, int wr, int wc, int fr, int fq) const {
    const int row0 = u.pm * 256 + wr * 64 + fr, col0 = u.pn * 256 + 64 * wc + 8 * fq;
#pragma unroll
    for (int ai = 0; ai < 2; ++ai)
#pragma unroll
      for (int m = 0; m < 4; ++m) { const int row = row0 + 128 * ai + 16 * m; const size_t off = (size_t)row * 1024 + col0; float ss = 0.f;
#pragma unroll
        for (int bj = 0; bj < 2; ++bj) { float f[8]; unpack8(*(const u32x4*)(xh + off + 32 * bj), f);
#pragma unroll
          for (int n = 0; n < 2; ++n)
#pragma unroll
            for (int e = 0; e < 4; ++e) { f[4 * n + e] += acc[ai][bj][m][n][e]; ss += f[4 * n + e] * f[4 * n + e]; }
          u32x4 w; w.x = cvtpk(f[0], f[1]); w.y = cvtpk(f[2], f[3]); w.z = cvtpk(f[4], f[5]); w.w = cvtpk(f[6], f[7]);
          *(u32x4*)(xh + off + 32 * bj) = w; }
        ss += __shfl_xor(ss, 16); ss += __shfl_xor(ss, 32);
        if (fq == 0) ssq[(size_t)row * 16 + u.pn * 4 + wc] = ss; }
  }
};
DI int srccol_A(int gc) { if (gc < 3072) return gc; if (gc < 3136) return 3080 + (gc - 3072); if (gc < 3144) return 3072 + (gc - 3136); return -1; }
DI void trans_item(const float* W, int Ns, const float* gk, bf16* Wt, int item, int nblk, int kindA, LAS float* scr, int lane) {
  const int kb = item / nblk, nb = item % nblk, k0 = 64 * kb, gc0 = 32 * nb;
  const int n = lane & 31, gc = gc0 + n; const int sc = kindA ? srccol_A(gc) : gc;
  const int c = lane & 7;
  float v[32];
  const float* wp = W + (size_t)(k0 + (lane >> 5)) * Ns + (sc >= 0 ? sc : 0);
#pragma unroll
  for (int i = 0; i < 32; ++i) v[i] = __builtin_nontemporal_load(wp + (size_t)(2 * i) * Ns);
  f32x4 g0 = {1.f, 1.f, 1.f, 1.f}, g1 = {1.f, 1.f, 1.f, 1.f};
  if (gk) { g0 = *(const f32x4*)(gk + k0 + 8 * c); g1 = *(const f32x4*)(gk + k0 + 8 * c + 4); }
#pragma unroll
  for (int i = 0; i < 32; ++i) scr[(2 * i + (lane >> 5)) * 33 + n] = sc >= 0 ? v[i] : 0.f;
  asm volatile("s_waitcnt lgkmcnt(0)" ::: "memory");
#pragma unroll
  for (int j = 0; j < 4; ++j) { const int nn = (lane >> 3) + 8 * j; const LAS float* s = scr + (8 * c) * 33 + nn;
    u32x4 o; o.x = cvtpk(s[0 * 33] * g0.x, s[1 * 33] * g0.y); o.y = cvtpk(s[2 * 33] * g0.z, s[3 * 33] * g0.w); o.z = cvtpk(s[4 * 33] * g1.x, s[5 * 33] * g1.y); o.w = cvtpk(s[6 * 33] * g1.z, s[7 * 33] * g1.w);
    *(u32x4*)(Wt + (size_t)slot_of(gc0 + nn) * 1024 + k0 + 8 * c) = o; }
  asm volatile("s_waitcnt lgkmcnt(0)" ::: "memory");
}

DI int kidx(int r, int hi) { return 16 * (r >> 3) + 8 * hi + (r & 7); }
DI void k_dma(const char* ksrc  , unsigned voff  , unsigned lds_slot  ) {
  unsigned keep;
  asm volatile("s_waitcnt lgkmcnt(0)\n\ts_mov_b32 %0, m0\n\ts_mov_b32 m0, %3\n\ts_nop 0\n\t"
               "global_load_lds_dwordx4 %1, %2\n\tglobal_load_lds_dwordx4 %1, %2 offset:1024\n\tglobal_load_lds_dwordx4 %1, %2 offset:2048\n\tglobal_load_lds_dwordx4 %1, %2 offset:3072\n\t"
               "s_mov_b32 m0, %0" : "=&s"(keep) : "v"(voff), "s"(ksrc), "s"(lds_slot) : "memory");
}
DI void v_load(bf16x8 (&vf)[4], const char* vsrc  , unsigned voff) {
  asm volatile("global_load_dwordx4 %0, %4, %5\n\tglobal_load_dwordx4 %1, %4, %5 offset:1024\n\tglobal_load_dwordx4 %2, %4, %5 offset:2048\n\tglobal_load_dwordx4 %3, %4, %5 offset:3072"
               : "=&v"(vf[0]), "=&v"(vf[1]), "=&v"(vf[2]), "=&v"(vf[3]) : "v"(voff), "s"(vsrc) : "memory");
}
DI void kv_wait(bf16x8 (&vf)[4]) { asm volatile("s_waitcnt vmcnt(0)" : "+v"(vf[0]), "+v"(vf[1]), "+v"(vf[2]), "+v"(vf[3]) :: "memory"); }
DI void qk_tile(f32x16 (&c)[2], const LAS unsigned char* kslot  , const bf16x8 (&qf)[2][4]) {
  bf16x8 kf[4];
#pragma unroll
  for (int s = 0; s < 4; ++s) kf[s] = *(const LAS bf16x8*)(kslot + s * 1024);
#pragma unroll
  for (int j = 0; j < 2; ++j) {
    f32x16 z;
#pragma unroll
    for (int r = 0; r < 16; ++r) z[r] = 0.f;
    c[j] = MFMA32(kf[0], qf[j][0], z);
#pragma unroll
    for (int s = 1; s < 4; ++s) c[j] = MFMA32(kf[s], qf[j][s], c[j]);
  }
}
DI void add_bias(f32x16 (&c)[2], const LAS float* bt0, int dist0) {
#pragma unroll
  for (int j = 0; j < 2; ++j) { const LAS float* tp = bt0 + j * 192 + (dist0 + 8);
#pragma unroll
    for (int r = 0; r < 16; ++r) c[j][r] += tp[23 - (16 * (r >> 3) + (r & 7))]; }
}
template <int MODE> DI void sm_pv(f32x16 (&O)[2][2], float (&l)[2], const f32x16 (&c)[2], const bf16x8 (&vf4)[4], unsigned m) {
#pragma unroll
  for (int j = 0; j < 2; ++j) {
    float p[16]; float ls = 0.f;
#pragma unroll
    for (int r = 0; r < 16; ++r) {
      const float e = __builtin_amdgcn_exp2f(c[j][r]);
      if (MODE == 0) { const unsigned ext = (unsigned)__builtin_amdgcn_sbfe((int)m, r, 1); p[r] = __uint_as_float(__float_as_uint(e) & ext); }
      else p[r] = e;
      ls += p[r];
    }
    if (MODE == 1) ls = __uint_as_float(__float_as_uint(ls) & m);
    l[j] += ls;
    bf16x8 pk[2];
#pragma unroll
    for (int s = 0; s < 2; ++s) { u32x4 w; w.x = cvtpk(p[8 * s], p[8 * s + 1]); w.y = cvtpk(p[8 * s + 2], p[8 * s + 3]); w.z = cvtpk(p[8 * s + 4], p[8 * s + 5]); w.w = cvtpk(p[8 * s + 6], p[8 * s + 7]);
      if (MODE == 1) { w.x &= m; w.y &= m; w.z &= m; w.w &= m; }
      pk[s] = __builtin_bit_cast(bf16x8, w); }
#pragma unroll
    for (int dt = 0; dt < 2; ++dt)
#pragma unroll
      for (int s = 0; s < 2; ++s) O[j][dt] = MFMA32(vf4[dt * 2 + s], pk[s], O[j][dt]);
  }
}
DI void attn_store(const f32x16 (&O)[2][2], const float (&l)[2], const bf16* SG, bf16* OG, size_t row0, int head0, LAS unsigned char* stg, int lane) {
  const int q = lane & 31, hi = lane >> 5, rr = lane >> 3, pc = lane & 7;
  const size_t goff = (row0 + rr) * 1024 + (size_t)head0 * 64 + 8 * pc;
  u32x4 sg[2][4];
#pragma unroll
  for (int j = 0; j < 2; ++j)
#pragma unroll
    for (int i = 0; i < 4; ++i) sg[j][i] = *(const u32x4*)(SG + goff + (size_t)i * 8192 + j * 64);
  LAS unsigned char* wb = stg + q * 256; const int wt = ((q & 15) ^ hi) << 4;
  const LAS unsigned char* rb = stg + rr * 256; const int rt = ((2 * pc) ^ rr) << 4;
#pragma unroll
  for (int j = 0; j < 2; ++j) {
    const float lt = l[j] + __shfl_xor(l[j], 32); const float inv = 1.0f / lt;
#pragma unroll
    for (int dt = 0; dt < 2; ++dt)
#pragma unroll
      for (int a = 0; a < 4; ++a) {
        f32x4 v; v.x = O[j][dt][4 * a + 0] * inv; v.y = O[j][dt][4 * a + 1] * inv; v.z = O[j][dt][4 * a + 2] * inv; v.w = O[j][dt][4 * a + 3] * inv;
        *(LAS f32x4*)(wb + (wt ^ ((8 * dt + 2 * a) << 4))) = v;
      }
    asm volatile("" ::: "memory");
#pragma unroll
    for (int i = 0; i < 4; ++i) {
      const int x0 = rt ^ ((i & 1) << 7);
      const f32x4 a0 = *(const LAS f32x4*)(rb + i * 2048 + x0), a1 = *(const LAS f32x4*)(rb + i * 2048 + (x0 ^ 16));
      const u32x4 g = sg[j][i]; u32x4 w;
      w.x = cvtpk(a0.x * bflo(g.x), a0.y * bfhi(g.x)); w.y = cvtpk(a0.z * bflo(g.y), a0.w * bfhi(g.y));
      w.z = cvtpk(a1.x * bflo(g.z), a1.y * bfhi(g.z)); w.w = cvtpk(a1.z * bflo(g.w), a1.w * bfhi(g.w));
      *(u32x4*)(OG + goff + (size_t)i * 8192 + j * 64) = w;
    }
    asm volatile("" ::: "memory");
  }
}
DI void build_btab(LAS unsigned char* lds, const float* rel_bias, int tid_) {
  LAS float* bt = (LAS float*)(lds + L_BTAB);
  for (int i = tid_; i < 16 * 192; i += 512) { const int h = i / 192, dist = i % 192 - 31;
    bt[i] = dist < 0 ? -INFINITY : (dist < 128 ? (rel_bias[(int)BKT[dist] * 16 + h] - rel_bias[31 * 16 + h]) * LOG2E : 0.f); }
}
DI unsigned causal16(int q, int hi) { unsigned m = 0;
#pragma unroll
  for (int r = 0; r < 16; ++r) m |= (kidx(r, hi) <= q) ? (1u << r) : 0u;
  return m; }

DI void dsa_unit(LAS unsigned char* lds, const Ptrs& P, int b, int qt, int wave_) {
  int tid = wave_ * 64 + lane_id_hw(); asm volatile("" : "+v"(tid));
  const int lane = tid & 63, w = __builtin_amdgcn_readfirstlane(tid >> 6), q = lane & 31, hi = lane >> 5;
  const int t0 = 32 * qt, nkt = qt + 1; const size_t rowb = (size_t)b * SEQ;
  LAS unsigned short* maskl = (LAS unsigned short*)(lds + L_MASK);
  bf16x8 qf[2][4];
#pragma unroll
  for (int j = 0; j < 2; ++j)
#pragma unroll
    for (int s = 0; s < 4; ++s) qf[j][s] = *(const bf16x8*)(P.Q + (rowb + t0 + q) * 1024 + (2 * w + j) * 64 + 16 * s + 8 * hi);
  __syncthreads();
  if (qt >= 8) {
    const bf16* ikb = P.IK + (size_t)(b * 64) * 2048 + lane * 8;
    bf16x8 ikc[4], ikn[4];
#pragma unroll
    for (int s = 0; s < 4; ++s) ikc[s] = *(const bf16x8*)(ikb + (size_t)w * 2048 + 512 * s);
    LAS float* wl = (LAS float*)(lds + L_HIST);
    { f32x4 wv = {0.f, 0.f, 0.f, 0.f}; if (tid < 64) wv = *(const f32x4*)(P.IW + (rowb + t0) * 8 + tid * 4);
      const int row = tid >> 4, ch = tid & 15; const u32x4* src = (const u32x4*)(P.IQ + (rowb + t0 + row) * 512);
#pragma unroll
      for (int c = 0; c < 4; ++c) *(LAS u32x4*)(lds + L_IQ + row * IQ_STRIDE + (ch + 16 * c) * 16) = __builtin_nontemporal_load(src + ch + 16 * c);
      if (tid < 64) *(LAS f32x4*)(wl + tid * 4) = wv; }
    __syncthreads();
    unsigned pl[4][16];
#pragma unroll
    for (int B = 0; B < 4; ++B) {
#pragma unroll
      for (int h2 = 0; h2 < 2; ++h2) {
        const int kt = w + 8 * (2 * B + h2);
        if (2 * B + h2 < 7) { const int ktn = (kt + 8 < nkt) ? kt + 8 : w;
#pragma unroll
          for (int s = 0; s < 4; ++s) ikn[s] = *(const bf16x8*)(ikb + (size_t)ktn * 2048 + 512 * s); }
        float sc[16];
        if (2 * B + h2 == 0 || kt < nkt) {
#pragma unroll
          for (int s = 0; s < 4; ++s) asm volatile("" : "+v"(ikc[s]));
#pragma unroll
          for (int r = 0; r < 16; ++r) sc[r] = 0.f;
#pragma unroll 2
          for (int hd = 0; hd < 8; ++hd) {
            f32x16 c;
#pragma unroll
            for (int r = 0; r < 16; ++r) c[r] = 0.f;
#pragma unroll
            for (int s = 0; s < 4; ++s) { const bf16x8 bq = *(const LAS bf16x8*)(lds + L_IQ + q * IQ_STRIDE + (hd * 64 + 16 * s + 8 * hi) * 2); c = MFMA32(ikc[s], bq, c); }
            const float wh = wl[q * 8 + hd];
#pragma unroll
            for (int r = 0; r < 16; ++r) { const int ci_ = __builtin_bit_cast(int, (float)c[r]); sc[r] += wh * __builtin_bit_cast(float, ci_ > 0 ? ci_ : 0); asm("" : "+v"(sc[r])); }
          }
          if (kt == qt) {
#pragma unroll
            for (int r = 0; r < 16; ++r) if (kidx(r, hi) > q) sc[r] = -INFINITY;
          }
        } else {
#pragma unroll
          for (int r = 0; r < 16; ++r) sc[r] = -INFINITY;
        }
#pragma unroll
        for (int v = 0; v < 16; ++v) {
          if (h2 == 0) pl[B][v] = __builtin_bit_cast(unsigned, __builtin_amdgcn_cvt_pkrtz(sc[v], 0.f));
          else pl[B][v] |= __builtin_bit_cast(unsigned, __builtin_amdgcn_cvt_pkrtz(0.f, sc[v]));
        }
#pragma unroll
        for (int s = 0; s < 4; ++s) ikc[s] = ikn[s];
      }
#pragma unroll
      for (int v = 0; v < 16; ++v) { const unsigned u = pl[B][v]; pl[B][v] = u ^ (((u >> 15) & 0x00010001u) * 0x7FFFu); }
#define TR_STAGE(J, MJ) _Pragma("unroll") for (int k = 0; k < 16; ++k) if ((k & (J)) == 0) { const unsigned t = ((pl[B][k] >> (J)) ^ pl[B][k + (J)]) & (MJ); pl[B][k + (J)] ^= t; pl[B][k] ^= t << (J); }
      TR_STAGE(8, 0x00FF00FFu) TR_STAGE(4, 0x0F0F0F0Fu) TR_STAGE(2, 0x33333333u) TR_STAGE(1, 0x55555555u)
#undef TR_STAGE
      pl[B][15] = ~pl[B][15];
#pragma unroll
      for (int v = 0; v < 16; ++v) asm volatile("" : "+v"(pl[B][v]));
      __builtin_amdgcn_sched_barrier(0);
    }
    LAS unsigned* cb = (LAS unsigned*)(lds + L_HIST + 32 * 257 * 4);
    if (tid < 64) cb[tid] = 0u;
    __syncthreads();
    unsigned mm[4] = {0xFFFFFFFFu, 0xFFFFFFFFu, 0xFFFFFFFFu, 0xFFFFFFFFu}, gt[4] = {0u, 0u, 0u, 0u}, Gtot = 0u, prev0 = 0u, prev1 = 0u;
#pragma unroll
    for (int bit = 15; bit >= 0; --bit) {
      unsigned t4[4]; unsigned cnt = 0u;
#pragma unroll
      for (int B = 0; B < 4; ++B) { t4[B] = mm[B] & pl[B][bit]; cnt += (unsigned)__builtin_popcount(t4[B]); }
      LAS unsigned* cw = cb + ((bit & 1) ? 32 : 0) + q;
      __hip_atomic_fetch_add(cw, cnt, __ATOMIC_RELAXED, __HIP_MEMORY_SCOPE_WORKGROUP);
      __syncthreads();
      const unsigned run = *cw; unsigned tot;
      if (bit & 1) { tot = run - prev1; prev1 = run; } else { tot = run - prev0; prev0 = run; }
      const bool acc1 = (Gtot + tot) >= 256u;
#pragma unroll
      for (int B = 0; B < 4; ++B) { if (acc1) mm[B] = t4[B]; else { gt[B] |= t4[B]; mm[B] ^= t4[B]; } }
      if (!acc1) Gtot += tot;
    }
    LAS unsigned short* tm = (LAS unsigned short*)(lds + L_HIST + 1024); LAS unsigned short* pf = (LAS unsigned short*)(lds + L_HIST + 1024 + 8192);
#pragma unroll
    for (int B = 0; B < 4; ++B) {
      tm[((w + 8 * (2 * B)) * 32 + q) * 2 + hi] = (unsigned short)(mm[B] & 0xFFFFu);
      tm[((w + 8 * (2 * B + 1)) * 32 + q) * 2 + hi] = (unsigned short)(mm[B] >> 16);
    }
    __syncthreads();
#pragma unroll
    for (int e = 0; e < 4; ++e) {
      const int qq = 4 * w + e;
      const unsigned c = (unsigned)__builtin_popcount(((const LAS unsigned*)tm)[lane * 32 + qq]);
      unsigned incl = c;
#pragma unroll
      for (int o = 1; o < 64; o <<= 1) { const unsigned t = __shfl_up(incl, o); if (lane >= o) incl += t; }
      pf[lane * 32 + qq] = (unsigned short)(incl - c);
    }
    __syncthreads();
    { const unsigned need = 256u - Gtot;
#pragma unroll
      for (int B = 0; B < 4; ++B) {
        unsigned sel = gt[B];
#pragma unroll
        for (int h2 = 0; h2 < 2; ++h2) {
          const unsigned t16 = (mm[B] >> (16 * h2)) & 0xFFFFu;
          if (t16) {
            const int kt = w + 8 * (2 * B + h2);
            const unsigned pair = ((const LAS unsigned*)tm)[kt * 32 + q], base = pf[kt * 32 + q];
            const unsigned c0 = (unsigned)__builtin_popcount(pair & 0xFFu), c1 = (unsigned)__builtin_popcount(pair & 0xFF0000u), c2 = (unsigned)__builtin_popcount(pair & 0xFF00u);
            const unsigned offL = base + (hi ? c0 : 0u), offH = base + (hi ? c0 + c1 + c2 : c0 + c1);
            unsigned rem = t16;
            while (rem) { const int pos = __builtin_ctz(rem); rem &= rem - 1u;
              const unsigned below = (unsigned)__builtin_popcount(t16 & ((1u << pos) - 1u) & (pos >= 8 ? 0xFF00u : 0xFFu));
              if ((pos >= 8 ? offH : offL) + below < need) sel |= 1u << (pos + 16 * h2); }
          }
        }
        if (w + 8 * (2 * B) < nkt) maskl[(w + 8 * (2 * B)) * 64 + lane] = (unsigned short)(sel & 0xFFFFu);
        if (w + 8 * (2 * B + 1) < nkt) maskl[(w + 8 * (2 * B + 1)) * 64 + lane] = (unsigned short)(sel >> 16);
      } }
  } else {
    const unsigned cm = causal16(q, hi);
#pragma unroll
    for (int i = 0; i < 8; ++i) { const int kt = w + 8 * i; if (kt < nkt) maskl[kt * 64 + lane] = (unsigned short)(kt == qt ? cm : 0xFFFFu); }
  }
  __syncthreads();
  const int g = w >> 1;
  const bf16* img = P.KV + (size_t)(b * 64) * 16384;
  const unsigned lds0 = (unsigned)(uintptr_t)lds;
#pragma unroll
  for (int j = 0; j < 2; ++j)
#pragma unroll
    for (int s = 0; s < 4; ++s) asm volatile("" : "+v"(qf[j][s]));
  f32x16 O[2][2]; float l[2] = {0.f, 0.f};
#pragma unroll
  for (int j = 0; j < 2; ++j)
#pragma unroll
    for (int dt = 0; dt < 2; ++dt)
#pragma unroll
      for (int r = 0; r < 16; ++r) O[j][dt][r] = 0.f;
  const LAS float* bt0 = (const LAS float*)(lds + L_BTAB) + (2 * w) * 192;
  LAS unsigned char* ringp = lds + 65536 + w * 8192;
  const char* ksrc = (const char*)img + g * 4096; const unsigned voff = (unsigned)lane * 16u;
  const unsigned kring = lds0 + (unsigned)w * 8192u; const LAS unsigned char* kl = lds + w * 8192 + lane * 16;
#define TSRC(t_) (ksrc + (size_t)((t_) < nkt ? (t_) : nkt - 1) * 32768)
  bf16x8 vA[4], vB[4]; f32x16 cA[2], cB[2];
  k_dma(TSRC(0), voff, kring); v_load(vA, TSRC(0) + 16384, voff); k_dma(TSRC(1), voff, kring + 4096u);
  kv_wait(vA);
  qk_tile(cA, kl, qf);
#pragma unroll 1
  for (int kt = 0; ; kt += 2) {
    k_dma(TSRC(kt + 2), voff, kring); v_load(vB, TSRC(kt + 1) + 16384, voff);
    if (qt - kt <= 4) add_bias(cA, bt0, (t0 + q) - (32 * kt + 8 * hi));
    { const unsigned m16 = maskl[kt * 64 + lane];
      qk_tile(cB, kl + 4096, qf); sm_pv<0>(O, l, cA, vA, m16); }
    kv_wait(vB);
    if (kt + 1 >= nkt) break;
    k_dma(TSRC(kt + 3), voff, kring + 4096u); v_load(vA, TSRC(kt + 2) + 16384, voff);
    if (qt - (kt + 1) <= 4) add_bias(cB, bt0, (t0 + q) - (32 * (kt + 1) + 8 * hi));
    { const unsigned m16 = maskl[(kt + 1) * 64 + lane];
      qk_tile(cA, kl, qf); sm_pv<0>(O, l, cB, vB, m16); }
    kv_wait(vA);
    if (kt + 2 >= nkt) break;
  }
#undef TSRC
  { int tid2 = lane_id_hw(); asm volatile("" : "+v"(tid2)); const int lane2 = tid2 & 63;
    attn_store(O, l, P.SG, P.OG, rowb + t0, 2 * w, ringp, lane2); }
}

DI void moba_unit(LAS unsigned char* lds, const Ptrs& P, int b, int qt, int wave_) {
  int tid = wave_ * 64 + lane_id_hw(); asm volatile("" : "+v"(tid));
  const int lane = tid & 63, w = __builtin_amdgcn_readfirstlane(tid >> 6), q = lane & 31, hi = lane >> 5;
  const int t0 = 32 * qt, ob = qt >> 3; const size_t rowb = (size_t)b * SEQ;
  LAS unsigned char* selm = lds + L_SELM; LAS unsigned* blkw = (LAS unsigned*)(lds + L_BLK);
  bf16x8 qf[2][4];
#pragma unroll
  for (int j = 0; j < 2; ++j)
#pragma unroll
    for (int s = 0; s < 4; ++s) qf[j][s] = *(const bf16x8*)(P.Q + (rowb + t0 + q) * 1024 + (2 * w + j) * 64 + 16 * s + 8 * hi);
  __syncthreads();
  if (tid == 0) blkw[0] = 0u;
  __syncthreads();
  if (ob > 0) {
    const int qq = tid & 31, gg = (tid >> 5) & 3, part = tid >> 7;
    float gs[7];
#pragma unroll
    for (int n = 0; n < 7; ++n) gs[n] = 0.f;
    const bf16* qp = P.Q + (rowb + t0 + qq) * 1024 + gg * 256 + part * 16;
#pragma unroll
    for (int c = 0; c < 2; ++c) {
      float qs[8];
#pragma unroll
      for (int e = 0; e < 8; ++e) qs[e] = 0.f;
#pragma unroll
      for (int j = 0; j < 4; ++j) { const u32x4 v = *(const u32x4*)(qp + j * 64 + c * 8);
        qs[0] += bflo(v.x); qs[1] += bfhi(v.x); qs[2] += bflo(v.y); qs[3] += bfhi(v.y); qs[4] += bflo(v.z); qs[5] += bfhi(v.z); qs[6] += bflo(v.w); qs[7] += bfhi(v.w); }
#pragma unroll
      for (int n = 0; n < 7; ++n) if (n < ob) { const f32x4* km = (const f32x4*)(P.KM + ((size_t)(b * 4 + gg) * 8 + n) * 64 + part * 16 + c * 8); const f32x4 k0 = km[0], k1 = km[1];
        gs[n] += (qs[0] * k0.x + qs[1] * k0.y + qs[2] * k0.z + qs[3] * k0.w) + (qs[4] * k1.x + qs[5] * k1.y + qs[6] * k1.z + qs[7] * k1.w); }
    }
    LAS float* gp = (LAS float*)lds + (size_t)(part * 128 + gg * 32 + qq) * 8;
#pragma unroll
    for (int n = 0; n < 7; ++n) gp[n] = gs[n];
  }
  __syncthreads();
  if (tid < 128) {
    const int qq = tid & 31, gg = tid >> 5; unsigned sel = 0;
    if (ob > 0) {
      float gs[7]; const LAS float* gp = (const LAS float*)lds + (size_t)(gg * 32 + qq) * 8;
#pragma unroll
      for (int n = 0; n < 7; ++n) gs[n] = (n < ob) ? ((gp[n] + gp[1024 + n]) + (gp[2048 + n] + gp[3072 + n])) : -INFINITY;
#pragma unroll
      for (int n = 0; n < 7; ++n) { if (n < ob) { int rank = 0;
#pragma unroll
          for (int m = 0; m < 7; ++m) if (m != n && m < ob) rank += ((gs[m] > gs[n]) || (gs[m] == gs[n] && m < n)) ? 1 : 0;
          if (rank < 3) sel |= 1u << n; } }
    }
    selm[gg * 32 + qq] = (unsigned char)sel;
    if (sel) __hip_atomic_fetch_or(blkw, sel, __ATOMIC_RELAXED, __HIP_MEMORY_SCOPE_WORKGROUP);
  }
  __syncthreads();
  const int g = w >> 1;
  const unsigned mysel = selm[g * 32 + q];
  const unsigned blk = (unsigned)__builtin_amdgcn_readfirstlane(blkw[0]) | (1u << ob);
  const bf16* img = P.KV + (size_t)(b * 64) * 16384;
  const unsigned lds0 = (unsigned)(uintptr_t)lds;
#pragma unroll
  for (int j = 0; j < 2; ++j)
#pragma unroll
    for (int s = 0; s < 4; ++s) asm volatile("" : "+v"(qf[j][s]));
  f32x16 O[2][2]; float l[2] = {0.f, 0.f};
#pragma unroll
  for (int j = 0; j < 2; ++j)
#pragma unroll
    for (int dt = 0; dt < 2; ++dt)
#pragma unroll
      for (int r = 0; r < 16; ++r) O[j][dt][r] = 0.f;
  const LAS float* bt0 = (const LAS float*)(lds + L_BTAB) + (2 * w) * 192;
#define NEXT_TILE(kt_, out_) do { int kn_ = (kt_) + 1; if (kn_ > qt) kn_ = -1; else if (((blk >> (kn_ >> 3)) & 1u) == 0u) kn_ = 8 * ((kn_ >> 3) + __builtin_ctz(blk >> (kn_ >> 3))); (out_) = kn_; } while (0)
  LAS unsigned char* ringp = lds + 65536 + w * 8192;
  const char* ksrc = (const char*)img + g * 4096; const unsigned voff = (unsigned)lane * 16u;
  const unsigned kring = lds0 + (unsigned)w * 8192u; const LAS unsigned char* kl = lds + w * 8192 + lane * 16;
  int ta = 8 * __builtin_ctz(blk), tb, tc, td;
  NEXT_TILE(ta, tb); tc = -1; if (tb >= 0) NEXT_TILE(tb, tc);
  const int tfirst = ta;
#define TSRC(t_) (ksrc + (size_t)((t_) >= 0 ? (t_) : tfirst) * 32768)
#define MOBA_SM(C, VF, KT) do { const int n_ = (KT) >> 3; const unsigned lm_ = (n_ < ob) ? (0u - ((mysel >> n_) & 1u)) : 0xFFFFFFFFu; sm_pv<1>(O, l, C, VF, lm_); } while (0)
  bf16x8 vA[4], vB[4]; f32x16 cA[2], cB[2];
  k_dma(TSRC(ta), voff, kring); v_load(vA, TSRC(ta) + 16384, voff); k_dma(TSRC(tb), voff, kring + 4096u);
  kv_wait(vA);
  qk_tile(cA, kl, qf);
#pragma unroll 1
  while (true) {
    k_dma(TSRC(tc), voff, kring); v_load(vB, TSRC(tb) + 16384, voff);
    if (qt - ta <= 4) add_bias(cA, bt0, (t0 + q) - (32 * ta + 8 * hi));
    qk_tile(cB, kl + 4096, qf); MOBA_SM(cA, vA, ta);
    kv_wait(vB);
    if (tb < 0) break;
    td = -1; if (tc >= 0) NEXT_TILE(tc, td);
    k_dma(TSRC(td), voff, kring + 4096u); v_load(vA, TSRC(tc) + 16384, voff);
    if (qt - tb <= 4) add_bias(cB, bt0, (t0 + q) - (32 * tb + 8 * hi));
    qk_tile(cA, kl, qf); MOBA_SM(cB, vB, tb);
    kv_wait(vA);
    if (tc < 0) break;
    ta = tc; tb = td; tc = -1; if (tb >= 0) NEXT_TILE(tb, tc);
  }
#undef MOBA_SM
#undef TSRC
#undef NEXT_TILE
  { int tid2 = lane_id_hw(); asm volatile("" : "+v"(tid2)); const int lane2 = tid2 & 63;
    attn_store(O, l, P.SG, P.OG, rowb + t0, 2 * w, ringp, lane2); }
}

__global__ void __launch_bounds__(512, 2) fwd(Args args) {
  extern __shared__ __attribute__((aligned(16))) unsigned char lds_raw[];
  LAS unsigned char* lds = (LAS unsigned char*)lds_raw;
  const int wave = __builtin_amdgcn_readfirstlane((int)threadIdx.x >> 6);
#define FRESH_TID(t_) int t_ = wave * 64 + lane_id_hw(); asm volatile("" : "+v"(t_))
  const int G = gridDim.x, bx = blockIdx.x;
  const int vcu = (G % 8 == 0) ? (bx % 8) * (G / 8) + bx / 8 : bx;
  LAS unsigned long long* ptab = (LAS unsigned long long*)(lds + L_MISC + 64);
  { FRESH_TID(tid0);
    if (tid0 < 16) { const unsigned long long* ka = (const unsigned long long*)__builtin_amdgcn_kernarg_segment_ptr(); ptab[tid0] = ka[tid0]; ((LAS unsigned*)(lds + L_MISC))[tid0] = 0u; }
    __syncthreads(); }
#define TABPTR(k) ((unsigned char*)(__attribute__((address_space(1))) unsigned char*)(((unsigned long long)(unsigned)__builtin_amdgcn_readfirstlane((int)(ptab[(k)] >> 32)) << 32) | (unsigned long long)(unsigned)__builtin_amdgcn_readfirstlane((int)(unsigned)ptab[(k)])))
#define LOAD_PTRS() Ptrs P; { asm volatile("" ::: "memory"); unsigned char* ws = TABPTR(15); \
  P.x = (const float*)TABPTR(0); P.norm_a_g = (const float*)TABPTR(1); P.w_in_a = (const float*)TABPTR(2); P.qn_a_g = (const float*)TABPTR(3); P.kn_a_g = (const float*)TABPTR(4); P.w_out_a = (const float*)TABPTR(5); P.rel_bias = (const float*)TABPTR(6); \
  P.norm_kv_g = (const float*)TABPTR(7); P.w_kv = (const float*)TABPTR(8); P.kn_b_g = (const float*)TABPTR(9); P.norm_b_g = (const float*)TABPTR(10); P.w_in_b = (const float*)TABPTR(11); P.qn_b_g = (const float*)TABPTR(12); P.w_out_b = (const float*)TABPTR(13); \
  P.out = (float*)TABPTR(14); \
  P.WtA = (bf16*)(ws + WS_WA); P.WtOA = (bf16*)(ws + WS_WOA); P.WtB = (bf16*)(ws + WS_WB); P.WtOB = (bf16*)(ws + WS_WOB); \
  P.XN = (bf16*)(ws + WS_XN); P.Q = (bf16*)(ws + WS_Q); P.KV = (bf16*)(ws + WS_K); P.SG = (bf16*)(ws + WS_SG); \
  P.IQ = (bf16*)(ws + WS_IQ); P.IK = (bf16*)(ws + WS_IK); P.OG = (bf16*)(ws + WS_OG); \
  P.IW = (float*)(ws + WS_IW); P.KM = (float*)(ws + WS_KM); P.RINV = (float*)(ws + WS_KM + 524288); P.SSQ = (float*)(ws + WS_H1); }
  const int lo = args.ph_lo, hi = args.ph_hi;
#ifndef PH_MASK
#define PH_MASK 0x1ff
#endif
#ifndef REP_MASK
#define REP_MASK 0
#endif
#define IN(k) (((PH_MASK >> (k)) & 1) && lo <= (k) && (k) < hi)
#define NREP(k) ((((REP_MASK) >> (k)) & 1) ? 2 : 1)
#if MK_N_LAUNCHES == 1
  const bool grouped = (G == 256);
  XcdBarrier xbar = xcd_barrier_post((unsigned*)TABPTR(15), (volatile LAS unsigned*)(lds + L_MISC), wave == 0 && lane_id_hw() == 0, (unsigned)G);
  XcdBarrier xbarL = xcd_barrier_post((unsigned*)(TABPTR(15) + 16384 * (1 + (bx & 7))), (volatile LAS unsigned*)(lds + L_MISC) + 2, wave == 0 && lane_id_hw() == 0, (unsigned)(G / 8));
#define SEAM(k) do { if (IN(k) && (hi > (k) + 1)) { if ((k) == 0 || !grouped) xcd_barrier(xbar, wave == 0 && lane_id_hw() == 0); else xcd_barrier(xbarL, wave == 0 && lane_id_hw() == 0); } } while (0)
#else
#define SEAM(k) do { } while (0)
#endif
  const int gw = vcu * 8 + wave, NGW = G * 8;

  if (IN(0)) {
    LOAD_PTRS();
    FRESH_TID(tid); const int lane = tid & 63;
    LAS float* scr = (LAS float*)(lds + wave * 8448);
    constexpr int I_A = 16 * (NCOL_A / 32), I_O = 16 * 32, I_KV = 16 * 16, I_B = 16 * 64;
    constexpr int NITEMS = I_A + I_O + I_KV + I_B + I_O;
#define P0_ITEM(it_) do { int r = (it_); \
      if (r < I_A) { trans_item(P.w_in_a, 3144, P.norm_a_g, P.WtA, r, NCOL_A / 32, 1, scr, lane); break; } r -= I_A; \
      if (r < I_O) { trans_item(P.w_out_a, 1024, nullptr, P.WtOA, r, 32, 0, scr, lane); break; } r -= I_O; \
      if (r < I_KV) { trans_item(P.w_kv, 512, P.norm_kv_g, P.WtB, r, 16, 0, scr, lane); break; } r -= I_KV; \
      if (r < I_B) { trans_item(P.w_in_b, 2048, P.norm_b_g, P.WtB + (size_t)512 * 1024, r, 64, 0, scr, lane); break; } r -= I_B; \
      trans_item(P.w_out_b, 1024, nullptr, P.WtOB, r, 32, 0, scr, lane); } while (0)
    int itw = gw;
    for (int m = gw; m < MTOK; m += 4 * NGW) {
      f32x4 v[4][4]; float ss[4];
#pragma unroll
      for (int u = 0; u < 4; ++u) { const int mm = m + u * NGW; const f32x4* xr = (const f32x4*)(P.x + (size_t)(mm < MTOK ? mm : m) * 1024) + lane;
#pragma unroll
        for (int j = 0; j < 4; ++j) v[u][j] = __builtin_nontemporal_load(xr + 64 * j); }
      if (itw < NITEMS) { P0_ITEM(itw); itw += NGW; }
#pragma unroll
      for (int u = 0; u < 4; ++u) { float a = 0.f;
#pragma unroll
        for (int j = 0; j < 4; ++j) a += (v[u][j].x * v[u][j].x + v[u][j].y * v[u][j].y) + (v[u][j].z * v[u][j].z + v[u][j].w * v[u][j].w);
        ss[u] = a; }
#pragma unroll
      for (int o = 1; o < 64; o <<= 1) {
#pragma unroll
        for (int u = 0; u < 4; ++u) ss[u] += __shfl_xor(ss[u], o); }
#pragma unroll
      for (int u = 0; u < 4; ++u) { const int mm = m + u * NGW; if (mm < MTOK) {
          u32x2* o8 = (u32x2*)(P.XN + (size_t)mm * 1024) + lane;
#pragma unroll
          for (int j = 0; j < 4; ++j) { u32x2 w; w.x = cvtpk(v[u][j].x, v[u][j].y); w.y = cvtpk(v[u][j].z, v[u][j].w); o8[64 * j] = w; }
          if (lane == 0) P.RINV[mm] = rsqrtf(ss[u] * (1.0f / 1024.0f) + EPS); } }
    }
    for (; itw < NITEMS; itw += NGW) P0_ITEM(itw);
#undef P0_ITEM
    for (int i = gw * 64 + lane; i < NBATCH * 4 * 8 * 64; i += NGW * 64) P.KM[i] = 0.f;
    __syncthreads();
  }
  SEAM(0);
  if (IN(1)) for (int rep_ = 0; rep_ < NREP(1); ++rep_) {
    LOAD_PTRS();
    pg8::Gemm g{P.XN, P.WtA, MTOK, NCOL_A, 1024}; OrderR S; S.init(MTOK, NCOL_A, G, bx); S.rv = P.RINV; S.ldsb = (unsigned)(uintptr_t)(lds + L_EPI); S.wv = wave; S.k = 0;
    EpiA E{P.Q, P.KV, P.SG, P.IQ, P.IK, P.IW, P.qn_a_g, P.kn_a_g, (const LAS float*)(lds + L_EPI), 0};
    pg8::gemm_phase<EpiA, OrderR, true, true>(lds, g, S, E, wave);
    __syncthreads();
  }
  SEAM(1);
  if (IN(2)) for (int rep_ = 0; rep_ < NREP(2); ++rep_) {
    LOAD_PTRS();
    { FRESH_TID(tidb); build_btab(lds, P.rel_bias, tidb); }
#pragma unroll 1
    for (int i = 0; ; ++i) { int b, qt;
      if (G == 256) { if (i >= 4) break; const int c = vcu & 31; b = 2 * (vcu >> 5) + (i >> 1); qt = (i & 1) ? c : 63 - c; }
      else { const int u = vcu + i * G; if (u >= 1024) break; b = u >> 6; qt = 63 - (u & 63); }
      dsa_unit(lds, P, b, qt, wave); }
    __syncthreads();
  }
  SEAM(2);
  if (IN(3)) for (int rep_ = 0; rep_ < NREP(3); ++rep_) {
    LOAD_PTRS();
    pg8::Gemm g{P.OG, P.WtOA, MTOK, 1024, 1024}; pg8::StaticOrder S; S.init(MTOK, 1024, G, bx);
    EpiRes2 E{P.XN, P.SSQ};
    pg8::gemm_phase<EpiRes2, pg8::StaticOrder, true, true>(lds, g, S, E, wave);
    __syncthreads();
  }
  SEAM(3);
  if (IN(4)) { LOAD_PTRS(); FRESH_TID(tidr);
    if (G == 256) { if (tidr < 128) { const int r = 4096 * (bx & 7) + 128 * (bx >> 3) + tidr; P.RINV[r] = row_rinv(P.SSQ, r); } }
    else for (int r = bx * 512 + tidr; r < MTOK; r += G * 512) P.RINV[r] = row_rinv(P.SSQ, r); }
  SEAM(4);
  if (IN(5)) for (int rep_ = 0; rep_ < NREP(5); ++rep_) {
    LOAD_PTRS();
    pg8::Gemm g{P.XN, P.WtB, MTOK, NCOL_B, 1024}; OrderR S; S.init(MTOK, NCOL_B, G, bx); S.rv = P.RINV; S.ldsb = (unsigned)(uintptr_t)(lds + L_EPI); S.wv = wave; S.k = 0;
    EpiB E{P.Q, P.KV, P.SG, P.qn_b_g, P.kn_b_g, (const LAS float*)(lds + L_EPI), P.KM, 0};
    pg8::gemm_phase<EpiB, OrderR, true, true>(lds, g, S, E, wave);
    __syncthreads();
  }
  SEAM(5);
  if (IN(7)) for (int rep_ = 0; rep_ < NREP(7); ++rep_) {
    LOAD_PTRS();
    { FRESH_TID(tidb); build_btab(lds, P.rel_bias, tidb); }
#pragma unroll 1
    for (int i = 0; ; ++i) { int b, qt;
      if (G == 256) { if (i >= 4) break; const int c = vcu & 31; b = 2 * (vcu >> 5) + (i >> 1); qt = (i & 1) ? c : 63 - c; }
      else { const int u = vcu + i * G; if (u >= 1024) break; b = u >> 6; qt = 63 - (u & 63); }
      moba_unit(lds, P, b, qt, wave); }
    __syncthreads();
  }
  SEAM(7);
  if (IN(8)) for (int rep_ = 0; rep_ < NREP(8); ++rep_) {
    LOAD_PTRS();
    pg8::Gemm g{P.OG, P.WtOB, MTOK, 1024, 1024}; pg8::StaticOrder S; S.init(MTOK, 1024, G, bx);
    EpiRes E{P.XN, P.out, lds + L_EPI};
    pg8::gemm_phase<EpiRes, pg8::StaticOrder, true, true>(lds, g, S, E, wave);
  }
#undef IN
#undef SEAM
}

extern "C" void kernel_launch(void* const* d_in, const int* in_sizes, int n_in, void* d_out, int out_size, void* d_ws, size_t ws_size, hipStream_t stream) {
  static int grid = 0;
  if (grid == 0) {
    if (n_in != 14 || out_size != MTOK * DM || ws_size < WS_END) { fprintf(stderr, "kernel_launch: unexpected problem (n_in %d, out %d, ws %zu)\n", n_in, out_size, ws_size); grid = -1; return; }
    int dev = 0, cus = 0, per_cu = 0;
    if (hipGetDevice(&dev) != hipSuccess || hipDeviceGetAttribute(&cus, hipDeviceAttributeMultiprocessorCount, dev) != hipSuccess) { grid = -1; return; }
    if (hipFuncSetAttribute((const void*)fwd, hipFuncAttributeMaxDynamicSharedMemorySize, LDS_BYTES) != hipSuccess) { fprintf(stderr, "kernel_launch: hipFuncSetAttribute failed\n"); grid = -1; return; }
    if (hipOccupancyMaxActiveBlocksPerMultiprocessor(&per_cu, (const void*)fwd, 512, LDS_BYTES) != hipSuccess || per_cu < 1) { fprintf(stderr, "kernel_launch: occupancy query says %d\n", per_cu); per_cu = 1; }
    (void)hipGetLastError();
    grid = cus;
  }
  if (grid < 0) return;
  Args a{};
  for (int i = 0; i < 14; ++i) a.in[i] = (const float*)d_in[i];
  a.out = (float*)d_out; a.ws = (unsigned char*)d_ws;
#if MK_N_LAUNCHES == 1
  if (hipMemsetAsync(d_ws, 0, 16384 * 9, stream) != hipSuccess) { fprintf(stderr, "kernel_launch: memset of the barrier words failed\n"); return; }
  a.ph_lo = 0; a.ph_hi = NPHASE;
  void* kargs[] = {&a};
  hipError_t e = hipLaunchCooperativeKernel((const void*)fwd, dim3(grid), dim3(512), kargs, LDS_BYTES, stream);
  if (e != hipSuccess) fprintf(stderr, "kernel_launch: cooperative launch failed: %s\n", hipGetErrorString(e));
#else
#ifndef HOST_REP_MASK
#define HOST_REP_MASK 0
#endif
  for (int p = 0; p < NPHASE; ++p) { a.ph_lo = p; a.ph_hi = p + 1; for (int r = 0; r < (((HOST_REP_MASK >> p) & 1) ? 2 : 1); ++r) hipLaunchKernelGGL(fwd, dim3(grid), dim3(512), LDS_BYTES, stream, a); }
#endif
}
```

```cpp
#include <hip/hip_runtime.h>
#include <hip/hip_cooperative_groups.h>
#include <cstdio>
#include <cstdint>
__device__ __forceinline__ int lane_id_hw() { unsigned z = 0u; asm volatile("" : "+v"(z)); return (int)__builtin_amdgcn_mbcnt_hi(~0u, __builtin_amdgcn_mbcnt_lo(~0u, z)); }
namespace pg8 {
#define PG8_LAS __attribute__((address_space(3)))
typedef unsigned short bf16_t;
typedef short bf16x8 __attribute__((ext_vector_type(8)));
typedef float f32x4 __attribute__((ext_vector_type(4)));
typedef unsigned u32x4 __attribute__((ext_vector_type(4)));
constexpr int BM = 256, BK = 64, HALF = 128, HTB = HALF * BK * 2  , STAGE_BYTES = 8 * HTB, NXCD = 8, WGM = 8;

__host__ __device__ __forceinline__ int lds_byte(int r, int c) { const int st = (r >> 4) * 2 + (c >> 5), rr = r & 15, cc = c & 31, ob = rr * 64 + cc * 2; return st * 1024 + (ob ^ (((ob >> 9) & 1) << 5)); }
__host__ __device__ __forceinline__ void stage_rc(int b, int& R, int& C) { const int st = b / 1024, sb = b % 1024, swz = sb ^ (((sb >> 9) & 1) << 5); R = (st >> 1) * 16 + swz / 64; C = (st & 1) * 32 + (swz % 64) / 2; }
__host__ __device__ __forceinline__ int perm32(int rho) { const int n = rho >> 4, i = rho & 15; return 8 * (i >> 2) + 4 * n + (i & 3); }

struct Unit { int pm, pn; };
struct Gemm { const bf16_t* A; const bf16_t* Bt; int M, N, K; };

struct StaticOrder {
    int nM, nN, nwg, G, c;
    __host__ __device__ void init(int M, int N, int G_, int c_) { nM = M / BM; nN = N / BM; nwg = nM * nN; G = G_; c = c_; }
    __host__ __device__ bool next(int i, Unit& u) const {
        const long L = (long)i * G + c; if (L >= nwg) return false;
        int wgid = (int)L; { const int q = nwg / NXCD, r = nwg % NXCD, xcd = wgid % NXCD, off = wgid / NXCD; wgid = (xcd < r ? xcd * (q + 1) : r * (q + 1) + (xcd - r) * q) + off; }
        const int nig = WGM * nN, gid = wgid / nig, fm = gid * WGM, gsz = (nM - fm) < WGM ? (nM - fm) : WGM;
        u.pm = fm + ((wgid % nig) % gsz); u.pn = (wgid % nig) / gsz; return true;
    }
    __device__ __forceinline__ void a_ready(const Unit&) const {}
    __device__ __forceinline__ void done(const Unit&) const {}
};

template <class Epi, class Sched, bool ALIGN_EPI = false, bool SP2 = false>
__device__ __forceinline__ void gemm_phase(PG8_LAS unsigned char* lds, const Gemm g, const Sched& S, const Epi& E, int wave_) {
    const int tid = wave_ * 64 + lane_id_hw(), wid = __builtin_amdgcn_readfirstlane(tid >> 6), lane = tid & 63, wr = wid >> 2, wc = wid & 3, fr = lane & 15, fq = lane >> 4;
    const int K = g.K, nt = K / BK;
    unsigned voffA[2], voffB[2];
#pragma unroll
    for (int i = 0; i < 2; ++i) { int R, C; stage_rc(tid * 16 + i * 8192, R, C); const int Rb = Epi::PERM ? ((R & ~31) + perm32(R & 31)) : R;
        voffA[i] = (unsigned)(R * K + C) * 2u; voffB[i] = (unsigned)(Rb * K + C) * 2u; }
    const size_t kstep = (size_t)(BK * 2);
    const size_t hstep = (size_t)HALF * K * 2;
    const size_t tstep = 2 * hstep;
    const unsigned ldsw = (unsigned)wid * 1024u;
    const int aoff = lds_byte(wr * 64 + fr, fq * 8), boff = lds_byte(wc * 32 + fr, fq * 8);
#define PG8_SA(b, h) (((b) * 2 + (h)) * HTB)
#define PG8_SB(b, h) ((4 + (b) * 2 + (h)) * HTB)
#define PG8_STAGE(bufoff, gbase, voff) do { _Pragma("unroll") for (int _i = 0; _i < 2; ++_i) \
        __builtin_amdgcn_global_load_lds((const unsigned*)((const char*)(gbase) + (voff)[_i]), (PG8_LAS unsigned*)(lds + (bufoff) + ldsw + _i * 8192), 16, 0, 0); } while (0)
#define PG8_LDA(dst, b, h) do { _Pragma("unroll") for (int m = 0; m < 4; ++m) _Pragma("unroll") for (int k = 0; k < 2; ++k) dst[m][k] = *(const PG8_LAS bf16x8*)(lds + PG8_SA(b, h) + aoff + m * 2048 + k * 1024); } while (0)
#define PG8_LDB(dst, b, h) do { _Pragma("unroll") for (int n = 0; n < 2; ++n) _Pragma("unroll") for (int k = 0; k < 2; ++k) dst[n][k] = *(const PG8_LAS bf16x8*)(lds + PG8_SB(b, h) + boff + n * 2048 + k * 1024); } while (0)
#define PG8_MMA(ai, bj, At, Bt) do { __builtin_amdgcn_s_setprio(1); _Pragma("unroll") for (int m = 0; m < 4; ++m) _Pragma("unroll") for (int n = 0; n < 2; ++n) _Pragma("unroll") for (int k = 0; k < 2; ++k) \
        acc[ai][bj][m][n] = __builtin_amdgcn_mfma_f32_16x16x32_bf16(Bt[n][k], At[m][k], acc[ai][bj][m][n], 0, 0, 0); __builtin_amdgcn_s_setprio(0); } while (0)
#define PG8_WAIT_V(n) asm volatile("s_waitcnt vmcnt(" #n ")" ::: "memory")
#define PG8_WAIT_L(n) asm volatile("s_waitcnt lgkmcnt(" #n ")" ::: "memory")
#define PG8_BAR __builtin_amdgcn_s_barrier()
#define PG8_SCHED __builtin_amdgcn_sched_barrier(0)
    Unit cur, nxt; int ui = 0;
    if (!S.next(0, cur)) return;
    f32x4 acc[2][2][4][2];
#pragma unroll
    for (int a = 0; a < 2; ++a)
#pragma unroll
        for (int b = 0; b < 2; ++b)
#pragma unroll
            for (int m = 0; m < 4; ++m)
#pragma unroll
                for (int n = 0; n < 2; ++n) acc[a][b][m][n] = (f32x4){0.f, 0.f, 0.f, 0.f};
    bf16x8 At[4][2], B0[2][2], B1[2][2];
    const char* cA = (const char*)g.A + (size_t)cur.pm * tstep; const char* cB = (const char*)g.Bt + (size_t)cur.pn * tstep;
    S.a_ready(cur);
    if constexpr (SP2) {
        PG8_STAGE(PG8_SB(0, 0), cB, voffB); PG8_STAGE(PG8_SB(0, 1), cB + hstep, voffB); PG8_STAGE(PG8_SA(0, 0), cA, voffA); PG8_STAGE(PG8_SA(0, 1), cA + hstep, voffA);
        if (wr == 1) PG8_BAR;
        PG8_WAIT_V(2); PG8_BAR;
        PG8_STAGE(PG8_SB(1, 0), cB + kstep, voffB); PG8_STAGE(PG8_SA(1, 0), cA + kstep, voffA); PG8_STAGE(PG8_SB(1, 1), cB + hstep + kstep, voffB);
        PG8_WAIT_V(6); PG8_BAR;
    } else {
        PG8_STAGE(PG8_SB(0, 0), cB, voffB); PG8_STAGE(PG8_SA(0, 0), cA, voffA); PG8_STAGE(PG8_SB(0, 1), cB + hstep, voffB); PG8_STAGE(PG8_SA(0, 1), cA + hstep, voffA);
        if (wr == 1) PG8_BAR;
        PG8_WAIT_V(4); PG8_BAR;
        PG8_STAGE(PG8_SB(1, 0), cB + kstep, voffB); PG8_STAGE(PG8_SA(1, 0), cA + kstep, voffA); PG8_STAGE(PG8_SB(1, 1), cB + hstep + kstep, voffB);
        PG8_WAIT_V(6); PG8_BAR;
    }
    for (;;) {
        const bool has_next = S.next(ui + 1, nxt);
        const char* nA = has_next ? (const char*)g.A + (size_t)nxt.pm * tstep : cA; const char* nB = has_next ? (const char*)g.Bt + (size_t)nxt.pn * tstep : cB;
        for (int t = 0; t < nt; t += 2) {
            const bool last = (t == nt - 2);
            const char* a1 = cA + (size_t)(t + 1) * kstep;
            const char* a2 = last ? nA : cA + (size_t)(t + 2) * kstep; const char* b2 = last ? nB : cB + (size_t)(t + 2) * kstep;
            const char* a3 = a2 + kstep; const char* b3 = b2 + kstep;
            if (last && has_next) S.a_ready(nxt);
            if constexpr (SP2) {
            PG8_LDB(B0, 0, 0); PG8_LDB(B1, 0, 1); PG8_SCHED; PG8_LDA(At, 0, 0); PG8_STAGE(PG8_SA(1, 1), a1 + hstep, voffA);
            PG8_WAIT_V(8); PG8_WAIT_L(0); PG8_BAR; PG8_MMA(0, 0, At, B0); PG8_MMA(0, 1, At, B1); PG8_BAR; PG8_SCHED;
            PG8_LDA(At, 0, 1); PG8_STAGE(PG8_SB(0, 0), b2, voffB); PG8_STAGE(PG8_SB(0, 1), b2 + hstep, voffB); PG8_STAGE(PG8_SA(0, 0), a2, voffA);
            PG8_WAIT_V(8); PG8_WAIT_L(0); PG8_BAR; PG8_MMA(1, 0, At, B0); PG8_MMA(1, 1, At, B1); PG8_BAR; PG8_SCHED;
            PG8_LDB(B0, 1, 0); PG8_LDB(B1, 1, 1); PG8_SCHED; PG8_LDA(At, 1, 0); PG8_STAGE(PG8_SA(0, 1), a2 + hstep, voffA);
            PG8_WAIT_V(8); PG8_WAIT_L(0); PG8_BAR; PG8_MMA(0, 0, At, B0); PG8_MMA(0, 1, At, B1); PG8_BAR; PG8_SCHED;
            PG8_LDA(At, 1, 1); PG8_STAGE(PG8_SB(1, 0), b3, voffB); PG8_STAGE(PG8_SB(1, 1), b3 + hstep, voffB); PG8_STAGE(PG8_SA(1, 0), a3, voffA);
            PG8_WAIT_V(8); PG8_WAIT_L(0); PG8_BAR; PG8_MMA(1, 0, At, B0); PG8_MMA(1, 1, At, B1); PG8_BAR; PG8_SCHED;
            } else {
            PG8_LDB(B0, 0, 0); PG8_SCHED; PG8_LDA(At, 0, 0); PG8_STAGE(PG8_SA(1, 1), a1 + hstep, voffA);
            PG8_WAIT_L(8); PG8_BAR; PG8_WAIT_L(0); PG8_MMA(0, 0, At, B0); PG8_BAR; PG8_SCHED;
            PG8_LDB(B1, 0, 1); PG8_STAGE(PG8_SB(0, 0), b2, voffB);
            PG8_BAR; PG8_WAIT_L(0); PG8_MMA(0, 1, At, B1); PG8_BAR;
            PG8_LDA(At, 0, 1); PG8_STAGE(PG8_SA(0, 0), a2, voffA);
            PG8_BAR; PG8_WAIT_L(0); PG8_MMA(1, 0, At, B0); PG8_BAR; PG8_SCHED;
            PG8_STAGE(PG8_SB(0, 1), b2 + hstep, voffB);
            PG8_WAIT_V(6); PG8_BAR; PG8_MMA(1, 1, At, B1); PG8_BAR;
            PG8_LDB(B0, 1, 0); PG8_SCHED; PG8_LDA(At, 1, 0); PG8_STAGE(PG8_SA(0, 1), a2 + hstep, voffA);
            PG8_WAIT_L(8); PG8_BAR; PG8_WAIT_L(0); PG8_MMA(0, 0, At, B0); PG8_BAR; PG8_SCHED;
            PG8_LDB(B1, 1, 1); PG8_STAGE(PG8_SB(1, 0), b3, voffB);
            PG8_BAR; PG8_WAIT_L(0); PG8_MMA(0, 1, At, B1); PG8_BAR;
            PG8_LDA(At, 1, 1); PG8_STAGE(PG8_SA(1, 0), a3, voffA);
            PG8_BAR; PG8_WAIT_L(0); PG8_MMA(1, 0, At, B0); PG8_BAR; PG8_SCHED;
            PG8_STAGE(PG8_SB(1, 1), b3 + hstep, voffB);
            PG8_WAIT_V(6); PG8_BAR; PG8_MMA(1, 1, At, B1); PG8_BAR;
            }
        }
        if constexpr (ALIGN_EPI) { if (wr == 0) PG8_BAR; }
        if constexpr (!Epi::AFTER_DRAIN) { E(acc, cur, wr, wc, fr, fq); S.done(cur); }
        if (!has_next) break;
#pragma unroll
        for (int a = 0; a < 2; ++a)
#pragma unroll
            for (int b = 0; b < 2; ++b)
#pragma unroll
                for (int m = 0; m < 4; ++m)
#pragma unroll
                    for (int n = 0; n < 2; ++n) acc[a][b][m][n] = (f32x4){0.f, 0.f, 0.f, 0.f};
        cur = nxt; cA = nA; cB = nB; ++ui;
        if constexpr (ALIGN_EPI) { if (wr == 1) PG8_BAR; }
    }
    PG8_WAIT_V(0);
    if constexpr (!ALIGN_EPI) { if (wr == 0) PG8_BAR; }
    PG8_BAR;
    if constexpr (Epi::AFTER_DRAIN) { E.fused(acc, cur, wr, wc, fr, fq, lds, wid, lane); S.done(cur); }
#undef PG8_SA
#undef PG8_SB
#undef PG8_STAGE
#undef PG8_LDA
#undef PG8_LDB
#undef PG8_MMA
#undef PG8_WAIT_V
#undef PG8_WAIT_L
#undef PG8_BAR
#undef PG8_SCHED
}
}

#ifndef MK_N_LAUNCHES
#define MK_N_LAUNCHES 1
#endif
namespace cg = cooperative_groups;
#define DI __device__ __forceinline__
#define LAS __attribute__((address_space(3)))
typedef unsigned short bf16;
typedef short bf16x8 __attribute__((ext_vector_type(8)));
typedef float f32x4 __attribute__((ext_vector_type(4)));
typedef float f32x16 __attribute__((ext_vector_type(16)));
typedef unsigned u32x4 __attribute__((ext_vector_type(4)));
typedef unsigned u32x2 __attribute__((ext_vector_type(2)));
typedef float f32x2_t __attribute__((ext_vector_type(2)));
typedef __bf16 bf16x2_t __attribute__((ext_vector_type(2)));
typedef short s16x2 __attribute__((ext_vector_type(2)));
typedef unsigned short u16x2 __attribute__((ext_vector_type(2)));

constexpr int SEQ = 2048, DM = 1024, NBATCH = 16, MTOK = NBATCH * SEQ;
constexpr int NCOL_A = 3328, NCOL_B = 2560;
constexpr float EPS = 1e-6f;
constexpr float LOG2E = 1.4426950408889634f;
constexpr float C2 = 0.125f * LOG2E;
constexpr int NPHASE = 9;

constexpr size_t MiB = 1u << 20;
constexpr size_t WS_WA = 1 * MiB, WS_WOA = 8 * MiB, WS_WB = 10 * MiB, WS_WOB = 15 * MiB, WS_KM = 17 * MiB, WS_IW = 18 * MiB, WS_IK = 19 * MiB;
constexpr size_t WS_XN = 24 * MiB, WS_Q = 88 * MiB, WS_K = 152 * MiB, WS_VT = 168 * MiB, WS_SG = 184 * MiB, WS_IQ = 248 * MiB, WS_OG = 280 * MiB, WS_H1 = 344 * MiB, WS_END = 472 * MiB;

constexpr int LDS_BYTES = 153600;
constexpr int IQ_STRIDE = 1040;
constexpr int L_IQ = 0, L_HIST = 33280, L_SEL = 131072, L_MASK = L_SEL + 512, L_BTAB = L_MASK + 8192, L_SELM = L_BTAB + 12288, L_BLK = L_SELM + 128, L_END = L_BLK + 16;
static_assert(L_HIST + 32 * 257 * 4 + 256 <= L_SEL, "selection scratch inside the ring");
constexpr int L_EPI = 131072;
static_assert(L_EPI + 8 * 2304 <= 152320, "epilogue staging");
constexpr int L_MISC = 152320;
static_assert(L_END <= L_MISC && L_MISC + 64 + 128 <= LDS_BYTES && LDS_BYTES <= 163840, "LDS map");

__device__ const unsigned char BKT[128] = {
  0, 1, 2, 3, 4, 5, 6, 7, 8, 9, 10, 11, 12, 13, 14, 15, 16, 16, 16, 17, 17, 18, 18, 18, 19, 19, 19, 20, 20, 20, 20, 21,
  21, 21, 21, 22, 22, 22, 22, 22, 23, 23, 23, 23, 23, 23, 24, 24, 24, 24, 24, 24, 25, 25, 25, 25, 25, 25, 25, 26, 26, 26, 26, 26,
  26, 26, 26, 27, 27, 27, 27, 27, 27, 27, 27, 27, 27, 28, 28, 28, 28, 28, 28, 28, 28, 28, 28, 29, 29, 29, 29, 29, 29, 29, 29, 29,
  29, 29, 29, 30, 30, 30, 30, 30, 30, 30, 30, 30, 30, 30, 30, 30, 30, 31, 31, 31, 31, 31, 31, 31, 31, 31, 31, 31, 31, 31, 31, 31};

struct Args { const float* in[14]; float* out; unsigned char* ws; int ph_lo, ph_hi; };

struct Ptrs {
  const float *x, *norm_a_g, *w_in_a, *qn_a_g, *kn_a_g, *w_out_a, *rel_bias, *norm_kv_g, *w_kv, *kn_b_g, *norm_b_g, *w_in_b, *qn_b_g, *w_out_b;
  float* out;
  bf16 *WtA, *WtOA, *WtB, *WtOB, *XN, *Q, *KV, *SG, *IQ, *IK, *OG;
  float *IW, *KM, *RINV, *SSQ;
};

DI unsigned cvtpk(float lo, float hi) { f32x2_t v = {lo, hi}; bf16x2_t b = __builtin_convertvector(v, bf16x2_t); return __builtin_bit_cast(unsigned, b); }
DI float bflo(unsigned u) { return __uint_as_float(u << 16); }
DI float bfhi(unsigned u) { return __uint_as_float(u & 0xffff0000u); }
DI float wave_sum(float v) {
#pragma unroll
  for (int o = 1; o < 64; o <<= 1) v += __shfl_xor(v, o);
  return v;
}
DI float silu_f(float v) { return v * __builtin_amdgcn_rcpf(1.0f + __expf(-v)); }
#define MFMA32(a, b, c) __builtin_amdgcn_mfma_f32_32x32x16_bf16((a), (b), (c), 0, 0, 0)

#define XB_TMO      128
#define XB_XCNT(j)  (256  + 64 * (j))
#define XB_XSUB(j)  (1280 + 64 * (j))
#define XB_XGEN(j)  (2304 + 64 * (j))
#define XB_TOP      3328
#define XB_TOPGEN   3392
#define XCD_BAR_WORDS 3456
#define XB_SPIN_CAP (1u << 18)

__device__ __forceinline__ unsigned xb_ld(unsigned* p)              { return __hip_atomic_load(p, __ATOMIC_RELAXED, __HIP_MEMORY_SCOPE_AGENT); }
__device__ __forceinline__ unsigned xb_add(unsigned* p, unsigned v) { return __hip_atomic_fetch_add(p, v, __ATOMIC_RELAXED, __HIP_MEMORY_SCOPE_AGENT); }
__device__ __forceinline__ unsigned xb_xcc_id() { return (unsigned)__builtin_amdgcn_s_getreg((3 << 11) | 20) & 0xFu; }
#define XB_SPIN(cond, bar) do { unsigned _sp = 0; while (cond) { __builtin_amdgcn_s_sleep(1); \
    if ((++_sp & 255u) == 0u) { if (xb_ld(&(bar)[XB_TMO])) break; if (_sp > XB_SPIN_CAP) { atomicAdd(&(bar)[XB_TMO], 1u); break; } } } } while (0)

struct XcdBarrier {
    unsigned* bar; unsigned x; unsigned total;
    volatile LAS unsigned* st;
};

__device__ __forceinline__ XcdBarrier xcd_barrier_post(unsigned* bar, volatile LAS unsigned* st, bool lead_, unsigned total_) {
    XcdBarrier b; b.bar = bar; b.x = xb_xcc_id(); b.st = st; b.total = total_;
    if (lead_) (void)xb_add(&bar[XB_XCNT(b.x)], 1u);
    return b;
}
__device__ __forceinline__ void xcd_barrier_complete(unsigned* bar, unsigned x, unsigned& nloc, unsigned& nx, unsigned G) {
    unsigned sum, cnt, mine, sp = 0u;
    for (;;) {
        sum = 0u; cnt = 0u; mine = 0u;
#pragma unroll
        for (unsigned j = 0; j < 16; ++j) { const unsigned c = xb_ld(&bar[XB_XCNT(j)]); sum += c; cnt += (c > 0u) ? 1u : 0u; mine = (j == x) ? c : mine; }
        if (sum == G) break;
        __builtin_amdgcn_s_sleep(1);
        if ((++sp & 255u) == 0u) { if (xb_ld(&bar[XB_TMO])) break; if (sp > XB_SPIN_CAP) { atomicAdd(&bar[XB_TMO], 1u); break; } }
    }
    nloc = mine > 0u ? mine : 1u; nx = cnt > 0u ? cnt : 1u;
}

__device__ __forceinline__ void xcd_barrier(const XcdBarrier& b, bool lead_) {
    asm volatile("s_waitcnt vmcnt(0)" ::: "memory");
    __syncthreads();
    if (lead_) {
        unsigned* bar = b.bar;
        __builtin_amdgcn_s_waitcnt(0);
        unsigned nloc = b.st[0], nx = b.st[1];
        if (nloc == 0u) { xcd_barrier_complete(bar, b.x, nloc, nx, b.total); b.st[0] = nloc; b.st[1] = nx; }
        const unsigned old = xb_add(&bar[XB_XSUB(b.x)], 1u);
        const unsigned gen = old / nloc;
        if (old + 1u == (gen + 1u) * nloc) {
            __builtin_amdgcn_fence(__ATOMIC_RELEASE, "agent");
            asm volatile("s_waitcnt vmcnt(0)" ::: "memory");
            if (nx > 1u) {
            const unsigned og = xb_add(&bar[XB_TOP], 1u);
            const unsigned tg = og / nx;
            if (og + 1u == (tg + 1u) * nx) xb_add(&bar[XB_TOPGEN], 1u);
            else XB_SPIN(xb_ld(&bar[XB_TOPGEN]) == tg, bar);
            }
            if (nx == 1u) (void)__hip_atomic_fetch_add(&bar[XB_XGEN(b.x)], 1u, __ATOMIC_RELAXED, __HIP_MEMORY_SCOPE_AGENT);
            __builtin_amdgcn_fence(__ATOMIC_ACQUIRE, "agent");
            if (nx > 1u) xb_add(&bar[XB_XGEN(b.x)], 1u);
            asm volatile("s_waitcnt vmcnt(0)" ::: "memory");
        } else {
            XB_SPIN(xb_ld(&bar[XB_XGEN(b.x)]) == gen, bar);
            __builtin_amdgcn_fence(__ATOMIC_ACQUIRE, "agent");
            asm volatile("s_waitcnt vmcnt(0)" ::: "memory");
        }
    }
    __syncthreads();
}

DI int slot_of(int gc) { const int u = gc & 255; return (gc & ~255) + 128 * ((u >> 5) & 1) + 32 * (u >> 6) + 16 * ((u >> 2) & 1) + 4 * ((u >> 3) & 3) + (u & 3); }

typedef pg8::f32x4 accq;
DI int pi32(int r) { return (r & ~12) | ((r & 4) << 1) | ((r & 8) >> 1); }
DI size_t kv_tile_elem(int row) { return (size_t)(row >> 5) * 16384; }
DI bf16* k_piece(bf16* KV, int row, int g, int bj, int fq) {
  return KV + kv_tile_elem(row) + (size_t)(((g * 4 + 2 * bj + (fq >> 1)) * 64 + (fq & 1) * 32 + pi32(row & 31)) * 8);
}
struct OrderR : pg8::StaticOrder {
  const float* rv; unsigned ldsb; int wv; mutable int k;
  DI void a_ready(const pg8::Unit& u) const {
    if (wv == 0) { const float* src = rv + (size_t)u.pm * 256 + lane_id_hw() * 4; unsigned keep; const unsigned dst = (unsigned)__builtin_amdgcn_readfirstlane((int)(ldsb + (unsigned)(k & 1) * 1024u));
      asm volatile("s_mov_b32 %0, m0\n\ts_mov_b32 m0, %2\n\ts_nop 0\n\tglobal_load_lds_dwordx4 %1, off\n\ts_mov_b32 m0, %0\n\ts_nop 0" : "=&s"(keep) : "v"(src), "s"(dst) : "memory"); }
    ++k;
  }
};
struct OrderS : pg8::StaticOrder {
  const float* sv; unsigned ldsb; int wv; mutable int k;
  DI void a_ready(const pg8::Unit& u) const {
    if (wv == 0) { const char* src = (const char*)(sv + (size_t)u.pm * 1024) + lane_id_hw() * 16; const unsigned dst0 = ldsb + (unsigned)(k & 1) * 4096u;
#pragma unroll
      for (int i = 0; i < 4; ++i) { unsigned keep; const unsigned d_ = (unsigned)__builtin_amdgcn_readfirstlane((int)(dst0 + (unsigned)i * 1024u)); const char* p_ = src + i * 1024;
        asm volatile("s_mov_b32 %0, m0\n\ts_mov_b32 m0, %2\n\ts_nop 0\n\tglobal_load_lds_dwordx4 %1, off\n\ts_mov_b32 m0, %0\n\ts_nop 0" : "=&s"(keep) : "v"(p_), "s"(d_) : "memory"); } }
    ++k;
  }
};
DI void load_gain(float (&gv)[2][2][4], const float* g, int fq, float sc) {
#pragma unroll
  for (int bj = 0; bj < 2; ++bj)
#pragma unroll
    for (int n = 0; n < 2; ++n)
#pragma unroll
      for (int e = 0; e < 4; ++e) gv[bj][n][e] = g[32 * bj + 8 * fq + 4 * n + e] * sc;
}
template <int ACT  > DI void plain_store(const accq (&acc)[2][2][4][2], int ai, int m, float sc, bf16* dst) {
#pragma unroll
  for (int bj = 0; bj < 2; ++bj) {
    float v[8];
#pragma unroll
    for (int n = 0; n < 2; ++n)
#pragma unroll
      for (int e = 0; e < 4; ++e) { float t = acc[ai][bj][m][n][e] * sc; if (ACT == 1) t = silu_f(t); v[4 * n + e] = t; }
    u32x4 w; w.x = cvtpk(v[0], v[1]); w.y = cvtpk(v[2], v[3]); w.z = cvtpk(v[4], v[5]); w.w = cvtpk(v[6], v[7]);
    *(u32x4*)(dst + 32 * bj) = w;
  }
}
DI void v_store_scaled(const accq (&acc)[2][2][4][2], int ai, int m, bf16* KV, int row, int g, int fq, float sc) {
  const int i = row & 31;
  bf16* base = KV + kv_tile_elem(row) + (size_t)((16 + g * 4 + (i >> 4)) * 512 + ((i >> 3) & 1) * 256 + (i & 7));
#pragma unroll
  for (int bj = 0; bj < 2; ++bj)
#pragma unroll
    for (int n = 0; n < 2; ++n)
#pragma unroll
      for (int e = 0; e < 4; e += 2) {
        const unsigned pk = cvtpk(acc[ai][bj][m][n][e] * sc, acc[ai][bj][m][n][e + 1] * sc);
        const int r = 8 * fq + 4 * n + e;
        base[bj * 1024 + r * 8] = (bf16)(pk & 0xffffu); base[bj * 1024 + (r + 1) * 8] = (bf16)(pk >> 16);
      }
}

struct EpiA {
  static constexpr bool PERM = false, AFTER_DRAIN = false;
  bf16 *Q, *KV, *SG, *IQ, *IK; float* IW; const float *qn_g, *kn_g; const LAS float* rl; mutable int k;
  DI void operator()(const accq (&acc)[2][2][4][2], const pg8::Unit& u, int wr, int wc, int fr, int fq) const {
    const int pn = u.pn, row0 = u.pm * 256 + wr * 64 + fr; const LAS float* rinv = rl + (k & 1) * 256 - u.pm * 256; ++k;
    if (pn <= 4) {
      float gv[2][2][4]; load_gain(gv, pn < 4 ? qn_g : kn_g, fq, pn < 4 ? C2 : 1.0f);
#pragma unroll
      for (int ai = 0; ai < 2; ++ai)
#pragma unroll
        for (int m = 0; m < 4; ++m) { const int row = row0 + 128 * ai + 16 * m; const float ri = rinv[row];
          float v[2][2][4]; float ss = 0.f;
#pragma unroll
          for (int bj = 0; bj < 2; ++bj)
#pragma unroll
            for (int n = 0; n < 2; ++n)
#pragma unroll
              for (int e = 0; e < 4; ++e) { v[bj][n][e] = acc[ai][bj][m][n][e] * ri; ss += v[bj][n][e] * v[bj][n][e]; }
          ss += __shfl_xor(ss, 16); ss += __shfl_xor(ss, 32);
          const float rn = rsqrtf(ss * (1.0f / 64.0f) + EPS);
#pragma unroll
          for (int bj = 0; bj < 2; ++bj) {
            u32x4 w; w.x = cvtpk(v[bj][0][0] * rn * gv[bj][0][0], v[bj][0][1] * rn * gv[bj][0][1]); w.y = cvtpk(v[bj][0][2] * rn * gv[bj][0][2], v[bj][0][3] * rn * gv[bj][0][3]);
            w.z = cvtpk(v[bj][1][0] * rn * gv[bj][1][0], v[bj][1][1] * rn * gv[bj][1][1]); w.w = cvtpk(v[bj][1][2] * rn * gv[bj][1][2], v[bj][1][3] * rn * gv[bj][1][3]);
            bf16* dst = pn < 4 ? Q + (size_t)row * 1024 + (4 * pn + wc) * 64 + 8 * fq + 32 * bj : k_piece(KV, row, wc, bj, fq);
            *(u32x4*)dst = w; } }
    } else if (pn == 5) {
#pragma unroll
      for (int ai = 0; ai < 2; ++ai)
#pragma unroll
        for (int m = 0; m < 4; ++m) { const int row = row0 + 128 * ai + 16 * m; v_store_scaled(acc, ai, m, KV, row, wc, fq, rinv[row]); }
    } else if (pn <= 9) {
#pragma unroll
      for (int ai = 0; ai < 2; ++ai)
#pragma unroll
        for (int m = 0; m < 4; ++m) { const int row = row0 + 128 * ai + 16 * m; plain_store<1>(acc, ai, m, rinv[row], SG + (size_t)row * 1024 + 256 * (pn - 6) + 64 * wc + 8 * fq); }
    } else if (pn <= 11) {
#pragma unroll
      for (int ai = 0; ai < 2; ++ai)
#pragma unroll
        for (int m = 0; m < 4; ++m) { const int row = row0 + 128 * ai + 16 * m; plain_store<0>(acc, ai, m, 0.125f * rinv[row], IQ + (size_t)row * 512 + 256 * (pn - 10) + 64 * wc + 8 * fq); }
    } else {
      if (wc == 0) {
#pragma unroll
        for (int ai = 0; ai < 2; ++ai)
#pragma unroll
          for (int m = 0; m < 4; ++m) { const int row = row0 + 128 * ai + 16 * m; const float sc = rinv[row];
#pragma unroll
            for (int bj = 0; bj < 2; ++bj) { u32x4 w; w.x = cvtpk(acc[ai][bj][m][0][0] * sc, acc[ai][bj][m][0][1] * sc); w.y = cvtpk(acc[ai][bj][m][0][2] * sc, acc[ai][bj][m][0][3] * sc);
              w.z = cvtpk(acc[ai][bj][m][1][0] * sc, acc[ai][bj][m][1][1] * sc); w.w = cvtpk(acc[ai][bj][m][1][2] * sc, acc[ai][bj][m][1][3] * sc);
              *(u32x4*)(IK + (size_t)(row >> 5) * 2048 + (size_t)(((2 * bj + (fq >> 1)) * 64 + (fq & 1) * 32 + pi32(row & 31)) * 8)) = w; } }
      } else if (wc == 1 && fq == 0) {
#pragma unroll
        for (int ai = 0; ai < 2; ++ai)
#pragma unroll
          for (int m = 0; m < 4; ++m) { const int row = row0 + 128 * ai + 16 * m; float* d = IW + (size_t)row * 8; const float sc = 0.35355339059327373f * rinv[row];
            *(f32x4*)d = acc[ai][0][m][0] * sc; *(f32x4*)(d + 4) = acc[ai][0][m][1] * sc; }
      }
    }
  }
};
struct EpiB {
  static constexpr bool PERM = false, AFTER_DRAIN = false;
  bf16 *Q, *KV, *SG; const float *qn_g, *kn_g; const LAS f32x4* rl; float* KM; mutable int k;
  DI void operator()(const accq (&acc)[2][2][4][2], const pg8::Unit& u, int wr, int wc, int fr, int fq) const {
    const int pn = u.pn, row0 = u.pm * 256 + wr * 64 + fr; const LAS f32x4* s4 = rl + (k & 1) * 256 - u.pm * 256; ++k;
#define RINV2(row_) ({ const f32x4 p_ = s4[(row_)]; rsqrtf(((p_.x + p_.y) + (p_.z + p_.w)) * (1.0f / 1024.0f) + EPS); })
    if (pn == 0 || (pn >= 2 && pn <= 5)) {
      float gv[2][2][4]; load_gain(gv, pn == 0 ? kn_g : qn_g, fq, pn == 0 ? 1.0f : C2);
      float cs[2][2][4];
#pragma unroll
      for (int bj = 0; bj < 2; ++bj)
#pragma unroll
        for (int n = 0; n < 2; ++n)
#pragma unroll
          for (int e = 0; e < 4; ++e) cs[bj][n][e] = 0.f;
#pragma unroll
      for (int ai = 0; ai < 2; ++ai)
#pragma unroll
        for (int m = 0; m < 4; ++m) { const int row = row0 + 128 * ai + 16 * m; const float ri = RINV2(row);
          float v[2][2][4]; float ss = 0.f;
#pragma unroll
          for (int bj = 0; bj < 2; ++bj)
#pragma unroll
            for (int n = 0; n < 2; ++n)
#pragma unroll
              for (int e = 0; e < 4; ++e) { v[bj][n][e] = acc[ai][bj][m][n][e] * ri; ss += v[bj][n][e] * v[bj][n][e]; }
          ss += __shfl_xor(ss, 16); ss += __shfl_xor(ss, 32);
          const float rn = rsqrtf(ss * (1.0f / 64.0f) + EPS);
#pragma unroll
          for (int bj = 0; bj < 2; ++bj) {
#pragma unroll
            for (int n = 0; n < 2; ++n)
#pragma unroll
              for (int e = 0; e < 4; ++e) { v[bj][n][e] = v[bj][n][e] * rn * gv[bj][n][e]; cs[bj][n][e] += v[bj][n][e]; }
            u32x4 w; w.x = cvtpk(v[bj][0][0], v[bj][0][1]); w.y = cvtpk(v[bj][0][2], v[bj][0][3]); w.z = cvtpk(v[bj][1][0], v[bj][1][1]); w.w = cvtpk(v[bj][1][2], v[bj][1][3]);
            bf16* dst = pn != 0 ? Q + (size_t)row * 1024 + (4 * (pn - 2) + wc) * 64 + 8 * fq + 32 * bj : k_piece(KV, row, wc, bj, fq);
            *(u32x4*)dst = w; } }
      if (pn == 0) {
        float* km = KM + ((size_t)((u.pm >> 3) * 4 + wc) * 8 + (u.pm & 7)) * 64 + 8 * fq;
#pragma unroll
        for (int bj = 0; bj < 2; ++bj)
#pragma unroll
          for (int n = 0; n < 2; ++n)
#pragma unroll
            for (int e = 0; e < 4; ++e) { float t = cs[bj][n][e]; t += __shfl_xor(t, 1); t += __shfl_xor(t, 2); t += __shfl_xor(t, 4); t += __shfl_xor(t, 8);
              if (fr == 0) atomicAdd(km + 32 * bj + 4 * n + e, t * (1.0f / 256.0f)); }
      }
    } else if (pn == 1) {
#pragma unroll
      for (int ai = 0; ai < 2; ++ai)
#pragma unroll
        for (int m = 0; m < 4; ++m) { const int row = row0 + 128 * ai + 16 * m; const float ri = RINV2(row);
          v_store_scaled(acc, ai, m, KV, row, wc, fq, ri); }
    } else {
#pragma unroll
      for (int ai = 0; ai < 2; ++ai)
#pragma unroll
        for (int m = 0; m < 4; ++m) { const int row = row0 + 128 * ai + 16 * m; plain_store<1>(acc, ai, m, RINV2(row), SG + (size_t)row * 1024 + 256 * (pn - 6) + 64 * wc + 8 * fq); }
    }
  }
};
DI void unpack8(const u32x4 w, float (&f)[8]) { f[0] = bflo(w.x); f[1] = bfhi(w.x); f[2] = bflo(w.y); f[3] = bfhi(w.y); f[4] = bflo(w.z); f[5] = bfhi(w.z); f[6] = bflo(w.w); f[7] = bfhi(w.w); }
struct EpiRes {
  static constexpr bool PERM = false, AFTER_DRAIN = false;
  const bf16* res; float* out; LAS unsigned char* stg0;
  DI void operator()(const accq (&acc)[2][2][4][2], const pg8::Unit& u, int wr, int wc, int fr, int fq) const {
    const int row0 = u.pm * 256 + wr * 64 + fr, col0 = u.pn * 256 + 64 * wc + 8 * fq; LAS unsigned char* stg = stg0 + (wr * 4 + wc) * 2304; const int lane = fq * 16 + fr, r8 = lane >> 3, p8 = lane & 7;
#pragma unroll
    for (int ai = 0; ai < 2; ++ai)
#pragma unroll
      for (int m = 0; m < 4; ++m) { const size_t off = (size_t)(row0 + 128 * ai + 16 * m) * 1024 + col0;
#pragma unroll
        for (int bj = 0; bj < 2; ++bj) { float f[8]; unpack8(*(const u32x4*)(res + off + 32 * bj), f);
          f32x4 o0 = acc[ai][bj][m][0], o1 = acc[ai][bj][m][1];
          o0.x += f[0]; o0.y += f[1]; o0.z += f[2]; o0.w += f[3]; o1.x += f[4]; o1.y += f[5]; o1.z += f[6]; o1.w += f[7];
          *(LAS f32x4*)(stg + fr * 144 + fq * 32) = o0; *(LAS f32x4*)(stg + fr * 144 + fq * 32 + 16) = o1;
          asm volatile("" ::: "memory");
          const f32x4 a = *(const LAS f32x4*)(stg + r8 * 144 + p8 * 16), b = *(const LAS f32x4*)(stg + (r8 + 8) * 144 + p8 * 16);
          float* ob = out + (size_t)(row0 - fr + 128 * ai + 16 * m) * 1024 + u.pn * 256 + 64 * wc + 32 * bj + 4 * p8;
          __builtin_nontemporal_store(a, (f32x4*)(ob + (size_t)r8 * 1024)); __builtin_nontemporal_store(b, (f32x4*)(ob + (size_t)(r8 + 8) * 1024));
          asm volatile("" ::: "memory"); } }
  }
};
struct EpiRes2 {
  static constexpr bool PERM = false, AFTER_DRAIN = false;
  bf16* xh; float* ssq4; LAS float* part;
  DI void operator()(const accq (&acc)[2][2][4][2], const pg8::Unit& u, int wr, int wc, int fr, int fq) const {
    const int row0 = u.pm * 256 + wr * 64 + fr, col0 = u.pn * 256 + 64 * wc + 8 * fq;
#pragma unroll
    for (int ai = 0; ai < 2; ++ai)
#pragma unroll
      for (int m = 0; m < 4; ++m) { const int row = row0 + 128 * ai + 16 * m; const size_t off = (size_t)row * 1024 + col0; float ss = 0.f;
#pragma unroll
        for (int bj = 0; bj < 2; ++bj) { float f[8]; unpack8(*(const u32x4*)(xh + off + 32 * bj), f);
#pragma unroll
          for (int n = 0; n < 2; ++n)
#pragma unroll
            for (int e = 0; e < 4; ++e) { f[4 * n + e] += acc[ai][bj][m][n][e]; ss += f[4 * n + e] * f[4 * n + e]; }
          u32x4 w; w.x = cvtpk(f[0], f[1]); w.y = cvtpk(f[2], f[3]); w.z = cvtpk(f[4], f[5]); w.w = cvtpk(f[6], f[7]);
          *(u32x4*)(xh + off + 32 * bj) = w; }
        ss += __shfl_xor(ss, 16); ss += __shfl_xor(ss, 32);
        if (fq == 0) part[wc * 256 + (row - u.pm * 256)] = ss; }
    asm volatile("s_waitcnt lgkmcnt(0)" ::: "memory"); __builtin_amdgcn_s_barrier();
    const int t = (wr * 4 + wc) * 64 + fq * 16 + fr;
    if (t < 256) ssq4[(size_t)(u.pm * 256 + t) * 4 + u.pn] = (part[t] + part[256 + t]) + (part[512 + t] + part[768 + t]);
  }
};
DI int srccol_A(int gc) { if (gc < 3072) return gc; if (gc < 3136) return 3080 + (gc - 3072); if (gc < 3144) return 3072 + (gc - 3136); return -1; }
DI void trans_item(const float* W, int Ns, const float* gk, bf16* Wt, int item, int nblk, int kindA, LAS float* scr, int lane) {
  const int kb = item / nblk, nb = item % nblk, k0 = 64 * kb, gc0 = 32 * nb;
  const int n = lane & 31, gc = gc0 + n; const int sc = kindA ? srccol_A(gc) : gc;
  const int c = lane & 7;
  float v[32];
  const float* wp = W + (size_t)(k0 + (lane >> 5)) * Ns + (sc >= 0 ? sc : 0);
#pragma unroll
  for (int i = 0; i < 32; ++i) v[i] = __builtin_nontemporal_load(wp + (size_t)(2 * i) * Ns);
  f32x4 g0 = {1.f, 1.f, 1.f, 1.f}, g1 = {1.f, 1.f, 1.f, 1.f};
  if (gk) { g0 = *(const f32x4*)(gk + k0 + 8 * c); g1 = *(const f32x4*)(gk + k0 + 8 * c + 4); }
#pragma unroll
  for (int i = 0; i < 32; ++i) scr[(2 * i + (lane >> 5)) * 33 + n] = sc >= 0 ? v[i] : 0.f;
  asm volatile("s_waitcnt lgkmcnt(0)" ::: "memory");
#pragma unroll
  for (int j = 0; j < 4; ++j) { const int nn = (lane >> 3) + 8 * j; const LAS float* s = scr + (8 * c) * 33 + nn;
    u32x4 o; o.x = cvtpk(s[0 * 33] * g0.x, s[1 * 33] * g0.y); o.y = cvtpk(s[2 * 33] * g0.z, s[3 * 33] * g0.w); o.z = cvtpk(s[4 * 33] * g1.x, s[5 * 33] * g1.y); o.w = cvtpk(s[6 * 33] * g1.z, s[7 * 33] * g1.w);
    *(u32x4*)(Wt + (size_t)slot_of(gc0 + nn) * 1024 + k0 + 8 * c) = o; }
  asm volatile("s_waitcnt lgkmcnt(0)" ::: "memory");
}

DI int kidx(int r, int hi) { return 16 * (r >> 3) + 8 * hi + (r & 7); }
DI void k_dma(const char* ksrc  , unsigned voff  , unsigned lds_slot  ) {
  unsigned keep;
  asm volatile("s_waitcnt lgkmcnt(0)\n\ts_mov_b32 %0, m0\n\ts_mov_b32 m0, %3\n\ts_nop 0\n\t"
               "global_load_lds_dwordx4 %1, %2\n\tglobal_load_lds_dwordx4 %1, %2 offset:1024\n\tglobal_load_lds_dwordx4 %1, %2 offset:2048\n\tglobal_load_lds_dwordx4 %1, %2 offset:3072\n\t"
               "s_mov_b32 m0, %0" : "=&s"(keep) : "v"(voff), "s"(ksrc), "s"(lds_slot) : "memory");
}
DI void v_load(bf16x8 (&vf)[4], const char* vsrc  , unsigned voff) {
  asm volatile("global_load_dwordx4 %0, %4, %5\n\tglobal_load_dwordx4 %1, %4, %5 offset:1024\n\tglobal_load_dwordx4 %2, %4, %5 offset:2048\n\tglobal_load_dwordx4 %3, %4, %5 offset:3072"
               : "=&v"(vf[0]), "=&v"(vf[1]), "=&v"(vf[2]), "=&v"(vf[3]) : "v"(voff), "s"(vsrc) : "memory");
}
DI void kv_wait(bf16x8 (&vf)[4]) { asm volatile("s_waitcnt vmcnt(0)" : "+v"(vf[0]), "+v"(vf[1]), "+v"(vf[2]), "+v"(vf[3]) :: "memory"); }
DI void qk_tile(f32x16 (&c)[2], const LAS unsigned char* kslot  , const bf16x8 (&qf)[2][4]) {
  bf16x8 kf[4];
#pragma unroll
  for (int s = 0; s < 4; ++s) kf[s] = *(const LAS bf16x8*)(kslot + s * 1024);
#pragma unroll
  for (int j = 0; j < 2; ++j) {
    f32x16 z;
#pragma unroll
    for (int r = 0; r < 16; ++r) z[r] = 0.f;
    c[j] = MFMA32(kf[0], qf[j][0], z);
#pragma unroll
    for (int s = 1; s < 4; ++s) c[j] = MFMA32(kf[s], qf[j][s], c[j]);
  }
}
DI void add_bias(f32x16 (&c)[2], const LAS float* bt0, int dist0) {
#pragma unroll
  for (int j = 0; j < 2; ++j) { const LAS float* tp = bt0 + j * 192 + (dist0 + 8);
#pragma unroll
    for (int r = 0; r < 16; ++r) c[j][r] += tp[23 - (16 * (r >> 3) + (r & 7))]; }
}
template <int MODE> DI void sm_pv(f32x16 (&O)[2][2], float (&l)[2], const f32x16 (&c)[2], const bf16x8 (&vf4)[4], unsigned m) {
#pragma unroll
  for (int j = 0; j < 2; ++j) {
    float p[16]; float ls = 0.f;
#pragma unroll
    for (int r = 0; r < 16; ++r) {
      const float e = __builtin_amdgcn_exp2f(c[j][r]);
      if (MODE == 0) { const unsigned ext = (unsigned)__builtin_amdgcn_sbfe((int)m, r, 1); p[r] = __uint_as_float(__float_as_uint(e) & ext); }
      else p[r] = e;
      ls += p[r];
    }
    if (MODE == 1) ls = __uint_as_float(__float_as_uint(ls) & m);
    l[j] += ls;
    bf16x8 pk[2];
#pragma unroll
    for (int s = 0; s < 2; ++s) { u32x4 w; w.x = cvtpk(p[8 * s], p[8 * s + 1]); w.y = cvtpk(p[8 * s + 2], p[8 * s + 3]); w.z = cvtpk(p[8 * s + 4], p[8 * s + 5]); w.w = cvtpk(p[8 * s + 6], p[8 * s + 7]);
      if (MODE == 1) { w.x &= m; w.y &= m; w.z &= m; w.w &= m; }
      pk[s] = __builtin_bit_cast(bf16x8, w); }
#pragma unroll
    for (int dt = 0; dt < 2; ++dt)
#pragma unroll
      for (int s = 0; s < 2; ++s) O[j][dt] = MFMA32(vf4[dt * 2 + s], pk[s], O[j][dt]);
  }
}
DI void attn_store(const f32x16 (&O)[2][2], const float (&l)[2], const bf16* SG, bf16* OG, size_t row0, int head0, LAS unsigned char* stg, int lane) {
  const int q = lane & 31, hi = lane >> 5, rr = lane >> 3, pc = lane & 7;
  const size_t goff = (row0 + rr) * 1024 + (size_t)head0 * 64 + 8 * pc;
  u32x4 sg[2][4];
#pragma unroll
  for (int j = 0; j < 2; ++j)
#pragma unroll
    for (int i = 0; i < 4; ++i) sg[j][i] = *(const u32x4*)(SG + goff + (size_t)i * 8192 + j * 64);
  LAS unsigned char* wb = stg + q * 256; const int wt = ((q & 15) ^ hi) << 4;
  const LAS unsigned char* rb = stg + rr * 256; const int rt = ((2 * pc) ^ rr) << 4;
#pragma unroll
  for (int j = 0; j < 2; ++j) {
    const float lt = l[j] + __shfl_xor(l[j], 32); const float inv = 1.0f / lt;
#pragma unroll
    for (int dt = 0; dt < 2; ++dt)
#pragma unroll
      for (int a = 0; a < 4; ++a) {
        f32x4 v; v.x = O[j][dt][4 * a + 0] * inv; v.y = O[j][dt][4 * a + 1] * inv; v.z = O[j][dt][4 * a + 2] * inv; v.w = O[j][dt][4 * a + 3] * inv;
        *(LAS f32x4*)(wb + (wt ^ ((8 * dt + 2 * a) << 4))) = v;
      }
    asm volatile("" ::: "memory");
#pragma unroll
    for (int i = 0; i < 4; ++i) {
      const int x0 = rt ^ ((i & 1) << 7);
      const f32x4 a0 = *(const LAS f32x4*)(rb + i * 2048 + x0), a1 = *(const LAS f32x4*)(rb + i * 2048 + (x0 ^ 16));
      const u32x4 g = sg[j][i]; u32x4 w;
      w.x = cvtpk(a0.x * bflo(g.x), a0.y * bfhi(g.x)); w.y = cvtpk(a0.z * bflo(g.y), a0.w * bfhi(g.y));
      w.z = cvtpk(a1.x * bflo(g.z), a1.y * bfhi(g.z)); w.w = cvtpk(a1.z * bflo(g.w), a1.w * bfhi(g.w));
      *(u32x4*)(OG + goff + (size_t)i * 8192 + j * 64) = w;
    }
    asm volatile("" ::: "memory");
  }
}
DI void build_btab(LAS unsigned char* lds, const float* rel_bias, int tid_) {
  LAS float* bt = (LAS float*)(lds + L_BTAB);
  for (int i = tid_; i < 16 * 192; i += 512) { const int h = i / 192, dist = i % 192 - 31;
    bt[i] = dist < 0 ? -INFINITY : (dist < 128 ? (rel_bias[(int)BKT[dist] * 16 + h] - rel_bias[31 * 16 + h]) * LOG2E : 0.f); }
}
DI unsigned causal16(int q, int hi) { unsigned m = 0;
#pragma unroll
  for (int r = 0; r < 16; ++r) m |= (kidx(r, hi) <= q) ? (1u << r) : 0u;
  return m; }

DI void dsa_unit(LAS unsigned char* lds, const Ptrs& P, int b, int qt, int wave_) {
  int tid = wave_ * 64 + lane_id_hw(); asm volatile("" : "+v"(tid));
  const int lane = tid & 63, w = __builtin_amdgcn_readfirstlane(tid >> 6), q = lane & 31, hi = lane >> 5;
  const int t0 = 32 * qt, nkt = qt + 1; const size_t rowb = (size_t)b * SEQ;
  LAS unsigned short* maskl = (LAS unsigned short*)(lds + L_MASK);
  bf16x8 qf[2][4];
#pragma unroll
  for (int j = 0; j < 2; ++j)
#pragma unroll
    for (int s = 0; s < 4; ++s) qf[j][s] = *(const bf16x8*)(P.Q + (rowb + t0 + q) * 1024 + (2 * w + j) * 64 + 16 * s + 8 * hi);
  __syncthreads();
  if (qt >= 8) {
    const bf16* ikb = P.IK + (size_t)(b * 64) * 2048 + lane * 8;
    bf16x8 ikc[4], ikn[4];
#pragma unroll
    for (int s = 0; s < 4; ++s) ikc[s] = *(const bf16x8*)(ikb + (size_t)w * 2048 + 512 * s);
    LAS float* wl = (LAS float*)(lds + L_HIST);
    { f32x4 wv = {0.f, 0.f, 0.f, 0.f}; if (tid < 64) wv = *(const f32x4*)(P.IW + (rowb + t0) * 8 + tid * 4);
      const int row = tid >> 4, ch = tid & 15; const u32x4* src = (const u32x4*)(P.IQ + (rowb + t0 + row) * 512);
#pragma unroll
      for (int c = 0; c < 4; ++c) *(LAS u32x4*)(lds + L_IQ + row * IQ_STRIDE + (ch + 16 * c) * 16) = __builtin_nontemporal_load(src + ch + 16 * c);
      if (tid < 64) *(LAS f32x4*)(wl + tid * 4) = wv; }
    __syncthreads();
    unsigned pl[4][16];
#pragma unroll
    for (int B = 0; B < 4; ++B) {
#pragma unroll
      for (int h2 = 0; h2 < 2; ++h2) {
        const int kt = w + 8 * (2 * B + h2);
        if (2 * B + h2 < 7) { const int ktn = (kt + 8 < nkt) ? kt + 8 : w;
#pragma unroll
          for (int s = 0; s < 4; ++s) ikn[s] = *(const bf16x8*)(ikb + (size_t)ktn * 2048 + 512 * s); }
        float sc[16];
        if (2 * B + h2 == 0 || kt < nkt) {
#pragma unroll
          for (int s = 0; s < 4; ++s) asm volatile("" : "+v"(ikc[s]));
#pragma unroll
          for (int r = 0; r < 16; ++r) sc[r] = 0.f;
#pragma unroll 2
          for (int hd = 0; hd < 8; ++hd) {
            f32x16 c;
#pragma unroll
            for (int r = 0; r < 16; ++r) c[r] = 0.f;
#pragma unroll
            for (int s = 0; s < 4; ++s) { const bf16x8 bq = *(const LAS bf16x8*)(lds + L_IQ + q * IQ_STRIDE + (hd * 64 + 16 * s + 8 * hi) * 2); c = MFMA32(ikc[s], bq, c); }
            const float wh = wl[q * 8 + hd];
#pragma unroll
            for (int r = 0; r < 16; ++r) { const int ci_ = __builtin_bit_cast(int, (float)c[r]); sc[r] += wh * __builtin_bit_cast(float, ci_ > 0 ? ci_ : 0); asm("" : "+v"(sc[r])); }
          }
          if (kt == qt) {
#pragma unroll
            for (int r = 0; r < 16; ++r) if (kidx(r, hi) > q) sc[r] = -INFINITY;
          }
        } else {
#pragma unroll
          for (int r = 0; r < 16; ++r) sc[r] = -INFINITY;
        }
#pragma unroll
        for (int v = 0; v < 16; ++v) {
          if (h2 == 0) pl[B][v] = __builtin_bit_cast(unsigned, __builtin_amdgcn_cvt_pkrtz(sc[v], 0.f));
          else pl[B][v] |= __builtin_bit_cast(unsigned, __builtin_amdgcn_cvt_pkrtz(0.f, sc[v]));
        }
#pragma unroll
        for (int s = 0; s < 4; ++s) ikc[s] = ikn[s];
      }
#pragma unroll
      for (int v = 0; v < 16; ++v) { const unsigned u = pl[B][v]; pl[B][v] = u ^ (((u >> 15) & 0x00010001u) * 0x7FFFu); }
#define TR_STAGE(J, MJ) _Pragma("unroll") for (int k = 0; k < 16; ++k) if ((k & (J)) == 0) { const unsigned t = ((pl[B][k] >> (J)) ^ pl[B][k + (J)]) & (MJ); pl[B][k + (J)] ^= t; pl[B][k] ^= t << (J); }
      TR_STAGE(8, 0x00FF00FFu) TR_STAGE(4, 0x0F0F0F0Fu) TR_STAGE(2, 0x33333333u) TR_STAGE(1, 0x55555555u)
#undef TR_STAGE
      pl[B][15] = ~pl[B][15];
#pragma unroll
      for (int v = 0; v < 16; ++v) asm volatile("" : "+v"(pl[B][v]));
      __builtin_amdgcn_sched_barrier(0);
    }
    LAS unsigned* cb = (LAS unsigned*)(lds + L_HIST + 32 * 257 * 4);
    if (tid < 64) cb[tid] = 0u;
    __syncthreads();
    unsigned mm[4] = {0xFFFFFFFFu, 0xFFFFFFFFu, 0xFFFFFFFFu, 0xFFFFFFFFu}, gt[4] = {0u, 0u, 0u, 0u}, Gtot = 0u, prev0 = 0u, prev1 = 0u;
#pragma unroll
    for (int bit = 15; bit >= 0; --bit) {
      unsigned t4[4]; unsigned cnt = 0u;
#pragma unroll
      for (int B = 0; B < 4; ++B) { t4[B] = mm[B] & pl[B][bit]; cnt += (unsigned)__builtin_popcount(t4[B]); }
      LAS unsigned* cw = cb + ((bit & 1) ? 32 : 0) + q;
      __hip_atomic_fetch_add(cw, cnt, __ATOMIC_RELAXED, __HIP_MEMORY_SCOPE_WORKGROUP);
      __syncthreads();
      const unsigned run = *cw; unsigned tot;
      if (bit & 1) { tot = run - prev1; prev1 = run; } else { tot = run - prev0; prev0 = run; }
      const bool acc1 = (Gtot + tot) >= 256u;
#pragma unroll
      for (int B = 0; B < 4; ++B) { if (acc1) mm[B] = t4[B]; else { gt[B] |= t4[B]; mm[B] ^= t4[B]; } }
      if (!acc1) Gtot += tot;
    }
    LAS unsigned short* tm = (LAS unsigned short*)(lds + L_HIST + 1024); LAS unsigned short* pf = (LAS unsigned short*)(lds + L_HIST + 1024 + 8192);
#pragma unroll
    for (int B = 0; B < 4; ++B) {
      tm[((w + 8 * (2 * B)) * 32 + q) * 2 + hi] = (unsigned short)(mm[B] & 0xFFFFu);
      tm[((w + 8 * (2 * B + 1)) * 32 + q) * 2 + hi] = (unsigned short)(mm[B] >> 16);
    }
    __syncthreads();
#pragma unroll
    for (int e = 0; e < 4; ++e) {
      const int qq = 4 * w + e;
      const unsigned c = (unsigned)__builtin_popcount(((const LAS unsigned*)tm)[lane * 32 + qq]);
      unsigned incl = c;
#pragma unroll
      for (int o = 1; o < 64; o <<= 1) { const unsigned t = __shfl_up(incl, o); if (lane >= o) incl += t; }
      pf[lane * 32 + qq] = (unsigned short)(incl - c);
    }
    __syncthreads();
    { const unsigned need = 256u - Gtot;
#pragma unroll
      for (int B = 0; B < 4; ++B) {
        unsigned sel = gt[B];
#pragma unroll
        for (int h2 = 0; h2 < 2; ++h2) {
          const unsigned t16 = (mm[B] >> (16 * h2)) & 0xFFFFu;
          if (t16) {
            const int kt = w + 8 * (2 * B + h2);
            const unsigned pair = ((const LAS unsigned*)tm)[kt * 32 + q], base = pf[kt * 32 + q];
            const unsigned c0 = (unsigned)__builtin_popcount(pair & 0xFFu), c1 = (unsigned)__builtin_popcount(pair & 0xFF0000u), c2 = (unsigned)__builtin_popcount(pair & 0xFF00u);
            const unsigned offL = base + (hi ? c0 : 0u), offH = base + (hi ? c0 + c1 + c2 : c0 + c1);
            unsigned rem = t16;
            while (rem) { const int pos = __builtin_ctz(rem); rem &= rem - 1u;
              const unsigned below = (unsigned)__builtin_popcount(t16 & ((1u << pos) - 1u) & (pos >= 8 ? 0xFF00u : 0xFFu));
              if ((pos >= 8 ? offH : offL) + below < need) sel |= 1u << (pos + 16 * h2); }
          }
        }
        if (w + 8 * (2 * B) < nkt) maskl[(w + 8 * (2 * B)) * 64 + lane] = (unsigned short)(sel & 0xFFFFu);
        if (w + 8 * (2 * B + 1) < nkt) maskl[(w + 8 * (2 * B + 1)) * 64 + lane] = (unsigned short)(sel >> 16);
      } }
  } else {
    const unsigned cm = causal16(q, hi);
#pragma unroll
    for (int i = 0; i < 8; ++i) { const int kt = w + 8 * i; if (kt < nkt) maskl[kt * 64 + lane] = (unsigned short)(kt == qt ? cm : 0xFFFFu); }
  }
  __syncthreads();
  const int g = w >> 1;
  const bf16* img = P.KV + (size_t)(b * 64) * 16384;
  const unsigned lds0 = (unsigned)(uintptr_t)lds;
#pragma unroll
  for (int j = 0; j < 2; ++j)
#pragma unroll
    for (int s = 0; s < 4; ++s) asm volatile("" : "+v"(qf[j][s]));
  f32x16 O[2][2]; float l[2] = {0.f, 0.f};
#pragma unroll
  for (int j = 0; j < 2; ++j)
#pragma unroll
    for (int dt = 0; dt < 2; ++dt)
#pragma unroll
      for (int r = 0; r < 16; ++r) O[j][dt][r] = 0.f;
  const LAS float* bt0 = (const LAS float*)(lds + L_BTAB) + (2 * w) * 192;
  LAS unsigned char* ringp = lds + 65536 + w * 8192;
  const char* ksrc = (const char*)img + g * 4096; const unsigned voff = (unsigned)lane * 16u;
  const unsigned kring = lds0 + (unsigned)w * 8192u; const LAS unsigned char* kl = lds + w * 8192 + lane * 16;
#define TSRC(t_) (ksrc + (size_t)((t_) < nkt ? (t_) : nkt - 1) * 32768)
  bf16x8 vA[4], vB[4]; f32x16 cA[2], cB[2];
  k_dma(TSRC(0), voff, kring); v_load(vA, TSRC(0) + 16384, voff); k_dma(TSRC(1), voff, kring + 4096u);
  kv_wait(vA);
  qk_tile(cA, kl, qf);
#pragma unroll 1
  for (int kt = 0; ; kt += 2) {
    k_dma(TSRC(kt + 2), voff, kring); v_load(vB, TSRC(kt + 1) + 16384, voff);
    if (qt - kt <= 4) add_bias(cA, bt0, (t0 + q) - (32 * kt + 8 * hi));
    { const unsigned m16 = maskl[kt * 64 + lane];
      qk_tile(cB, kl + 4096, qf); sm_pv<0>(O, l, cA, vA, m16); }
    kv_wait(vB);
    if (kt + 1 >= nkt) break;
    k_dma(TSRC(kt + 3), voff, kring + 4096u); v_load(vA, TSRC(kt + 2) + 16384, voff);
    if (qt - (kt + 1) <= 4) add_bias(cB, bt0, (t0 + q) - (32 * (kt + 1) + 8 * hi));
    { const unsigned m16 = maskl[(kt + 1) * 64 + lane];
      qk_tile(cA, kl, qf); sm_pv<0>(O, l, cB, vB, m16); }
    kv_wait(vA);
    if (kt + 2 >= nkt) break;
  }
#undef TSRC
  { int tid2 = lane_id_hw(); asm volatile("" : "+v"(tid2)); const int lane2 = tid2 & 63;
    attn_store(O, l, P.SG, P.OG, rowb + t0, 2 * w, ringp, lane2); }
}

DI void moba_unit(LAS unsigned char* lds, const Ptrs& P, int b, int qt, int wave_) {
  int tid = wave_ * 64 + lane_id_hw(); asm volatile("" : "+v"(tid));
  const int lane = tid & 63, w = __builtin_amdgcn_readfirstlane(tid >> 6), q = lane & 31, hi = lane >> 5;
  const int t0 = 32 * qt, ob = qt >> 3; const size_t rowb = (size_t)b * SEQ;
  LAS unsigned char* selm = lds + L_SELM; LAS unsigned* blkw = (LAS unsigned*)(lds + L_BLK);
  bf16x8 qf[2][4];
#pragma unroll
  for (int j = 0; j < 2; ++j)
#pragma unroll
    for (int s = 0; s < 4; ++s) qf[j][s] = *(const bf16x8*)(P.Q + (rowb + t0 + q) * 1024 + (2 * w + j) * 64 + 16 * s + 8 * hi);
  __syncthreads();
  if (tid == 0) blkw[0] = 0u;
  __syncthreads();
  if (ob > 0) {
    const int qq = tid & 31, gg = (tid >> 5) & 3, part = tid >> 7;
    float gs[7];
#pragma unroll
    for (int n = 0; n < 7; ++n) gs[n] = 0.f;
    const bf16* qp = P.Q + (rowb + t0 + qq) * 1024 + gg * 256 + part * 16;
#pragma unroll
    for (int c = 0; c < 2; ++c) {
      float qs[8];
#pragma unroll
      for (int e = 0; e < 8; ++e) qs[e] = 0.f;
#pragma unroll
      for (int j = 0; j < 4; ++j) { const u32x4 v = *(const u32x4*)(qp + j * 64 + c * 8);
        qs[0] += bflo(v.x); qs[1] += bfhi(v.x); qs[2] += bflo(v.y); qs[3] += bfhi(v.y); qs[4] += bflo(v.z); qs[5] += bfhi(v.z); qs[6] += bflo(v.w); qs[7] += bfhi(v.w); }
#pragma unroll
      for (int n = 0; n < 7; ++n) if (n < ob) { const f32x4* km = (const f32x4*)(P.KM + ((size_t)(b * 4 + gg) * 8 + n) * 64 + part * 16 + c * 8); const f32x4 k0 = km[0], k1 = km[1];
        gs[n] += (qs[0] * k0.x + qs[1] * k0.y + qs[2] * k0.z + qs[3] * k0.w) + (qs[4] * k1.x + qs[5] * k1.y + qs[6] * k1.z + qs[7] * k1.w); }
    }
    LAS float* gp = (LAS float*)lds + (size_t)(part * 128 + gg * 32 + qq) * 8;
#pragma unroll
    for (int n = 0; n < 7; ++n) gp[n] = gs[n];
  }
  __syncthreads();
  if (tid < 128) {
    const int qq = tid & 31, gg = tid >> 5; unsigned sel = 0;
    if (ob > 0) {
      float gs[7]; const LAS float* gp = (const LAS float*)lds + (size_t)(gg * 32 + qq) * 8;
#pragma unroll
      for (int n = 0; n < 7; ++n) gs[n] = (n < ob) ? ((gp[n] + gp[1024 + n]) + (gp[2048 + n] + gp[3072 + n])) : -INFINITY;
#pragma unroll
      for (int n = 0; n < 7; ++n) { if (n < ob) { int rank = 0;
#pragma unroll
          for (int m = 0; m < 7; ++m) if (m != n && m < ob) rank += ((gs[m] > gs[n]) || (gs[m] == gs[n] && m < n)) ? 1 : 0;
          if (rank < 3) sel |= 1u << n; } }
    }
    selm[gg * 32 + qq] = (unsigned char)sel;
    if (sel) __hip_atomic_fetch_or(blkw, sel, __ATOMIC_RELAXED, __HIP_MEMORY_SCOPE_WORKGROUP);
  }
  __syncthreads();
  const int g = w >> 1;
  const unsigned mysel = selm[g * 32 + q];
  const unsigned blk = (unsigned)__builtin_amdgcn_readfirstlane(blkw[0]) | (1u << ob);
  const bf16* img = P.KV + (size_t)(b * 64) * 16384;
  const unsigned lds0 = (unsigned)(uintptr_t)lds;
#pragma unroll
  for (int j = 0; j < 2; ++j)
#pragma unroll
    for (int s = 0; s < 4; ++s) asm volatile("" : "+v"(qf[j][s]));
  f32x16 O[2][2]; float l[2] = {0.f, 0.f};
#pragma unroll
  for (int j = 0; j < 2; ++j)
#pragma unroll
    for (int dt = 0; dt < 2; ++dt)
#pragma unroll
      for (int r = 0; r < 16; ++r) O[j][dt][r] = 0.f;
  const LAS float* bt0 = (const LAS float*)(lds + L_BTAB) + (2 * w) * 192;
#define NEXT_TILE(kt_, out_) do { int kn_ = (kt_) + 1; if (kn_ > qt) kn_ = -1; else if (((blk >> (kn_ >> 3)) & 1u) == 0u) kn_ = 8 * ((kn_ >> 3) + __builtin_ctz(blk >> (kn_ >> 3))); (out_) = kn_; } while (0)
  LAS unsigned char* ringp = lds + 65536 + w * 8192;
  const char* ksrc = (const char*)img + g * 4096; const unsigned voff = (unsigned)lane * 16u;
  const unsigned kring = lds0 + (unsigned)w * 8192u; const LAS unsigned char* kl = lds + w * 8192 + lane * 16;
  int ta = 8 * __builtin_ctz(blk), tb, tc, td;
  NEXT_TILE(ta, tb); tc = -1; if (tb >= 0) NEXT_TILE(tb, tc);
  const int tfirst = ta;
#define TSRC(t_) (ksrc + (size_t)((t_) >= 0 ? (t_) : tfirst) * 32768)
#define MOBA_SM(C, VF, KT) do { const int n_ = (KT) >> 3; const unsigned lm_ = (n_ < ob) ? (0u - ((mysel >> n_) & 1u)) : 0xFFFFFFFFu; sm_pv<1>(O, l, C, VF, lm_); } while (0)
  bf16x8 vA[4], vB[4]; f32x16 cA[2], cB[2];
  k_dma(TSRC(ta), voff, kring); v_load(vA, TSRC(ta) + 16384, voff); k_dma(TSRC(tb), voff, kring + 4096u);
  kv_wait(vA);
  qk_tile(cA, kl, qf);
#pragma unroll 1
  while (true) {
    k_dma(TSRC(tc), voff, kring); v_load(vB, TSRC(tb) + 16384, voff);
    if (qt - ta <= 4) add_bias(cA, bt0, (t0 + q) - (32 * ta + 8 * hi));
    qk_tile(cB, kl + 4096, qf); MOBA_SM(cA, vA, ta);
    kv_wait(vB);
    if (tb < 0) break;
    td = -1; if (tc >= 0) NEXT_TILE(tc, td);
    k_dma(TSRC(td), voff, kring + 4096u); v_load(vA, TSRC(tc) + 16384, voff);
    if (qt - tb <= 4) add_bias(cB, bt0, (t0 + q) - (32 * tb + 8 * hi));
    qk_tile(cA, kl, qf); MOBA_SM(cB, vB, tb);
    kv_wait(vA);
    if (tc < 0) break;
    ta = tc; tb = td; tc = -1; if (tb >= 0) NEXT_TILE(tb, tc);
  }
#undef MOBA_SM
#undef TSRC
#undef NEXT_TILE
  { int tid2 = lane_id_hw(); asm volatile("" : "+v"(tid2)); const int lane2 = tid2 & 63;
    attn_store(O, l, P.SG, P.OG, rowb + t0, 2 * w, ringp, lane2); }
}

__global__ void __launch_bounds__(512, 2) fwd(Args args) {
  extern __shared__ __attribute__((aligned(16))) unsigned char lds_raw[];
  LAS unsigned char* lds = (LAS unsigned char*)lds_raw;
  const int wave = __builtin_amdgcn_readfirstlane((int)threadIdx.x >> 6);
#define FRESH_TID(t_) int t_ = wave * 64 + lane_id_hw(); asm volatile("" : "+v"(t_))
  const int G = gridDim.x, bx = blockIdx.x;
  const int vcu = (G % 8 == 0) ? (bx % 8) * (G / 8) + bx / 8 : bx;
  LAS unsigned long long* ptab = (LAS unsigned long long*)(lds + L_MISC + 64);
  { FRESH_TID(tid0);
    if (tid0 < 16) { const unsigned long long* ka = (const unsigned long long*)__builtin_amdgcn_kernarg_segment_ptr(); ptab[tid0] = ka[tid0]; ((LAS unsigned*)(lds + L_MISC))[tid0] = 0u; }
    __syncthreads(); }
#define TABPTR(k) ((unsigned char*)(__attribute__((address_space(1))) unsigned char*)(((unsigned long long)(unsigned)__builtin_amdgcn_readfirstlane((int)(ptab[(k)] >> 32)) << 32) | (unsigned long long)(unsigned)__builtin_amdgcn_readfirstlane((int)(unsigned)ptab[(k)])))
#define LOAD_PTRS() Ptrs P; { asm volatile("" ::: "memory"); unsigned char* ws = TABPTR(15); \
  P.x = (const float*)TABPTR(0); P.norm_a_g = (const float*)TABPTR(1); P.w_in_a = (const float*)TABPTR(2); P.qn_a_g = (const float*)TABPTR(3); P.kn_a_g = (const float*)TABPTR(4); P.w_out_a = (const float*)TABPTR(5); P.rel_bias = (const float*)TABPTR(6); \
  P.norm_kv_g = (const float*)TABPTR(7); P.w_kv = (const float*)TABPTR(8); P.kn_b_g = (const float*)TABPTR(9); P.norm_b_g = (const float*)TABPTR(10); P.w_in_b = (const float*)TABPTR(11); P.qn_b_g = (const float*)TABPTR(12); P.w_out_b = (const float*)TABPTR(13); \
  P.out = (float*)TABPTR(14); \
  P.WtA = (bf16*)(ws + WS_WA); P.WtOA = (bf16*)(ws + WS_WOA); P.WtB = (bf16*)(ws + WS_WB); P.WtOB = (bf16*)(ws + WS_WOB); \
  P.XN = (bf16*)(ws + WS_XN); P.Q = (bf16*)(ws + WS_Q); P.KV = (bf16*)(ws + WS_K); P.SG = (bf16*)(ws + WS_SG); \
  P.IQ = (bf16*)(ws + WS_IQ); P.IK = (bf16*)(ws + WS_IK); P.OG = (bf16*)(ws + WS_OG); \
  P.IW = (float*)(ws + WS_IW); P.KM = (float*)(ws + WS_KM); P.RINV = (float*)(ws + WS_KM + 524288); P.SSQ = (float*)(ws + WS_H1); }
  const int lo = args.ph_lo, hi = args.ph_hi;
#ifndef PH_MASK
#define PH_MASK 0x1ff
#endif
#ifndef REP_MASK
#define REP_MASK 0
#endif
#define IN(k) (((PH_MASK >> (k)) & 1) && lo <= (k) && (k) < hi)
#define NREP(k) ((((REP_MASK) >> (k)) & 1) ? 2 : 1)
#if MK_N_LAUNCHES == 1
  const bool grouped = (G == 256);
  XcdBarrier xbar = xcd_barrier_post((unsigned*)TABPTR(15), (volatile LAS unsigned*)(lds + L_MISC), wave == 0 && lane_id_hw() == 0, (unsigned)G);
  XcdBarrier xbarL = xcd_barrier_post((unsigned*)(TABPTR(15) + 16384 * (1 + (bx & 7))), (volatile LAS unsigned*)(lds + L_MISC) + 2, wave == 0 && lane_id_hw() == 0, (unsigned)(G / 8));
#define SEAM(k) do { if (IN(k) && (hi > (k) + 1)) { if ((k) == 0 || !grouped) xcd_barrier(xbar, wave == 0 && lane_id_hw() == 0); else xcd_barrier(xbarL, wave == 0 && lane_id_hw() == 0); } } while (0)
#else
#define SEAM(k) do { } while (0)
#endif
  const int gw = vcu * 8 + wave, NGW = G * 8;

  if (IN(0)) {
    LOAD_PTRS();
    FRESH_TID(tid); const int lane = tid & 63;
    LAS float* scr = (LAS float*)(lds + wave * 8448);
    constexpr int I_A = 16 * (NCOL_A / 32), I_O = 16 * 32, I_KV = 16 * 16, I_B = 16 * 64;
    constexpr int NITEMS = I_A + I_O + I_KV + I_B + I_O;
#define P0_ITEM(it_) do { int r = (it_); \
      if (r < I_A) { trans_item(P.w_in_a, 3144, P.norm_a_g, P.WtA, r, NCOL_A / 32, 1, scr, lane); break; } r -= I_A; \
      if (r < I_O) { trans_item(P.w_out_a, 1024, nullptr, P.WtOA, r, 32, 0, scr, lane); break; } r -= I_O; \
      if (r < I_KV) { trans_item(P.w_kv, 512, P.norm_kv_g, P.WtB, r, 16, 0, scr, lane); break; } r -= I_KV; \
      if (r < I_B) { trans_item(P.w_in_b, 2048, P.norm_b_g, P.WtB + (size_t)512 * 1024, r, 64, 0, scr, lane); break; } r -= I_B; \
      trans_item(P.w_out_b, 1024, nullptr, P.WtOB, r, 32, 0, scr, lane); } while (0)
    int itw = gw;
    for (int m = gw; m < MTOK; m += 4 * NGW) {
      f32x4 v[4][4]; float ss[4];
#pragma unroll
      for (int u = 0; u < 4; ++u) { const int mm = m + u * NGW; const f32x4* xr = (const f32x4*)(P.x + (size_t)(mm < MTOK ? mm : m) * 1024) + lane;
#pragma unroll
        for (int j = 0; j < 4; ++j) v[u][j] = __builtin_nontemporal_load(xr + 64 * j); }
      if (itw < NITEMS) { P0_ITEM(itw); itw += NGW; }
#pragma unroll
      for (int u = 0; u < 4; ++u) { float a = 0.f;
#pragma unroll
        for (int j = 0; j < 4; ++j) a += (v[u][j].x * v[u][j].x + v[u][j].y * v[u][j].y) + (v[u][j].z * v[u][j].z + v[u][j].w * v[u][j].w);
        ss[u] = a; }
#pragma unroll
      for (int o = 1; o < 64; o <<= 1) {
#pragma unroll
        for (int u = 0; u < 4; ++u) ss[u] += __shfl_xor(ss[u], o); }
#pragma unroll
      for (int u = 0; u < 4; ++u) { const int mm = m + u * NGW; if (mm < MTOK) {
          u32x2* o8 = (u32x2*)(P.XN + (size_t)mm * 1024) + lane;
#pragma unroll
          for (int j = 0; j < 4; ++j) { u32x2 w; w.x = cvtpk(v[u][j].x, v[u][j].y); w.y = cvtpk(v[u][j].z, v[u][j].w); o8[64 * j] = w; }
          if (lane == 0) P.RINV[mm] = rsqrtf(ss[u] * (1.0f / 1024.0f) + EPS); } }
    }
    for (; itw < NITEMS; itw += NGW) P0_ITEM(itw);
#undef P0_ITEM
    for (int i = gw * 64 + lane; i < NBATCH * 4 * 8 * 64; i += NGW * 64) P.KM[i] = 0.f;
    __syncthreads();
  }
  SEAM(0);
  if (IN(1)) for (int rep_ = 0; rep_ < NREP(1); ++rep_) {
    LOAD_PTRS();
    pg8::Gemm g{P.XN, P.WtA, MTOK, NCOL_A, 1024}; OrderR S; S.init(MTOK, NCOL_A, G, bx); S.rv = P.RINV; S.ldsb = (unsigned)(uintptr_t)(lds + L_EPI); S.wv = wave; S.k = 0;
    EpiA E{P.Q, P.KV, P.SG, P.IQ, P.IK, P.IW, P.qn_a_g, P.kn_a_g, (const LAS float*)(lds + L_EPI), 0};
    pg8::gemm_phase<EpiA, OrderR, true, true>(lds, g, S, E, wave);
    __syncthreads();
  }
  SEAM(1);
  if (IN(2)) for (int rep_ = 0; rep_ < NREP(2); ++rep_) {
    LOAD_PTRS();
    { FRESH_TID(tidb); build_btab(lds, P.rel_bias, tidb); }
#pragma unroll 1
    for (int i = 0; ; ++i) { int b, qt;
      if (G == 256) { if (i >= 4) break; const int c = vcu & 31; b = 2 * (vcu >> 5) + (i >> 1); qt = (i & 1) ? c : 63 - c; }
      else { const int u = vcu + i * G; if (u >= 1024) break; b = u >> 6; qt = 63 - (u & 63); }
      dsa_unit(lds, P, b, qt, wave); }
    __syncthreads();
  }
  SEAM(2);
  if (IN(3)) for (int rep_ = 0; rep_ < NREP(3); ++rep_) {
    LOAD_PTRS();
    pg8::Gemm g{P.OG, P.WtOA, MTOK, 1024, 1024}; pg8::StaticOrder S; S.init(MTOK, 1024, G, bx);
    EpiRes2 E{P.XN, P.SSQ, (LAS float*)(lds + L_EPI)};
    pg8::gemm_phase<EpiRes2, pg8::StaticOrder, true, true>(lds, g, S, E, wave);
    __syncthreads();
  }
  SEAM(3);
  if (IN(5)) for (int rep_ = 0; rep_ < NREP(5); ++rep_) {
    LOAD_PTRS();
    pg8::Gemm g{P.XN, P.WtB, MTOK, NCOL_B, 1024}; OrderS S; S.init(MTOK, NCOL_B, G, bx); S.sv = P.SSQ; S.ldsb = (unsigned)(uintptr_t)(lds + L_EPI); S.wv = wave; S.k = 0;
    EpiB E{P.Q, P.KV, P.SG, P.qn_b_g, P.kn_b_g, (const LAS f32x4*)(lds + L_EPI), P.KM, 0};
    pg8::gemm_phase<EpiB, OrderS, true, true>(lds, g, S, E, wave);
    __syncthreads();
  }
  SEAM(5);
  if (IN(7)) for (int rep_ = 0; rep_ < NREP(7); ++rep_) {
    LOAD_PTRS();
    { FRESH_TID(tidb); build_btab(lds, P.rel_bias, tidb); }
#pragma unroll 1
    for (int i = 0; ; ++i) { int b, qt;
      if (G == 256) { if (i >= 4) break; const int c = vcu & 31; b = 2 * (vcu >> 5) + (i >> 1); qt = (i & 1) ? c : 63 - c; }
      else { const int u = vcu + i * G; if (u >= 1024) break; b = u >> 6; qt = 63 - (u & 63); }
      moba_unit(lds, P, b, qt, wave); }
    __syncthreads();
  }
  SEAM(7);
  if (IN(8)) for (int rep_ = 0; rep_ < NREP(8); ++rep_) {
    LOAD_PTRS();
    pg8::Gemm g{P.OG, P.WtOB, MTOK, 1024, 1024}; pg8::StaticOrder S; S.init(MTOK, 1024, G, bx);
    EpiRes E{P.XN, P.out, lds + L_EPI};
    pg8::gemm_phase<EpiRes, pg8::StaticOrder, true, true>(lds, g, S, E, wave);
  }
#undef IN
#undef SEAM
}

extern "C" void kernel_launch(void* const* d_in, const int* in_sizes, int n_in, void* d_out, int out_size, void* d_ws, size_t ws_size, hipStream_t stream) {
  static int grid = 0;
  if (grid == 0) {
    if (n_in != 14 || out_size != MTOK * DM || ws_size < WS_END) { fprintf(stderr, "kernel_launch: unexpected problem (n_in %d, out %d, ws %zu)\n", n_in, out_size, ws_size); grid = -1; return; }
    int dev = 0, cus = 0, per_cu = 0;
    if (hipGetDevice(&dev) != hipSuccess || hipDeviceGetAttribute(&cus, hipDeviceAttributeMultiprocessorCount, dev) != hipSuccess) { grid = -1; return; }
    if (hipFuncSetAttribute((const void*)fwd, hipFuncAttributeMaxDynamicSharedMemorySize, LDS_BYTES) != hipSuccess) { fprintf(stderr, "kernel_launch: hipFuncSetAttribute failed\n"); grid = -1; return; }
    if (hipOccupancyMaxActiveBlocksPerMultiprocessor(&per_cu, (const void*)fwd, 512, LDS_BYTES) != hipSuccess || per_cu < 1) { fprintf(stderr, "kernel_launch: occupancy query says %d\n", per_cu); per_cu = 1; }
    (void)hipGetLastError();
    grid = cus;
  }
  if (grid < 0) return;
  Args a{};
  for (int i = 0; i < 14; ++i) a.in[i] = (const float*)d_in[i];
  a.out = (float*)d_out; a.ws = (unsigned char*)d_ws;
#if MK_N_LAUNCHES == 1
  if (hipMemsetAsync(d_ws, 0, 16384 * 9, stream) != hipSuccess) { fprintf(stderr, "kernel_launch: memset of the barrier words failed\n"); return; }
  a.ph_lo = 0; a.ph_hi = NPHASE;
  void* kargs[] = {&a};
  hipError_t e = hipLaunchCooperativeKernel((const void*)fwd, dim3(grid), dim3(512), kargs, LDS_BYTES, stream);
  if (e != hipSuccess) fprintf(stderr, "kernel_launch: cooperative launch failed: %s\n", hipGetErrorString(e));
#else
#ifndef HOST_REP_MASK
#define HOST_REP_MASK 0
#endif
  for (int p = 0; p < NPHASE; ++p) { a.ph_lo = p; a.ph_hi = p + 1; for (int r = 0; r < (((HOST_REP_MASK >> p) & 1) ? 2 : 1); ++r) hipLaunchKernelGGL(fwd, dim3(grid), dim3(512), LDS_BYTES, stream, a); }
#endif
}
```

```cpp
#include <hip/hip_runtime.h>
#include <hip/hip_cooperative_groups.h>
#include <cstdio>
#include <cstdint>
__device__ __forceinline__ int lane_id_hw() { unsigned z = 0u; asm volatile("" : "+v"(z)); return (int)__builtin_amdgcn_mbcnt_hi(~0u, __builtin_amdgcn_mbcnt_lo(~0u, z)); }
namespace pg8 {
#define PG8_LAS __attribute__((address_space(3)))
typedef unsigned short bf16_t;
typedef short bf16x8 __attribute__((ext_vector_type(8)));
typedef float f32x4 __attribute__((ext_vector_type(4)));
typedef unsigned u32x4 __attribute__((ext_vector_type(4)));
constexpr int BM = 256, BK = 64, HALF = 128, HTB = HALF * BK * 2  , STAGE_BYTES = 8 * HTB, NXCD = 8, WGM = 8;

__host__ __device__ __forceinline__ int lds_byte(int r, int c) { const int st = (r >> 4) * 2 + (c >> 5), rr = r & 15, cc = c & 31, ob = rr * 64 + cc * 2; return st * 1024 + (ob ^ (((ob >> 9) & 1) << 5)); }
__host__ __device__ __forceinline__ void stage_rc(int b, int& R, int& C) { const int st = b / 1024, sb = b % 1024, swz = sb ^ (((sb >> 9) & 1) << 5); R = (st >> 1) * 16 + swz / 64; C = (st & 1) * 32 + (swz % 64) / 2; }
__host__ __device__ __forceinline__ int perm32(int rho) { const int n = rho >> 4, i = rho & 15; return 8 * (i >> 2) + 4 * n + (i & 3); }

struct Unit { int pm, pn; };
struct Gemm { const bf16_t* A; const bf16_t* Bt; int M, N, K; };

struct StaticOrder {
    int nM, nN, nwg, G, c;
    __host__ __device__ void init(int M, int N, int G_, int c_) { nM = M / BM; nN = N / BM; nwg = nM * nN; G = G_; c = c_; }
    __host__ __device__ bool next(int i, Unit& u) const {
        const long L = (long)i * G + c; if (L >= nwg) return false;
        int wgid = (int)L; { const int q = nwg / NXCD, r = nwg % NXCD, xcd = wgid % NXCD, off = wgid / NXCD; wgid = (xcd < r ? xcd * (q + 1) : r * (q + 1) + (xcd - r) * q) + off; }
        const int nig = WGM * nN, gid = wgid / nig, fm = gid * WGM, gsz = (nM - fm) < WGM ? (nM - fm) : WGM;
        u.pm = fm + ((wgid % nig) % gsz); u.pn = (wgid % nig) / gsz; return true;
    }
    __device__ __forceinline__ void a_ready(const Unit&) const {}
    __device__ __forceinline__ void done(const Unit&) const {}
};

template <class Epi, class Sched, bool ALIGN_EPI = false, bool SP2 = false>
__device__ __forceinline__ void gemm_phase(PG8_LAS unsigned char* lds, const Gemm g, const Sched& S, const Epi& E, int wave_) {
    const int tid = wave_ * 64 + lane_id_hw(), wid = __builtin_amdgcn_readfirstlane(tid >> 6), lane = tid & 63, wr = wid >> 2, wc = wid & 3, fr = lane & 15, fq = lane >> 4;
    const int K = g.K, nt = K / BK;
    unsigned voffA[2], voffB[2];
#pragma unroll
    for (int i = 0; i < 2; ++i) { int R, C; stage_rc(tid * 16 + i * 8192, R, C); const int Rb = Epi::PERM ? ((R & ~31) + perm32(R & 31)) : R;
        voffA[i] = (unsigned)(R * K + C) * 2u; voffB[i] = (unsigned)(Rb * K + C) * 2u; }
    const size_t kstep = (size_t)(BK * 2);
    const size_t hstep = (size_t)HALF * K * 2;
    const size_t tstep = 2 * hstep;
    const unsigned ldsw = (unsigned)wid * 1024u;
    const int aoff = lds_byte(wr * 64 + fr, fq * 8), boff = lds_byte(wc * 32 + fr, fq * 8);
#define PG8_SA(b, h) (((b) * 2 + (h)) * HTB)
#define PG8_SB(b, h) ((4 + (b) * 2 + (h)) * HTB)
#define PG8_STAGE(bufoff, gbase, voff) do { _Pragma("unroll") for (int _i = 0; _i < 2; ++_i) \
        __builtin_amdgcn_global_load_lds((const unsigned*)((const char*)(gbase) + (voff)[_i]), (PG8_LAS unsigned*)(lds + (bufoff) + ldsw + _i * 8192), 16, 0, 0); } while (0)
#define PG8_LDA(dst, b, h) do { _Pragma("unroll") for (int m = 0; m < 4; ++m) _Pragma("unroll") for (int k = 0; k < 2; ++k) dst[m][k] = *(const PG8_LAS bf16x8*)(lds + PG8_SA(b, h) + aoff + m * 2048 + k * 1024); } while (0)
#define PG8_LDB(dst, b, h) do { _Pragma("unroll") for (int n = 0; n < 2; ++n) _Pragma("unroll") for (int k = 0; k < 2; ++k) dst[n][k] = *(const PG8_LAS bf16x8*)(lds + PG8_SB(b, h) + boff + n * 2048 + k * 1024); } while (0)
#define PG8_MMA(ai, bj, At, Bt) do { __builtin_amdgcn_s_setprio(1); _Pragma("unroll") for (int m = 0; m < 4; ++m) _Pragma("unroll") for (int n = 0; n < 2; ++n) _Pragma("unroll") for (int k = 0; k < 2; ++k) \
        acc[ai][bj][m][n] = __builtin_amdgcn_mfma_f32_16x16x32_bf16(Bt[n][k], At[m][k], acc[ai][bj][m][n], 0, 0, 0); __builtin_amdgcn_s_setprio(0); } while (0)
#define PG8_WAIT_V(n) asm volatile("s_waitcnt vmcnt(" #n ")" ::: "memory")
#define PG8_WAIT_L(n) asm volatile("s_waitcnt lgkmcnt(" #n ")" ::: "memory")
#define PG8_BAR __builtin_amdgcn_s_barrier()
#define PG8_SCHED __builtin_amdgcn_sched_barrier(0)
    Unit cur, nxt; int ui = 0;
    if (!S.next(0, cur)) return;
    f32x4 acc[2][2][4][2];
#pragma unroll
    for (int a = 0; a < 2; ++a)
#pragma unroll
        for (int b = 0; b < 2; ++b)
#pragma unroll
            for (int m = 0; m < 4; ++m)
#pragma unroll
                for (int n = 0; n < 2; ++n) acc[a][b][m][n] = (f32x4){0.f, 0.f, 0.f, 0.f};
    bf16x8 At[4][2], B0[2][2], B1[2][2];
    const char* cA = (const char*)g.A + (size_t)cur.pm * tstep; const char* cB = (const char*)g.Bt + (size_t)cur.pn * tstep;
    S.a_ready(cur);
    if constexpr (SP2) {
        PG8_STAGE(PG8_SB(0, 0), cB, voffB); PG8_STAGE(PG8_SB(0, 1), cB + hstep, voffB); PG8_STAGE(PG8_SA(0, 0), cA, voffA); PG8_STAGE(PG8_SA(0, 1), cA + hstep, voffA);
        if (wr == 1) PG8_BAR;
        PG8_WAIT_V(2); PG8_BAR;
        PG8_STAGE(PG8_SB(1, 0), cB + kstep, voffB); PG8_STAGE(PG8_SA(1, 0), cA + kstep, voffA); PG8_STAGE(PG8_SB(1, 1), cB + hstep + kstep, voffB);
        PG8_WAIT_V(6); PG8_BAR;
    } else {
        PG8_STAGE(PG8_SB(0, 0), cB, voffB); PG8_STAGE(PG8_SA(0, 0), cA, voffA); PG8_STAGE(PG8_SB(0, 1), cB + hstep, voffB); PG8_STAGE(PG8_SA(0, 1), cA + hstep, voffA);
        if (wr == 1) PG8_BAR;
        PG8_WAIT_V(4); PG8_BAR;
        PG8_STAGE(PG8_SB(1, 0), cB + kstep, voffB); PG8_STAGE(PG8_SA(1, 0), cA + kstep, voffA); PG8_STAGE(PG8_SB(1, 1), cB + hstep + kstep, voffB);
        PG8_WAIT_V(6); PG8_BAR;
    }
    for (;;) {
        const bool has_next = S.next(ui + 1, nxt);
        const char* nA = has_next ? (const char*)g.A + (size_t)nxt.pm * tstep : cA; const char* nB = has_next ? (const char*)g.Bt + (size_t)nxt.pn * tstep : cB;
        for (int t = 0; t < nt; t += 2) {
            const bool last = (t == nt - 2);
            const char* a1 = cA + (size_t)(t + 1) * kstep;
            const char* a2 = last ? nA : cA + (size_t)(t + 2) * kstep; const char* b2 = last ? nB : cB + (size_t)(t + 2) * kstep;
            const char* a3 = a2 + kstep; const char* b3 = b2 + kstep;
            if (last && has_next) S.a_ready(nxt);
            if constexpr (SP2) {
            PG8_LDB(B0, 0, 0); PG8_LDB(B1, 0, 1); PG8_SCHED; PG8_LDA(At, 0, 0); PG8_STAGE(PG8_SA(1, 1), a1 + hstep, voffA);
            PG8_WAIT_V(8); PG8_WAIT_L(0); PG8_BAR; PG8_MMA(0, 0, At, B0); PG8_MMA(0, 1, At, B1); PG8_BAR; PG8_SCHED;
            PG8_LDA(At, 0, 1); PG8_STAGE(PG8_SB(0, 0), b2, voffB); PG8_STAGE(PG8_SB(0, 1), b2 + hstep, voffB); PG8_STAGE(PG8_SA(0, 0), a2, voffA);
            PG8_WAIT_V(8); PG8_WAIT_L(0); PG8_BAR; PG8_MMA(1, 0, At, B0); PG8_MMA(1, 1, At, B1); PG8_BAR; PG8_SCHED;
            PG8_LDB(B0, 1, 0); PG8_LDB(B1, 1, 1); PG8_SCHED; PG8_LDA(At, 1, 0); PG8_STAGE(PG8_SA(0, 1), a2 + hstep, voffA);
            PG8_WAIT_V(8); PG8_WAIT_L(0); PG8_BAR; PG8_MMA(0, 0, At, B0); PG8_MMA(0, 1, At, B1); PG8_BAR; PG8_SCHED;
            PG8_LDA(At, 1, 1); PG8_STAGE(PG8_SB(1, 0), b3, voffB); PG8_STAGE(PG8_SB(1, 1), b3 + hstep, voffB); PG8_STAGE(PG8_SA(1, 0), a3, voffA);
            PG8_WAIT_V(8); PG8_WAIT_L(0); PG8_BAR; PG8_MMA(1, 0, At, B0); PG8_MMA(1, 1, At, B1); PG8_BAR; PG8_SCHED;
            } else {
            PG8_LDB(B0, 0, 0); PG8_SCHED; PG8_LDA(At, 0, 0); PG8_STAGE(PG8_SA(1, 1), a1 + hstep, voffA);
            PG8_WAIT_L(8); PG8_BAR; PG8_WAIT_L(0); PG8_MMA(0, 0, At, B0); PG8_BAR; PG8_SCHED;
            PG8_LDB(B1, 0, 1); PG8_STAGE(PG8_SB(0, 0), b2, voffB);
            PG8_BAR; PG8_WAIT_L(0); PG8_MMA(0, 1, At, B1); PG8_BAR;
            PG8_LDA(At, 0, 1); PG8_STAGE(PG8_SA(0, 0), a2, voffA);
            PG8_BAR; PG8_WAIT_L(0); PG8_MMA(1, 0, At, B0); PG8_BAR; PG8_SCHED;
            PG8_STAGE(PG8_SB(0, 1), b2 + hstep, voffB);
            PG8_WAIT_V(6); PG8_BAR; PG8_MMA(1, 1, At, B1); PG8_BAR;
            PG8_LDB(B0, 1, 0); PG8_SCHED; PG8_LDA(At, 1, 0); PG8_STAGE(PG8_SA(0, 1), a2 + hstep, voffA);
            PG8_WAIT_L(8); PG8_BAR; PG8_WAIT_L(0); PG8_MMA(0, 0, At, B0); PG8_BAR; PG8_SCHED;
            PG8_LDB(B1, 1, 1); PG8_STAGE(PG8_SB(1, 0), b3, voffB);
            PG8_BAR; PG8_WAIT_L(0); PG8_MMA(0, 1, At, B1); PG8_BAR;
            PG8_LDA(At, 1, 1); PG8_STAGE(PG8_SA(1, 0), a3, voffA);
            PG8_BAR; PG8_WAIT_L(0); PG8_MMA(1, 0, At, B0); PG8_BAR; PG8_SCHED;
            PG8_STAGE(PG8_SB(1, 1), b3 + hstep, voffB);
            PG8_WAIT_V(6); PG8_BAR; PG8_MMA(1, 1, At, B1); PG8_BAR;
            }
        }
        if constexpr (ALIGN_EPI) { if (wr == 0) PG8_BAR; }
        if constexpr (!Epi::AFTER_DRAIN) { E(acc, cur, wr, wc, fr, fq); S.done(cur); }
        if (!has_next) break;
#pragma unroll
        for (int a = 0; a < 2; ++a)
#pragma unroll
            for (int b = 0; b < 2; ++b)
#pragma unroll
                for (int m = 0; m < 4; ++m)
#pragma unroll
                    for (int n = 0; n < 2; ++n) acc[a][b][m][n] = (f32x4){0.f, 0.f, 0.f, 0.f};
        cur = nxt; cA = nA; cB = nB; ++ui;
        if constexpr (ALIGN_EPI) { if (wr == 1) PG8_BAR; }
    }
    PG8_WAIT_V(0);
    if constexpr (!ALIGN_EPI) { if (wr == 0) PG8_BAR; }
    PG8_BAR;
    if constexpr (Epi::AFTER_DRAIN) { E.fused(acc, cur, wr, wc, fr, fq, lds, wid, lane); S.done(cur); }
#undef PG8_SA
#undef PG8_SB
#undef PG8_STAGE
#undef PG8_LDA
#undef PG8_LDB
#undef PG8_MMA
#undef PG8_WAIT_V
#undef PG8_WAIT_L
#undef PG8_BAR
#undef PG8_SCHED
}
}

#ifndef MK_N_LAUNCHES
#define MK_N_LAUNCHES 1
#endif
namespace cg = cooperative_groups;
#define DI __device__ __forceinline__
#define LAS __attribute__((address_space(3)))
typedef unsigned short bf16;
typedef short bf16x8 __attribute__((ext_vector_type(8)));
typedef float f32x4 __attribute__((ext_vector_type(4)));
typedef float f32x16 __attribute__((ext_vector_type(16)));
typedef unsigned u32x4 __attribute__((ext_vector_type(4)));
typedef unsigned u32x2 __attribute__((ext_vector_type(2)));
typedef float f32x2_t __attribute__((ext_vector_type(2)));
typedef __bf16 bf16x2_t __attribute__((ext_vector_type(2)));
typedef short s16x2 __attribute__((ext_vector_type(2)));
typedef unsigned short u16x2 __attribute__((ext_vector_type(2)));

constexpr int SEQ = 2048, DM = 1024, NBATCH = 16, MTOK = NBATCH * SEQ;
constexpr int NCOL_A = 3328, NCOL_B = 2560;
constexpr float EPS = 1e-6f;
constexpr float LOG2E = 1.4426950408889634f;
constexpr float C2 = 0.125f * LOG2E;
constexpr int NPHASE = 9;

constexpr size_t MiB = 1u << 20;
constexpr size_t WS_WA = 1 * MiB, WS_WOA = 8 * MiB, WS_WB = 10 * MiB, WS_WOB = 15 * MiB, WS_KM = 17 * MiB, WS_IW = 18 * MiB, WS_IK = 19 * MiB;
constexpr size_t WS_XN = 24 * MiB, WS_Q = 88 * MiB, WS_K = 152 * MiB, WS_VT = 168 * MiB, WS_SG = 184 * MiB, WS_IQ = 248 * MiB, WS_OG = 280 * MiB, WS_H1 = 344 * MiB, WS_END = 472 * MiB;

constexpr int LDS_BYTES = 153600;
constexpr int IQ_STRIDE = 1040;
constexpr int L_IQ = 0, L_HIST = 33280, L_SEL = 131072, L_MASK = L_SEL + 512, L_BTAB = L_MASK + 8192, L_SELM = L_BTAB + 12288, L_BLK = L_SELM + 128, L_END = L_BLK + 16;
static_assert(L_HIST + 32 * 257 * 4 + 256 <= L_SEL, "selection scratch inside the ring");
constexpr int L_EPI = 131072;
static_assert(L_EPI + 8 * 2304 <= 152320, "epilogue staging");
constexpr int L_MISC = 152320;
static_assert(L_END <= L_MISC && L_MISC + 64 + 128 <= LDS_BYTES && LDS_BYTES <= 163840, "LDS map");

__device__ const unsigned char BKT[128] = {
  0, 1, 2, 3, 4, 5, 6, 7, 8, 9, 10, 11, 12, 13, 14, 15, 16, 16, 16, 17, 17, 18, 18, 18, 19, 19, 19, 20, 20, 20, 20, 21,
  21, 21, 21, 22, 22, 22, 22, 22, 23, 23, 23, 23, 23, 23, 24, 24, 24, 24, 24, 24, 25, 25, 25, 25, 25, 25, 25, 26, 26, 26, 26, 26,
  26, 26, 26, 27, 27, 27, 27, 27, 27, 27, 27, 27, 27, 28, 28, 28, 28, 28, 28, 28, 28, 28, 28, 29, 29, 29, 29, 29, 29, 29, 29, 29,
  29, 29, 29, 30, 30, 30, 30, 30, 30, 30, 30, 30, 30, 30, 30, 30, 30, 31, 31, 31, 31, 31, 31, 31, 31, 31, 31, 31, 31, 31, 31, 31};

struct Args { const float* in[14]; float* out; unsigned char* ws; int ph_lo, ph_hi; };

struct Ptrs {
  const float *x, *norm_a_g, *w_in_a, *qn_a_g, *kn_a_g, *w_out_a, *rel_bias, *norm_kv_g, *w_kv, *kn_b_g, *norm_b_g, *w_in_b, *qn_b_g, *w_out_b;
  float* out;
  bf16 *WtA, *WtOA, *WtB, *WtOB, *XN, *Q, *KV, *SG, *IQ, *IK, *OG;
  float *IW, *KM, *RINV, *SSQ;
};

DI unsigned cvtpk(float lo, float hi) { f32x2_t v = {lo, hi}; bf16x2_t b = __builtin_convertvector(v, bf16x2_t); return __builtin_bit_cast(unsigned, b); }
DI float bflo(unsigned u) { return __uint_as_float(u << 16); }
DI float bfhi(unsigned u) { return __uint_as_float(u & 0xffff0000u); }
DI float wave_sum(float v) {
#pragma unroll
  for (int o = 1; o < 64; o <<= 1) v += __shfl_xor(v, o);
  return v;
}
DI float silu_f(float v) { return v * __builtin_amdgcn_rcpf(1.0f + __expf(-v)); }
#define MFMA32(a, b, c) __builtin_amdgcn_mfma_f32_32x32x16_bf16((a), (b), (c), 0, 0, 0)

#define XB_TMO      128
#define XB_XCNT(j)  (256  + 64 * (j))
#define XB_XSUB(j)  (1280 + 64 * (j))
#define XB_XGEN(j)  (2304 + 64 * (j))
#define XB_TOP      3328
#define XB_TOPGEN   3392
#define XCD_BAR_WORDS 3456
#define XB_SPIN_CAP (1u << 18)

__device__ __forceinline__ unsigned xb_ld(unsigned* p)              { return __hip_atomic_load(p, __ATOMIC_RELAXED, __HIP_MEMORY_SCOPE_AGENT); }
__device__ __forceinline__ unsigned xb_add(unsigned* p, unsigned v) { return __hip_atomic_fetch_add(p, v, __ATOMIC_RELAXED, __HIP_MEMORY_SCOPE_AGENT); }
__device__ __forceinline__ unsigned xb_xcc_id() { return (unsigned)__builtin_amdgcn_s_getreg((3 << 11) | 20) & 0xFu; }
#define XB_SPIN(cond, bar) do { unsigned _sp = 0; while (cond) { __builtin_amdgcn_s_sleep(1); \
    if ((++_sp & 255u) == 0u) { if (xb_ld(&(bar)[XB_TMO])) break; if (_sp > XB_SPIN_CAP) { atomicAdd(&(bar)[XB_TMO], 1u); break; } } } } while (0)

struct XcdBarrier {
    unsigned* bar; unsigned x; unsigned total;
    volatile LAS unsigned* st;
};

__device__ __forceinline__ XcdBarrier xcd_barrier_post(unsigned* bar, volatile LAS unsigned* st, bool lead_, unsigned total_) {
    XcdBarrier b; b.bar = bar; b.x = xb_xcc_id(); b.st = st; b.total = total_;
    if (lead_) (void)xb_add(&bar[XB_XCNT(b.x)], 1u);
    return b;
}
__device__ __forceinline__ void xcd_barrier_complete(unsigned* bar, unsigned x, unsigned& nloc, unsigned& nx, unsigned G) {
    unsigned sum, cnt, mine, sp = 0u;
    for (;;) {
        sum = 0u; cnt = 0u; mine = 0u;
#pragma unroll
        for (unsigned j = 0; j < 16; ++j) { const unsigned c = xb_ld(&bar[XB_XCNT(j)]); sum += c; cnt += (c > 0u) ? 1u : 0u; mine = (j == x) ? c : mine; }
        if (sum == G) break;
        __builtin_amdgcn_s_sleep(1);
        if ((++sp & 255u) == 0u) { if (xb_ld(&bar[XB_TMO])) break; if (sp > XB_SPIN_CAP) { atomicAdd(&bar[XB_TMO], 1u); break; } }
    }
    nloc = mine > 0u ? mine : 1u; nx = cnt > 0u ? cnt : 1u;
}

__device__ __forceinline__ void xcd_barrier(const XcdBarrier& b, bool lead_) {
    asm volatile("s_waitcnt vmcnt(0)" ::: "memory");
    __syncthreads();
    if (lead_) {
        unsigned* bar = b.bar;
        __builtin_amdgcn_s_waitcnt(0);
        unsigned nloc = b.st[0], nx = b.st[1];
        if (nloc == 0u) { xcd_barrier_complete(bar, b.x, nloc, nx, b.total); b.st[0] = nloc; b.st[1] = nx; }
        const unsigned old = xb_add(&bar[XB_XSUB(b.x)], 1u);
        const unsigned gen = old / nloc;
        if (old + 1u == (gen + 1u) * nloc) {
            if (nx > 1u) __builtin_amdgcn_fence(__ATOMIC_RELEASE, "agent");
            else __builtin_amdgcn_fence(__ATOMIC_RELEASE, "workgroup");
            asm volatile("s_waitcnt vmcnt(0)" ::: "memory");
            if (nx > 1u) {
            const unsigned og = xb_add(&bar[XB_TOP], 1u);
            const unsigned tg = og / nx;
            if (og + 1u == (tg + 1u) * nx) xb_add(&bar[XB_TOPGEN], 1u);
            else XB_SPIN(xb_ld(&bar[XB_TOPGEN]) == tg, bar);
            }
            if (nx == 1u) (void)__hip_atomic_fetch_add(&bar[XB_XGEN(b.x)], 1u, __ATOMIC_RELAXED, __HIP_MEMORY_SCOPE_AGENT);
            __builtin_amdgcn_fence(__ATOMIC_ACQUIRE, "agent");
            if (nx > 1u) xb_add(&bar[XB_XGEN(b.x)], 1u);
            asm volatile("s_waitcnt vmcnt(0)" ::: "memory");
        } else {
            XB_SPIN(xb_ld(&bar[XB_XGEN(b.x)]) == gen, bar);
            __builtin_amdgcn_fence(__ATOMIC_ACQUIRE, "agent");
            asm volatile("s_waitcnt vmcnt(0)" ::: "memory");
        }
    }
    __syncthreads();
}

DI int slot_of(int gc) { const int u = gc & 255; return (gc & ~255) + 128 * ((u >> 5) & 1) + 32 * (u >> 6) + 16 * ((u >> 2) & 1) + 4 * ((u >> 3) & 3) + (u & 3); }

typedef pg8::f32x4 accq;
DI int pi32(int r) { return (r & ~12) | ((r & 4) << 1) | ((r & 8) >> 1); }
DI size_t kv_tile_elem(int row) { return (size_t)(row >> 5) * 16384; }
DI bf16* k_piece(bf16* KV, int row, int g, int bj, int fq) {
  return KV + kv_tile_elem(row) + (size_t)(((g * 4 + 2 * bj + (fq >> 1)) * 64 + (fq & 1) * 32 + pi32(row & 31)) * 8);
}
struct OrderR : pg8::StaticOrder {
  const float* rv; unsigned ldsb; int wv; mutable int k;
  DI void a_ready(const pg8::Unit& u) const {
    if (wv == 0) { const float* src = rv + (size_t)u.pm * 256 + lane_id_hw() * 4; unsigned keep; const unsigned dst = (unsigned)__builtin_amdgcn_readfirstlane((int)(ldsb + (unsigned)(k & 1) * 1024u));
      asm volatile("s_mov_b32 %0, m0\n\ts_mov_b32 m0, %2\n\ts_nop 0\n\tglobal_load_lds_dwordx4 %1, off\n\ts_mov_b32 m0, %0\n\ts_nop 0" : "=&s"(keep) : "v"(src), "s"(dst) : "memory"); }
    ++k;
  }
};
struct OrderS : pg8::StaticOrder {
  const float* sv; unsigned ldsb; int wv; mutable int k;
  DI void a_ready(const pg8::Unit& u) const {
    if (wv == 0) { const char* src = (const char*)(sv + (size_t)u.pm * 1024) + lane_id_hw() * 16; const unsigned dst0 = ldsb + (unsigned)(k & 1) * 4096u;
#pragma unroll
      for (int i = 0; i < 4; ++i) { unsigned keep; const unsigned d_ = (unsigned)__builtin_amdgcn_readfirstlane((int)(dst0 + (unsigned)i * 1024u)); const char* p_ = src + i * 1024;
        asm volatile("s_mov_b32 %0, m0\n\ts_mov_b32 m0, %2\n\ts_nop 0\n\tglobal_load_lds_dwordx4 %1, off\n\ts_mov_b32 m0, %0\n\ts_nop 0" : "=&s"(keep) : "v"(p_), "s"(d_) : "memory"); } }
    ++k;
  }
};
DI void load_gain(float (&gv)[2][2][4], const float* g, int fq, float sc) {
#pragma unroll
  for (int bj = 0; bj < 2; ++bj)
#pragma unroll
    for (int n = 0; n < 2; ++n)
#pragma unroll
      for (int e = 0; e < 4; ++e) gv[bj][n][e] = g[32 * bj + 8 * fq + 4 * n + e] * sc;
}
template <int ACT  > DI void plain_store(const accq (&acc)[2][2][4][2], int ai, int m, float sc, bf16* dst) {
#pragma unroll
  for (int bj = 0; bj < 2; ++bj) {
    float v[8];
#pragma unroll
    for (int n = 0; n < 2; ++n)
#pragma unroll
      for (int e = 0; e < 4; ++e) { float t = acc[ai][bj][m][n][e] * sc; if (ACT == 1) t = silu_f(t); v[4 * n + e] = t; }
    u32x4 w; w.x = cvtpk(v[0], v[1]); w.y = cvtpk(v[2], v[3]); w.z = cvtpk(v[4], v[5]); w.w = cvtpk(v[6], v[7]);
    *(u32x4*)(dst + 32 * bj) = w;
  }
}
DI void v_store_scaled(const accq (&acc)[2][2][4][2], int ai, int m, bf16* KV, int row, int g, int fq, float sc) {
  const int i = row & 31;
  bf16* base = KV + kv_tile_elem(row) + (size_t)((16 + g * 4 + (i >> 4)) * 512 + ((i >> 3) & 1) * 256 + (i & 7));
#pragma unroll
  for (int bj = 0; bj < 2; ++bj)
#pragma unroll
    for (int n = 0; n < 2; ++n)
#pragma unroll
      for (int e = 0; e < 4; e += 2) {
        const unsigned pk = cvtpk(acc[ai][bj][m][n][e] * sc, acc[ai][bj][m][n][e + 1] * sc);
        const int r = 8 * fq + 4 * n + e;
        base[bj * 1024 + r * 8] = (bf16)(pk & 0xffffu); base[bj * 1024 + (r + 1) * 8] = (bf16)(pk >> 16);
      }
}

struct EpiA {
  static constexpr bool PERM = false, AFTER_DRAIN = false;
  bf16 *Q, *KV, *SG, *IQ, *IK; float* IW; const float *qn_g, *kn_g; const LAS float* rl; mutable int k;
  DI void operator()(const accq (&acc)[2][2][4][2], const pg8::Unit& u, int wr, int wc, int fr, int fq) const {
    const int pn = u.pn, row0 = u.pm * 256 + wr * 64 + fr; const LAS float* rinv = rl + (k & 1) * 256 - u.pm * 256; ++k;
    if (pn <= 4) {
      float gv[2][2][4]; load_gain(gv, pn < 4 ? qn_g : kn_g, fq, pn < 4 ? C2 : 1.0f);
#pragma unroll
      for (int ai = 0; ai < 2; ++ai)
#pragma unroll
        for (int m = 0; m < 4; ++m) { const int row = row0 + 128 * ai + 16 * m; const float ri = rinv[row];
          float v[2][2][4]; float ss = 0.f;
#pragma unroll
          for (int bj = 0; bj < 2; ++bj)
#pragma unroll
            for (int n = 0; n < 2; ++n)
#pragma unroll
              for (int e = 0; e < 4; ++e) { v[bj][n][e] = acc[ai][bj][m][n][e] * ri; ss += v[bj][n][e] * v[bj][n][e]; }
          ss += __shfl_xor(ss, 16); ss += __shfl_xor(ss, 32);
          const float rn = rsqrtf(ss * (1.0f / 64.0f) + EPS);
#pragma unroll
          for (int bj = 0; bj < 2; ++bj) {
            u32x4 w; w.x = cvtpk(v[bj][0][0] * rn * gv[bj][0][0], v[bj][0][1] * rn * gv[bj][0][1]); w.y = cvtpk(v[bj][0][2] * rn * gv[bj][0][2], v[bj][0][3] * rn * gv[bj][0][3]);
            w.z = cvtpk(v[bj][1][0] * rn * gv[bj][1][0], v[bj][1][1] * rn * gv[bj][1][1]); w.w = cvtpk(v[bj][1][2] * rn * gv[bj][1][2], v[bj][1][3] * rn * gv[bj][1][3]);
            bf16* dst = pn < 4 ? Q + (size_t)row * 1024 + (4 * pn + wc) * 64 + 8 * fq + 32 * bj : k_piece(KV, row, wc, bj, fq);
            *(u32x4*)dst = w; } }
    } else if (pn == 5) {
#pragma unroll
      for (int ai = 0; ai < 2; ++ai)
#pragma unroll
        for (int m = 0; m < 4; ++m) { const int row = row0 + 128 * ai + 16 * m; v_store_scaled(acc, ai, m, KV, row, wc, fq, rinv[row]); }
    } else if (pn <= 9) {
#pragma unroll
      for (int ai = 0; ai < 2; ++ai)
#pragma unroll
        for (int m = 0; m < 4; ++m) { const int row = row0 + 128 * ai + 16 * m; plain_store<1>(acc, ai, m, rinv[row], SG + (size_t)row * 1024 + 256 * (pn - 6) + 64 * wc + 8 * fq); }
    } else if (pn <= 11) {
#pragma unroll
      for (int ai = 0; ai < 2; ++ai)
#pragma unroll
        for (int m = 0; m < 4; ++m) { const int row = row0 + 128 * ai + 16 * m; plain_store<0>(acc, ai, m, 0.125f * rinv[row], IQ + (size_t)row * 512 + 256 * (pn - 10) + 64 * wc + 8 * fq); }
    } else {
      if (wc == 0) {
#pragma unroll
        for (int ai = 0; ai < 2; ++ai)
#pragma unroll
          for (int m = 0; m < 4; ++m) { const int row = row0 + 128 * ai + 16 * m; const float sc = rinv[row];
#pragma unroll
            for (int bj = 0; bj < 2; ++bj) { u32x4 w; w.x = cvtpk(acc[ai][bj][m][0][0] * sc, acc[ai][bj][m][0][1] * sc); w.y = cvtpk(acc[ai][bj][m][0][2] * sc, acc[ai][bj][m][0][3] * sc);
              w.z = cvtpk(acc[ai][bj][m][1][0] * sc, acc[ai][bj][m][1][1] * sc); w.w = cvtpk(acc[ai][bj][m][1][2] * sc, acc[ai][bj][m][1][3] * sc);
              *(u32x4*)(IK + (size_t)(row >> 5) * 2048 + (size_t)(((2 * bj + (fq >> 1)) * 64 + (fq & 1) * 32 + pi32(row & 31)) * 8)) = w; } }
      } else if (wc == 1 && fq == 0) {
#pragma unroll
        for (int ai = 0; ai < 2; ++ai)
#pragma unroll
          for (int m = 0; m < 4; ++m) { const int row = row0 + 128 * ai + 16 * m; float* d = IW + (size_t)row * 8; const float sc = 0.35355339059327373f * rinv[row];
            *(f32x4*)d = acc[ai][0][m][0] * sc; *(f32x4*)(d + 4) = acc[ai][0][m][1] * sc; }
      }
    }
  }
};
struct EpiB {
  static constexpr bool PERM = false, AFTER_DRAIN = false;
  bf16 *Q, *KV, *SG; const float *qn_g, *kn_g; const LAS f32x4* rl; float* KM; mutable int k;
  DI void operator()(const accq (&acc)[2][2][4][2], const pg8::Unit& u, int wr, int wc, int fr, int fq) const {
    const int pn = u.pn, row0 = u.pm * 256 + wr * 64 + fr; const LAS f32x4* s4 = rl + (k & 1) * 256 - u.pm * 256; ++k;
#define RINV2(row_) ({ const f32x4 p_ = s4[(row_)]; rsqrtf(((p_.x + p_.y) + (p_.z + p_.w)) * (1.0f / 1024.0f) + EPS); })
    if (pn == 0 || (pn >= 2 && pn <= 5)) {
      float gv[2][2][4]; load_gain(gv, pn == 0 ? kn_g : qn_g, fq, pn == 0 ? 1.0f : C2);
      float cs[2][2][4];
#pragma unroll
      for (int bj = 0; bj < 2; ++bj)
#pragma unroll
        for (int n = 0; n < 2; ++n)
#pragma unroll
          for (int e = 0; e < 4; ++e) cs[bj][n][e] = 0.f;
#pragma unroll
      for (int ai = 0; ai < 2; ++ai)
#pragma unroll
        for (int m = 0; m < 4; ++m) { const int row = row0 + 128 * ai + 16 * m; const float ri = RINV2(row);
          float v[2][2][4]; float ss = 0.f;
#pragma unroll
          for (int bj = 0; bj < 2; ++bj)
#pragma unroll
            for (int n = 0; n < 2; ++n)
#pragma unroll
              for (int e = 0; e < 4; ++e) { v[bj][n][e] = acc[ai][bj][m][n][e] * ri; ss += v[bj][n][e] * v[bj][n][e]; }
          ss += __shfl_xor(ss, 16); ss += __shfl_xor(ss, 32);
          const float rn = rsqrtf(ss * (1.0f / 64.0f) + EPS);
#pragma unroll
          for (int bj = 0; bj < 2; ++bj) {
#pragma unroll
            for (int n = 0; n < 2; ++n)
#pragma unroll
              for (int e = 0; e < 4; ++e) { v[bj][n][e] = v[bj][n][e] * rn * gv[bj][n][e]; cs[bj][n][e] += v[bj][n][e]; }
            u32x4 w; w.x = cvtpk(v[bj][0][0], v[bj][0][1]); w.y = cvtpk(v[bj][0][2], v[bj][0][3]); w.z = cvtpk(v[bj][1][0], v[bj][1][1]); w.w = cvtpk(v[bj][1][2], v[bj][1][3]);
            bf16* dst = pn != 0 ? Q + (size_t)row * 1024 + (4 * (pn - 2) + wc) * 64 + 8 * fq + 32 * bj : k_piece(KV, row, wc, bj, fq);
            *(u32x4*)dst = w; } }
      if (pn == 0) {
        float* km = KM + ((size_t)((u.pm >> 3) * 4 + wc) * 8 + (u.pm & 7)) * 64 + 8 * fq;
#pragma unroll
        for (int bj = 0; bj < 2; ++bj)
#pragma unroll
          for (int n = 0; n < 2; ++n)
#pragma unroll
            for (int e = 0; e < 4; ++e) { float t = cs[bj][n][e]; t += __shfl_xor(t, 1); t += __shfl_xor(t, 2); t += __shfl_xor(t, 4); t += __shfl_xor(t, 8);
              if (fr == 0) atomicAdd(km + 32 * bj + 4 * n + e, t * (1.0f / 256.0f)); }
      }
    } else if (pn == 1) {
#pragma unroll
      for (int ai = 0; ai < 2; ++ai)
#pragma unroll
        for (int m = 0; m < 4; ++m) { const int row = row0 + 128 * ai + 16 * m; const float ri = RINV2(row);
          v_store_scaled(acc, ai, m, KV, row, wc, fq, ri); }
    } else {
#pragma unroll
      for (int ai = 0; ai < 2; ++ai)
#pragma unroll
        for (int m = 0; m < 4; ++m) { const int row = row0 + 128 * ai + 16 * m; plain_store<1>(acc, ai, m, RINV2(row), SG + (size_t)row * 1024 + 256 * (pn - 6) + 64 * wc + 8 * fq); }
    }
  }
};
DI void unpack8(const u32x4 w, float (&f)[8]) { f[0] = bflo(w.x); f[1] = bfhi(w.x); f[2] = bflo(w.y); f[3] = bfhi(w.y); f[4] = bflo(w.z); f[5] = bfhi(w.z); f[6] = bflo(w.w); f[7] = bfhi(w.w); }
struct EpiRes {
  static constexpr bool PERM = false, AFTER_DRAIN = false;
  const bf16* res; float* out; LAS unsigned char* stg0;
  DI void operator()(const accq (&acc)[2][2][4][2], const pg8::Unit& u, int wr, int wc, int fr, int fq) const {
    const int row0 = u.pm * 256 + wr * 64 + fr, col0 = u.pn * 256 + 64 * wc + 8 * fq; LAS unsigned char* stg = stg0 + (wr * 4 + wc) * 2304; const int lane = fq * 16 + fr, r8 = lane >> 3, p8 = lane & 7;
#pragma unroll
    for (int ai = 0; ai < 2; ++ai)
#pragma unroll
      for (int m = 0; m < 4; ++m) { const size_t off = (size_t)(row0 + 128 * ai + 16 * m) * 1024 + col0;
#pragma unroll
        for (int bj = 0; bj < 2; ++bj) { float f[8]; unpack8(*(const u32x4*)(res + off + 32 * bj), f);
          f32x4 o0 = acc[ai][bj][m][0], o1 = acc[ai][bj][m][1];
          o0.x += f[0]; o0.y += f[1]; o0.z += f[2]; o0.w += f[3]; o1.x += f[4]; o1.y += f[5]; o1.z += f[6]; o1.w += f[7];
          *(LAS f32x4*)(stg + fr * 144 + fq * 32) = o0; *(LAS f32x4*)(stg + fr * 144 + fq * 32 + 16) = o1;
          asm volatile("" ::: "memory");
          const f32x4 a = *(const LAS f32x4*)(stg + r8 * 144 + p8 * 16), b = *(const LAS f32x4*)(stg + (r8 + 8) * 144 + p8 * 16);
          float* ob = out + (size_t)(row0 - fr + 128 * ai + 16 * m) * 1024 + u.pn * 256 + 64 * wc + 32 * bj + 4 * p8;
          __builtin_nontemporal_store(a, (f32x4*)(ob + (size_t)r8 * 1024)); __builtin_nontemporal_store(b, (f32x4*)(ob + (size_t)(r8 + 8) * 1024));
          asm volatile("" ::: "memory"); } }
  }
};
struct EpiRes2 {
  static constexpr bool PERM = false, AFTER_DRAIN = false;
  bf16* xh; float* ssq4; LAS float* part;
  DI void operator()(const accq (&acc)[2][2][4][2], const pg8::Unit& u, int wr, int wc, int fr, int fq) const {
    const int row0 = u.pm * 256 + wr * 64 + fr, col0 = u.pn * 256 + 64 * wc + 8 * fq;
#pragma unroll
    for (int ai = 0; ai < 2; ++ai)
#pragma unroll
      for (int m = 0; m < 4; ++m) { const int row = row0 + 128 * ai + 16 * m; const size_t off = (size_t)row * 1024 + col0; float ss = 0.f;
#pragma unroll
        for (int bj = 0; bj < 2; ++bj) { float f[8]; unpack8(*(const u32x4*)(xh + off + 32 * bj), f);
#pragma unroll
          for (int n = 0; n < 2; ++n)
#pragma unroll
            for (int e = 0; e < 4; ++e) { f[4 * n + e] += acc[ai][bj][m][n][e]; ss += f[4 * n + e] * f[4 * n + e]; }
          u32x4 w; w.x = cvtpk(f[0], f[1]); w.y = cvtpk(f[2], f[3]); w.z = cvtpk(f[4], f[5]); w.w = cvtpk(f[6], f[7]);
          *(u32x4*)(xh + off + 32 * bj) = w; }
        ss += __shfl_xor(ss, 16); ss += __shfl_xor(ss, 32);
        if (fq == 0) part[wc * 256 + (row - u.pm * 256)] = ss; }
    asm volatile("s_waitcnt lgkmcnt(0)" ::: "memory"); __builtin_amdgcn_s_barrier();
    const int t = (wr * 4 + wc) * 64 + fq * 16 + fr;
    if (t < 256) ssq4[(size_t)(u.pm * 256 + t) * 4 + u.pn] = (part[t] + part[256 + t]) + (part[512 + t] + part[768 + t]);
  }
};
DI int srccol_A(int gc) { if (gc < 3072) return gc; if (gc < 3136) return 3080 + (gc - 3072); if (gc < 3144) return 3072 + (gc - 3136); return -1; }
DI void trans_item(const float* W, int Ns, const float* gk, bf16* Wt, int item, int nblk, int kindA, LAS float* scr, int lane) {
  const int kb = item / nblk, nb = item % nblk, k0 = 64 * kb, gc0 = 32 * nb;
  const int n = lane & 31, gc = gc0 + n; const int sc = kindA ? srccol_A(gc) : gc;
  const int c = lane & 7;
  float v[32];
  const float* wp = W + (size_t)(k0 + (lane >> 5)) * Ns + (sc >= 0 ? sc : 0);
#pragma unroll
  for (int i = 0; i < 32; ++i) v[i] = __builtin_nontemporal_load(wp + (size_t)(2 * i) * Ns);
  f32x4 g0 = {1.f, 1.f, 1.f, 1.f}, g1 = {1.f, 1.f, 1.f, 1.f};
  if (gk) { g0 = *(const f32x4*)(gk + k0 + 8 * c); g1 = *(const f32x4*)(gk + k0 + 8 * c + 4); }
#pragma unroll
  for (int i = 0; i < 32; ++i) scr[(2 * i + (lane >> 5)) * 33 + n] = sc >= 0 ? v[i] : 0.f;
  asm volatile("s_waitcnt lgkmcnt(0)" ::: "memory");
#pragma unroll
  for (int j = 0; j < 4; ++j) { const int nn = (lane >> 3) + 8 * j; const LAS float* s = scr + (8 * c) * 33 + nn;
    u32x4 o; o.x = cvtpk(s[0 * 33] * g0.x, s[1 * 33] * g0.y); o.y = cvtpk(s[2 * 33] * g0.z, s[3 * 33] * g0.w); o.z = cvtpk(s[4 * 33] * g1.x, s[5 * 33] * g1.y); o.w = cvtpk(s[6 * 33] * g1.z, s[7 * 33] * g1.w);
    *(u32x4*)(Wt + (size_t)slot_of(gc0 + nn) * 1024 + k0 + 8 * c) = o; }
  asm volatile("s_waitcnt lgkmcnt(0)" ::: "memory");
}

DI int kidx(int r, int hi) { return 16 * (r >> 3) + 8 * hi + (r & 7); }
DI void k_dma(const char* ksrc  , unsigned voff  , unsigned lds_slot  ) {
  unsigned keep;
  asm volatile("s_waitcnt lgkmcnt(0)\n\ts_mov_b32 %0, m0\n\ts_mov_b32 m0, %3\n\ts_nop 0\n\t"
               "global_load_lds_dwordx4 %1, %2\n\tglobal_load_lds_dwordx4 %1, %2 offset:1024\n\tglobal_load_lds_dwordx4 %1, %2 offset:2048\n\tglobal_load_lds_dwordx4 %1, %2 offset:3072\n\t"
               "s_mov_b32 m0, %0" : "=&s"(keep) : "v"(voff), "s"(ksrc), "s"(lds_slot) : "memory");
}
DI void v_load(bf16x8 (&vf)[4], const char* vsrc  , unsigned voff) {
  asm volatile("global_load_dwordx4 %0, %4, %5\n\tglobal_load_dwordx4 %1, %4, %5 offset:1024\n\tglobal_load_dwordx4 %2, %4, %5 offset:2048\n\tglobal_load_dwordx4 %3, %4, %5 offset:3072"
               : "=&v"(vf[0]), "=&v"(vf[1]), "=&v"(vf[2]), "=&v"(vf[3]) : "v"(voff), "s"(vsrc) : "memory");
}
DI void kv_wait(bf16x8 (&vf)[4]) { asm volatile("s_waitcnt vmcnt(0)" : "+v"(vf[0]), "+v"(vf[1]), "+v"(vf[2]), "+v"(vf[3]) :: "memory"); }
DI void qk_tile(f32x16 (&c)[2], const LAS unsigned char* kslot  , const bf16x8 (&qf)[2][4]) {
  bf16x8 kf[4];
#pragma unroll
  for (int s = 0; s < 4; ++s) kf[s] = *(const LAS bf16x8*)(kslot + s * 1024);
#pragma unroll
  for (int j = 0; j < 2; ++j) {
    f32x16 z;
#pragma unroll
    for (int r = 0; r < 16; ++r) z[r] = 0.f;
    c[j] = MFMA32(kf[0], qf[j][0], z);
#pragma unroll
    for (int s = 1; s < 4; ++s) c[j] = MFMA32(kf[s], qf[j][s], c[j]);
  }
}
DI void add_bias(f32x16 (&c)[2], const LAS float* bt0, int dist0) {
#pragma unroll
  for (int j = 0; j < 2; ++j) { const LAS float* tp = bt0 + j * 192 + (dist0 + 8);
#pragma unroll
    for (int r = 0; r < 16; ++r) c[j][r] += tp[23 - (16 * (r >> 3) + (r & 7))]; }
}
template <int MODE> DI void sm_pv(f32x16 (&O)[2][2], float (&l)[2], const f32x16 (&c)[2], const bf16x8 (&vf4)[4], unsigned m) {
#pragma unroll
  for (int j = 0; j < 2; ++j) {
    float p[16]; float ls = 0.f;
#pragma unroll
    for (int r = 0; r < 16; ++r) {
      const float e = __builtin_amdgcn_exp2f(c[j][r]);
      if (MODE == 0) { const unsigned ext = (unsigned)__builtin_amdgcn_sbfe((int)m, r, 1); p[r] = __uint_as_float(__float_as_uint(e) & ext); }
      else p[r] = e;
      ls += p[r];
    }
    if (MODE == 1) ls = __uint_as_float(__float_as_uint(ls) & m);
    l[j] += ls;
    bf16x8 pk[2];
#pragma unroll
    for (int s = 0; s < 2; ++s) { u32x4 w; w.x = cvtpk(p[8 * s], p[8 * s + 1]); w.y = cvtpk(p[8 * s + 2], p[8 * s + 3]); w.z = cvtpk(p[8 * s + 4], p[8 * s + 5]); w.w = cvtpk(p[8 * s + 6], p[8 * s + 7]);
      if (MODE == 1) { w.x &= m; w.y &= m; w.z &= m; w.w &= m; }
      pk[s] = __builtin_bit_cast(bf16x8, w); }
#pragma unroll
    for (int dt = 0; dt < 2; ++dt)
#pragma unroll
      for (int s = 0; s < 2; ++s) O[j][dt] = MFMA32(vf4[dt * 2 + s], pk[s], O[j][dt]);
  }
}
DI void attn_store(const f32x16 (&O)[2][2], const float (&l)[2], const bf16* SG, bf16* OG, size_t row0, int head0, LAS unsigned char* stg, int lane) {
  const int q = lane & 31, hi = lane >> 5, rr = lane >> 3, pc = lane & 7;
  const size_t goff = (row0 + rr) * 1024 + (size_t)head0 * 64 + 8 * pc;
  u32x4 sg[2][4];
#pragma unroll
  for (int j = 0; j < 2; ++j)
#pragma unroll
    for (int i = 0; i < 4; ++i) sg[j][i] = *(const u32x4*)(SG + goff + (size_t)i * 8192 + j * 64);
  LAS unsigned char* wb = stg + q * 256; const int wt = ((q & 15) ^ hi) << 4;
  const LAS unsigned char* rb = stg + rr * 256; const int rt = ((2 * pc) ^ rr) << 4;
#pragma unroll
  for (int j = 0; j < 2; ++j) {
    const float lt = l[j] + __shfl_xor(l[j], 32); const float inv = 1.0f / lt;
#pragma unroll
    for (int dt = 0; dt < 2; ++dt)
#pragma unroll
      for (int a = 0; a < 4; ++a) {
        f32x4 v; v.x = O[j][dt][4 * a + 0] * inv; v.y = O[j][dt][4 * a + 1] * inv; v.z = O[j][dt][4 * a + 2] * inv; v.w = O[j][dt][4 * a + 3] * inv;
        *(LAS f32x4*)(wb + (wt ^ ((8 * dt + 2 * a) << 4))) = v;
      }
    asm volatile("" ::: "memory");
#pragma unroll
    for (int i = 0; i < 4; ++i) {
      const int x0 = rt ^ ((i & 1) << 7);
      const f32x4 a0 = *(const LAS f32x4*)(rb + i * 2048 + x0), a1 = *(const LAS f32x4*)(rb + i * 2048 + (x0 ^ 16));
      const u32x4 g = sg[j][i]; u32x4 w;
      w.x = cvtpk(a0.x * bflo(g.x), a0.y * bfhi(g.x)); w.y = cvtpk(a0.z * bflo(g.y), a0.w * bfhi(g.y));
      w.z = cvtpk(a1.x * bflo(g.z), a1.y * bfhi(g.z)); w.w = cvtpk(a1.z * bflo(g.w), a1.w * bfhi(g.w));
      *(u32x4*)(OG + goff + (size_t)i * 8192 + j * 64) = w;
    }
    asm volatile("" ::: "memory");
  }
}
DI void build_btab(LAS unsigned char* lds, const float* rel_bias, int tid_) {
  LAS float* bt = (LAS float*)(lds + L_BTAB);
  for (int i = tid_; i < 16 * 192; i += 512) { const int h = i / 192, dist = i % 192 - 31;
    bt[i] = dist < 0 ? -INFINITY : (dist < 128 ? (rel_bias[(int)BKT[dist] * 16 + h] - rel_bias[31 * 16 + h]) * LOG2E : 0.f); }
}
DI unsigned causal16(int q, int hi) { unsigned m = 0;
#pragma unroll
  for (int r = 0; r < 16; ++r) m |= (kidx(r, hi) <= q) ? (1u << r) : 0u;
  return m; }

DI void dsa_unit(LAS unsigned char* lds, const Ptrs& P, int b, int qt, int wave_) {
  int tid = wave_ * 64 + lane_id_hw(); asm volatile("" : "+v"(tid));
  const int lane = tid & 63, w = __builtin_amdgcn_readfirstlane(tid >> 6), q = lane & 31, hi = lane >> 5;
  const int t0 = 32 * qt, nkt = qt + 1; const size_t rowb = (size_t)b * SEQ;
  LAS unsigned short* maskl = (LAS unsigned short*)(lds + L_MASK);
  bf16x8 qf[2][4];
#pragma unroll
  for (int j = 0; j < 2; ++j)
#pragma unroll
    for (int s = 0; s < 4; ++s) qf[j][s] = *(const bf16x8*)(P.Q + (rowb + t0 + q) * 1024 + (2 * w + j) * 64 + 16 * s + 8 * hi);
  __syncthreads();
  if (qt >= 8) {
    const bf16* ikb = P.IK + (size_t)(b * 64) * 2048 + lane * 8;
    bf16x8 ikc[4], ikn[4];
#pragma unroll
    for (int s = 0; s < 4; ++s) ikc[s] = *(const bf16x8*)(ikb + (size_t)w * 2048 + 512 * s);
    LAS float* wl = (LAS float*)(lds + L_HIST);
    { f32x4 wv = {0.f, 0.f, 0.f, 0.f}; if (tid < 64) wv = *(const f32x4*)(P.IW + (rowb + t0) * 8 + tid * 4);
      const int row = tid >> 4, ch = tid & 15; const u32x4* src = (const u32x4*)(P.IQ + (rowb + t0 + row) * 512);
#pragma unroll
      for (int c = 0; c < 4; ++c) *(LAS u32x4*)(lds + L_IQ + row * IQ_STRIDE + (ch + 16 * c) * 16) = __builtin_nontemporal_load(src + ch + 16 * c);
      if (tid < 64) *(LAS f32x4*)(wl + tid * 4) = wv; }
    __syncthreads();
    unsigned pl[4][16];
#pragma unroll
    for (int B = 0; B < 4; ++B) {
#pragma unroll
      for (int h2 = 0; h2 < 2; ++h2) {
        const int kt = w + 8 * (2 * B + h2);
        if (2 * B + h2 < 7) { const int ktn = (kt + 8 < nkt) ? kt + 8 : w;
#pragma unroll
          for (int s = 0; s < 4; ++s) ikn[s] = *(const bf16x8*)(ikb + (size_t)ktn * 2048 + 512 * s); }
        float sc[16];
        if (2 * B + h2 == 0 || kt < nkt) {
#pragma unroll
          for (int s = 0; s < 4; ++s) asm volatile("" : "+v"(ikc[s]));
#pragma unroll
          for (int r = 0; r < 16; ++r) sc[r] = 0.f;
#pragma unroll 2
          for (int hd = 0; hd < 8; ++hd) {
            f32x16 c;
#pragma unroll
            for (int r = 0; r < 16; ++r) c[r] = 0.f;
#pragma unroll
            for (int s = 0; s < 4; ++s) { const bf16x8 bq = *(const LAS bf16x8*)(lds + L_IQ + q * IQ_STRIDE + (hd * 64 + 16 * s + 8 * hi) * 2); c = MFMA32(ikc[s], bq, c); }
            const float wh = wl[q * 8 + hd];
#pragma unroll
            for (int r = 0; r < 16; ++r) { const int ci_ = __builtin_bit_cast(int, (float)c[r]); sc[r] += wh * __builtin_bit_cast(float, ci_ > 0 ? ci_ : 0); asm("" : "+v"(sc[r])); }
          }
          if (kt == qt) {
#pragma unroll
            for (int r = 0; r < 16; ++r) if (kidx(r, hi) > q) sc[r] = -INFINITY;
          }
        } else {
#pragma unroll
          for (int r = 0; r < 16; ++r) sc[r] = -INFINITY;
        }
#pragma unroll
        for (int v = 0; v < 16; ++v) {
          if (h2 == 0) pl[B][v] = __builtin_bit_cast(unsigned, __builtin_amdgcn_cvt_pkrtz(sc[v], 0.f));
          else pl[B][v] |= __builtin_bit_cast(unsigned, __builtin_amdgcn_cvt_pkrtz(0.f, sc[v]));
        }
#pragma unroll
        for (int s = 0; s < 4; ++s) ikc[s] = ikn[s];
      }
#pragma unroll
      for (int v = 0; v < 16; ++v) { const unsigned u = pl[B][v]; pl[B][v] = u ^ (((u >> 15) & 0x00010001u) * 0x7FFFu); }
#define TR_STAGE(J, MJ) _Pragma("unroll") for (int k = 0; k < 16; ++k) if ((k & (J)) == 0) { const unsigned t = ((pl[B][k] >> (J)) ^ pl[B][k + (J)]) & (MJ); pl[B][k + (J)] ^= t; pl[B][k] ^= t << (J); }
      TR_STAGE(8, 0x00FF00FFu) TR_STAGE(4, 0x0F0F0F0Fu) TR_STAGE(2, 0x33333333u) TR_STAGE(1, 0x55555555u)
#undef TR_STAGE
      pl[B][15] = ~pl[B][15];
#pragma unroll
      for (int v = 0; v < 16; ++v) asm volatile("" : "+v"(pl[B][v]));
      __builtin_amdgcn_sched_barrier(0);
    }
    LAS unsigned* cb = (LAS unsigned*)(lds + L_HIST + 32 * 257 * 4);
    if (tid < 64) cb[tid] = 0u;
    __syncthreads();
    unsigned mm[4] = {0xFFFFFFFFu, 0xFFFFFFFFu, 0xFFFFFFFFu, 0xFFFFFFFFu}, gt[4] = {0u, 0u, 0u, 0u}, Gtot = 0u, prev0 = 0u, prev1 = 0u;
#pragma unroll
    for (int bit = 15; bit >= 0; --bit) {
      unsigned t4[4]; unsigned cnt = 0u;
#pragma unroll
      for (int B = 0; B < 4; ++B) { t4[B] = mm[B] & pl[B][bit]; cnt += (unsigned)__builtin_popcount(t4[B]); }
      LAS unsigned* cw = cb + ((bit & 1) ? 32 : 0) + q;
      __hip_atomic_fetch_add(cw, cnt, __ATOMIC_RELAXED, __HIP_MEMORY_SCOPE_WORKGROUP);
      __syncthreads();
      const unsigned run = *cw; unsigned tot;
      if (bit & 1) { tot = run - prev1; prev1 = run; } else { tot = run - prev0; prev0 = run; }
      const bool acc1 = (Gtot + tot) >= 256u;
#pragma unroll
      for (int B = 0; B < 4; ++B) { if (acc1) mm[B] = t4[B]; else { gt[B] |= t4[B]; mm[B] ^= t4[B]; } }
      if (!acc1) Gtot += tot;
    }
    LAS unsigned short* tm = (LAS unsigned short*)(lds + L_HIST + 1024); LAS unsigned short* pf = (LAS unsigned short*)(lds + L_HIST + 1024 + 8192);
#pragma unroll
    for (int B = 0; B < 4; ++B) {
      tm[((w + 8 * (2 * B)) * 32 + q) * 2 + hi] = (unsigned short)(mm[B] & 0xFFFFu);
      tm[((w + 8 * (2 * B + 1)) * 32 + q) * 2 + hi] = (unsigned short)(mm[B] >> 16);
    }
    __syncthreads();
#pragma unroll
    for (int e = 0; e < 4; ++e) {
      const int qq = 4 * w + e;
      const unsigned c = (unsigned)__builtin_popcount(((const LAS unsigned*)tm)[lane * 32 + qq]);
      unsigned incl = c;
#pragma unroll
      for (int o = 1; o < 64; o <<= 1) { const unsigned t = __shfl_up(incl, o); if (lane >= o) incl += t; }
      pf[lane * 32 + qq] = (unsigned short)(incl - c);
    }
    __syncthreads();
    { const unsigned need = 256u - Gtot;
#pragma unroll
      for (int B = 0; B < 4; ++B) {
        unsigned sel = gt[B];
#pragma unroll
        for (int h2 = 0; h2 < 2; ++h2) {
          const unsigned t16 = (mm[B] >> (16 * h2)) & 0xFFFFu;
          if (t16) {
            const int kt = w + 8 * (2 * B + h2);
            const unsigned pair = ((const LAS unsigned*)tm)[kt * 32 + q], base = pf[kt * 32 + q];
            const unsigned c0 = (unsigned)__builtin_popcount(pair & 0xFFu), c1 = (unsigned)__builtin_popcount(pair & 0xFF0000u), c2 = (unsigned)__builtin_popcount(pair & 0xFF00u);
            const unsigned offL = base + (hi ? c0 : 0u), offH = base + (hi ? c0 + c1 + c2 : c0 + c1);
            unsigned rem = t16;
            while (rem) { const int pos = __builtin_ctz(rem); rem &= rem - 1u;
              const unsigned below = (unsigned)__builtin_popcount(t16 & ((1u << pos) - 1u) & (pos >= 8 ? 0xFF00u : 0xFFu));
              if ((pos >= 8 ? offH : offL) + below < need) sel |= 1u << (pos + 16 * h2); }
          }
        }
        if (w + 8 * (2 * B) < nkt) maskl[(w + 8 * (2 * B)) * 64 + lane] = (unsigned short)(sel & 0xFFFFu);
        if (w + 8 * (2 * B + 1) < nkt) maskl[(w + 8 * (2 * B + 1)) * 64 + lane] = (unsigned short)(sel >> 16);
      } }
  } else {
    const unsigned cm = causal16(q, hi);
#pragma unroll
    for (int i = 0; i < 8; ++i) { const int kt = w + 8 * i; if (kt < nkt) maskl[kt * 64 + lane] = (unsigned short)(kt == qt ? cm : 0xFFFFu); }
  }
  __syncthreads();
  const int g = w >> 1;
  const bf16* img = P.KV + (size_t)(b * 64) * 16384;
  const unsigned lds0 = (unsigned)(uintptr_t)lds;
#pragma unroll
  for (int j = 0; j < 2; ++j)
#pragma unroll
    for (int s = 0; s < 4; ++s) asm volatile("" : "+v"(qf[j][s]));
  f32x16 O[2][2]; float l[2] = {0.f, 0.f};
#pragma unroll
  for (int j = 0; j < 2; ++j)
#pragma unroll
    for (int dt = 0; dt < 2; ++dt)
#pragma unroll
      for (int r = 0; r < 16; ++r) O[j][dt][r] = 0.f;
  const LAS float* bt0 = (const LAS float*)(lds + L_BTAB) + (2 * w) * 192;
  LAS unsigned char* ringp = lds + 65536 + w * 8192;
  const char* ksrc = (const char*)img + g * 4096; const unsigned voff = (unsigned)lane * 16u;
  const unsigned kring = lds0 + (unsigned)w * 8192u; const LAS unsigned char* kl = lds + w * 8192 + lane * 16;
#define TSRC(t_) (ksrc + (size_t)((t_) < nkt ? (t_) : nkt - 1) * 32768)
  bf16x8 vA[4], vB[4]; f32x16 cA[2], cB[2];
  k_dma(TSRC(0), voff, kring); v_load(vA, TSRC(0) + 16384, voff); k_dma(TSRC(1), voff, kring + 4096u);
  kv_wait(vA);
  qk_tile(cA, kl, qf);
#pragma unroll 1
  for (int kt = 0; ; kt += 2) {
    k_dma(TSRC(kt + 2), voff, kring); v_load(vB, TSRC(kt + 1) + 16384, voff);
    if (qt - kt <= 4) add_bias(cA, bt0, (t0 + q) - (32 * kt + 8 * hi));
    { const unsigned m16 = maskl[kt * 64 + lane];
      qk_tile(cB, kl + 4096, qf); sm_pv<0>(O, l, cA, vA, m16); }
    kv_wait(vB);
    if (kt + 1 >= nkt) break;
    k_dma(TSRC(kt + 3), voff, kring + 4096u); v_load(vA, TSRC(kt + 2) + 16384, voff);
    if (qt - (kt + 1) <= 4) add_bias(cB, bt0, (t0 + q) - (32 * (kt + 1) + 8 * hi));
    { const unsigned m16 = maskl[(kt + 1) * 64 + lane];
      qk_tile(cA, kl, qf); sm_pv<0>(O, l, cB, vB, m16); }
    kv_wait(vA);
    if (kt + 2 >= nkt) break;
  }
#undef TSRC
  { int tid2 = lane_id_hw(); asm volatile("" : "+v"(tid2)); const int lane2 = tid2 & 63;
    attn_store(O, l, P.SG, P.OG, rowb + t0, 2 * w, ringp, lane2); }
}

DI void moba_unit(LAS unsigned char* lds, const Ptrs& P, int b, int qt, int wave_) {
  int tid = wave_ * 64 + lane_id_hw(); asm volatile("" : "+v"(tid));
  const int lane = tid & 63, w = __builtin_amdgcn_readfirstlane(tid >> 6), q = lane & 31, hi = lane >> 5;
  const int t0 = 32 * qt, ob = qt >> 3; const size_t rowb = (size_t)b * SEQ;
  LAS unsigned char* selm = lds + L_SELM; LAS unsigned* blkw = (LAS unsigned*)(lds + L_BLK);
  bf16x8 qf[2][4];
#pragma unroll
  for (int j = 0; j < 2; ++j)
#pragma unroll
    for (int s = 0; s < 4; ++s) qf[j][s] = *(const bf16x8*)(P.Q + (rowb + t0 + q) * 1024 + (2 * w + j) * 64 + 16 * s + 8 * hi);
  __syncthreads();
  if (tid == 0) blkw[0] = 0u;
  __syncthreads();
  if (ob > 0) {
    const int qq = tid & 31, gg = (tid >> 5) & 3, part = tid >> 7;
    float gs[7];
#pragma unroll
    for (int n = 0; n < 7; ++n) gs[n] = 0.f;
    const bf16* qp = P.Q + (rowb + t0 + qq) * 1024 + gg * 256 + part * 16;
#pragma unroll
    for (int c = 0; c < 2; ++c) {
      float qs[8];
#pragma unroll
      for (int e = 0; e < 8; ++e) qs[e] = 0.f;
#pragma unroll
      for (int j = 0; j < 4; ++j) { const u32x4 v = *(const u32x4*)(qp + j * 64 + c * 8);
        qs[0] += bflo(v.x); qs[1] += bfhi(v.x); qs[2] += bflo(v.y); qs[3] += bfhi(v.y); qs[4] += bflo(v.z); qs[5] += bfhi(v.z); qs[6] += bflo(v.w); qs[7] += bfhi(v.w); }
#pragma unroll
      for (int n = 0; n < 7; ++n) if (n < ob) { const f32x4* km = (const f32x4*)(P.KM + ((size_t)(b * 4 + gg) * 8 + n) * 64 + part * 16 + c * 8); const f32x4 k0 = km[0], k1 = km[1];
        gs[n] += (qs[0] * k0.x + qs[1] * k0.y + qs[2] * k0.z + qs[3] * k0.w) + (qs[4] * k1.x + qs[5] * k1.y + qs[6] * k1.z + qs[7] * k1.w); }
    }
    LAS float* gp = (LAS float*)lds + (size_t)(part * 128 + gg * 32 + qq) * 8;
#pragma unroll
    for (int n = 0; n < 7; ++n) gp[n] = gs[n];
  }
  __syncthreads();
  if (tid < 128) {
    const int qq = tid & 31, gg = tid >> 5; unsigned sel = 0;
    if (ob > 0) {
      float gs[7]; const LAS float* gp = (const LAS float*)lds + (size_t)(gg * 32 + qq) * 8;
#pragma unroll
      for (int n = 0; n < 7; ++n) gs[n] = (n < ob) ? ((gp[n] + gp[1024 + n]) + (gp[2048 + n] + gp[3072 + n])) : -INFINITY;
#pragma unroll
      for (int n = 0; n < 7; ++n) { if (n < ob) { int rank = 0;
#pragma unroll
          for (int m = 0; m < 7; ++m) if (m != n && m < ob) rank += ((gs[m] > gs[n]) || (gs[m] == gs[n] && m < n)) ? 1 : 0;
          if (rank < 3) sel |= 1u << n; } }
    }
    selm[gg * 32 + qq] = (unsigned char)sel;
    if (sel) __hip_atomic_fetch_or(blkw, sel, __ATOMIC_RELAXED, __HIP_MEMORY_SCOPE_WORKGROUP);
  }
  __syncthreads();
  const int g = w >> 1;
  const unsigned mysel = selm[g * 32 + q];
  const unsigned blk = (unsigned)__builtin_amdgcn_readfirstlane(blkw[0]) | (1u << ob);
  const bf16* img = P.KV + (size_t)(b * 64) * 16384;
  const unsigned lds0 = (unsigned)(uintptr_t)lds;
#pragma unroll
  for (int j = 0; j < 2; ++j)
#pragma unroll
    for (int s = 0; s < 4; ++s) asm volatile("" : "+v"(qf[j][s]));
  f32x16 O[2][2]; float l[2] = {0.f, 0.f};
#pragma unroll
  for (int j = 0; j < 2; ++j)
#pragma unroll
    for (int dt = 0; dt < 2; ++dt)
#pragma unroll
      for (int r = 0; r < 16; ++r) O[j][dt][r] = 0.f;
  const LAS float* bt0 = (const LAS float*)(lds + L_BTAB) + (2 * w) * 192;
#define NEXT_TILE(kt_, out_) do { int kn_ = (kt_) + 1; if (kn_ > qt) kn_ = -1; else if (((blk >> (kn_ >> 3)) & 1u) == 0u) kn_ = 8 * ((kn_ >> 3) + __builtin_ctz(blk >> (kn_ >> 3))); (out_) = kn_; } while (0)
  LAS unsigned char* ringp = lds + 65536 + w * 8192;
  const char* ksrc = (const char*)img + g * 4096; const unsigned voff = (unsigned)lane * 16u;
  const unsigned kring = lds0 + (unsigned)w * 8192u; const LAS unsigned char* kl = lds + w * 8192 + lane * 16;
  int ta = 8 * __builtin_ctz(blk), tb, tc, td;
  NEXT_TILE(ta, tb); tc = -1; if (tb >= 0) NEXT_TILE(tb, tc);
  const int tfirst = ta;
#define TSRC(t_) (ksrc + (size_t)((t_) >= 0 ? (t_) : tfirst) * 32768)
#define MOBA_SM(C, VF, KT) do { const int n_ = (KT) >> 3; const unsigned lm_ = (n_ < ob) ? (0u - ((mysel >> n_) & 1u)) : 0xFFFFFFFFu; sm_pv<1>(O, l, C, VF, lm_); } while (0)
  bf16x8 vA[4], vB[4]; f32x16 cA[2], cB[2];
  k_dma(TSRC(ta), voff, kring); v_load(vA, TSRC(ta) + 16384, voff); k_dma(TSRC(tb), voff, kring + 4096u);
  kv_wait(vA);
  qk_tile(cA, kl, qf);
#pragma unroll 1
  while (true) {
    k_dma(TSRC(tc), voff, kring); v_load(vB, TSRC(tb) + 16384, voff);
    if (qt - ta <= 4) add_bias(cA, bt0, (t0 + q) - (32 * ta + 8 * hi));
    qk_tile(cB, kl + 4096, qf); MOBA_SM(cA, vA, ta);
    kv_wait(vB);
    if (tb < 0) break;
    td = -1; if (tc >= 0) NEXT_TILE(tc, td);
    k_dma(TSRC(td), voff, kring + 4096u); v_load(vA, TSRC(tc) + 16384, voff);
    if (qt - tb <= 4) add_bias(cB, bt0, (t0 + q) - (32 * tb + 8 * hi));
    qk_tile(cA, kl, qf); MOBA_SM(cB, vB, tb);
    kv_wait(vA);
    if (tc < 0) break;
    ta = tc; tb = td; tc = -1; if (tb >= 0) NEXT_TILE(tb, tc);
  }
#undef MOBA_SM
#undef TSRC
#undef NEXT_TILE
  { int tid2 = lane_id_hw(); asm volatile("" : "+v"(tid2)); const int lane2 = tid2 & 63;
    attn_store(O, l, P.SG, P.OG, rowb + t0, 2 * w, ringp, lane2); }
}

__global__ void __launch_bounds__(512, 2) fwd(Args args) {
  extern __shared__ __attribute__((aligned(16))) unsigned char lds_raw[];
  LAS unsigned char* lds = (LAS unsigned char*)lds_raw;
  const int wave = __builtin_amdgcn_readfirstlane((int)threadIdx.x >> 6);
#define FRESH_TID(t_) int t_ = wave * 64 + lane_id_hw(); asm volatile("" : "+v"(t_))
  const int G = gridDim.x, bx = blockIdx.x;
  const int vcu = (G % 8 == 0) ? (bx % 8) * (G / 8) + bx / 8 : bx;
  LAS unsigned long long* ptab = (LAS unsigned long long*)(lds + L_MISC + 64);
  { FRESH_TID(tid0);
    if (tid0 < 16) { const unsigned long long* ka = (const unsigned long long*)__builtin_amdgcn_kernarg_segment_ptr(); ptab[tid0] = ka[tid0]; ((LAS unsigned*)(lds + L_MISC))[tid0] = 0u; }
    __syncthreads(); }
#define TABPTR(k) ((unsigned char*)(__attribute__((address_space(1))) unsigned char*)(((unsigned long long)(unsigned)__builtin_amdgcn_readfirstlane((int)(ptab[(k)] >> 32)) << 32) | (unsigned long long)(unsigned)__builtin_amdgcn_readfirstlane((int)(unsigned)ptab[(k)])))
#define LOAD_PTRS() Ptrs P; { asm volatile("" ::: "memory"); unsigned char* ws = TABPTR(15); \
  P.x = (const float*)TABPTR(0); P.norm_a_g = (const float*)TABPTR(1); P.w_in_a = (const float*)TABPTR(2); P.qn_a_g = (const float*)TABPTR(3); P.kn_a_g = (const float*)TABPTR(4); P.w_out_a = (const float*)TABPTR(5); P.rel_bias = (const float*)TABPTR(6); \
  P.norm_kv_g = (const float*)TABPTR(7); P.w_kv = (const float*)TABPTR(8); P.kn_b_g = (const float*)TABPTR(9); P.norm_b_g = (const float*)TABPTR(10); P.w_in_b = (const float*)TABPTR(11); P.qn_b_g = (const float*)TABPTR(12); P.w_out_b = (const float*)TABPTR(13); \
  P.out = (float*)TABPTR(14); \
  P.WtA = (bf16*)(ws + WS_WA); P.WtOA = (bf16*)(ws + WS_WOA); P.WtB = (bf16*)(ws + WS_WB); P.WtOB = (bf16*)(ws + WS_WOB); \
  P.XN = (bf16*)(ws + WS_XN); P.Q = (bf16*)(ws + WS_Q); P.KV = (bf16*)(ws + WS_K); P.SG = (bf16*)(ws + WS_SG); \
  P.IQ = (bf16*)(ws + WS_IQ); P.IK = (bf16*)(ws + WS_IK); P.OG = (bf16*)(ws + WS_OG); \
  P.IW = (float*)(ws + WS_IW); P.KM = (float*)(ws + WS_KM); P.RINV = (float*)(ws + WS_KM + 524288); P.SSQ = (float*)(ws + WS_H1); }
  const int lo = args.ph_lo, hi = args.ph_hi;
#ifndef PH_MASK
#define PH_MASK 0x1ff
#endif
#ifndef REP_MASK
#define REP_MASK 0
#endif
#define IN(k) (((PH_MASK >> (k)) & 1) && lo <= (k) && (k) < hi)
#define NREP(k) ((((REP_MASK) >> (k)) & 1) ? 2 : 1)
#if MK_N_LAUNCHES == 1
  const bool grouped = (G == 256);
  XcdBarrier xbar = xcd_barrier_post((unsigned*)TABPTR(15), (volatile LAS unsigned*)(lds + L_MISC), wave == 0 && lane_id_hw() == 0, (unsigned)G);
  XcdBarrier xbarL = xcd_barrier_post((unsigned*)(TABPTR(15) + 16384 * (1 + (bx & 7))), (volatile LAS unsigned*)(lds + L_MISC) + 2, wave == 0 && lane_id_hw() == 0, (unsigned)(G / 8));
#define SEAM(k) do { if (IN(k) && (hi > (k) + 1)) { if ((k) == 0 || !grouped) xcd_barrier(xbar, wave == 0 && lane_id_hw() == 0); else xcd_barrier(xbarL, wave == 0 && lane_id_hw() == 0); } } while (0)
#else
#define SEAM(k) do { } while (0)
#endif
  const int gw = vcu * 8 + wave, NGW = G * 8;

  if (IN(0)) {
    LOAD_PTRS();
    FRESH_TID(tid); const int lane = tid & 63;
    LAS float* scr = (LAS float*)(lds + wave * 8448);
    constexpr int I_A = 16 * (NCOL_A / 32), I_O = 16 * 32, I_KV = 16 * 16, I_B = 16 * 64;
    constexpr int NITEMS = I_A + I_O + I_KV + I_B + I_O;
#define P0_ITEM(it_) do { int r = (it_); \
      if (r < I_A) { trans_item(P.w_in_a, 3144, P.norm_a_g, P.WtA, r, NCOL_A / 32, 1, scr, lane); break; } r -= I_A; \
      if (r < I_O) { trans_item(P.w_out_a, 1024, nullptr, P.WtOA, r, 32, 0, scr, lane); break; } r -= I_O; \
      if (r < I_KV) { trans_item(P.w_kv, 512, P.norm_kv_g, P.WtB, r, 16, 0, scr, lane); break; } r -= I_KV; \
      if (r < I_B) { trans_item(P.w_in_b, 2048, P.norm_b_g, P.WtB + (size_t)512 * 1024, r, 64, 0, scr, lane); break; } r -= I_B; \
      trans_item(P.w_out_b, 1024, nullptr, P.WtOB, r, 32, 0, scr, lane); } while (0)
    int itw = gw;
    for (int m = gw; m < MTOK; m += 4 * NGW) {
      f32x4 v[4][4]; float ss[4];
#pragma unroll
      for (int u = 0; u < 4; ++u) { const int mm = m + u * NGW; const f32x4* xr = (const f32x4*)(P.x + (size_t)(mm < MTOK ? mm : m) * 1024) + lane;
#pragma unroll
        for (int j = 0; j < 4; ++j) v[u][j] = __builtin_nontemporal_load(xr + 64 * j); }
      if (itw < NITEMS) { P0_ITEM(itw); itw += NGW; }
#pragma unroll
      for (int u = 0; u < 4; ++u) { float a = 0.f;
#pragma unroll
        for (int j = 0; j < 4; ++j) a += (v[u][j].x * v[u][j].x + v[u][j].y * v[u][j].y) + (v[u][j].z * v[u][j].z + v[u][j].w * v[u][j].w);
        ss[u] = a; }
#pragma unroll
      for (int o = 1; o < 64; o <<= 1) {
#pragma unroll
        for (int u = 0; u < 4; ++u) ss[u] += __shfl_xor(ss[u], o); }
#pragma unroll
      for (int u = 0; u < 4; ++u) { const int mm = m + u * NGW; if (mm < MTOK) {
          u32x2* o8 = (u32x2*)(P.XN + (size_t)mm * 1024) + lane;
#pragma unroll
          for (int j = 0; j < 4; ++j) { u32x2 w; w.x = cvtpk(v[u][j].x, v[u][j].y); w.y = cvtpk(v[u][j].z, v[u][j].w); o8[64 * j] = w; }
          if (lane == 0) P.RINV[mm] = rsqrtf(ss[u] * (1.0f / 1024.0f) + EPS); } }
    }
    for (; itw < NITEMS; itw += NGW) P0_ITEM(itw);
#undef P0_ITEM
    for (int i = gw * 64 + lane; i < NBATCH * 4 * 8 * 64; i += NGW * 64) P.KM[i] = 0.f;
    __syncthreads();
  }
  SEAM(0);
  if (IN(1)) for (int rep_ = 0; rep_ < NREP(1); ++rep_) {
    LOAD_PTRS();
    pg8::Gemm g{P.XN, P.WtA, MTOK, NCOL_A, 1024}; OrderR S; S.init(MTOK, NCOL_A, G, bx); S.rv = P.RINV; S.ldsb = (unsigned)(uintptr_t)(lds + L_EPI); S.wv = wave; S.k = 0;
    EpiA E{P.Q, P.KV, P.SG, P.IQ, P.IK, P.IW, P.qn_a_g, P.kn_a_g, (const LAS float*)(lds + L_EPI), 0};
    pg8::gemm_phase<EpiA, OrderR, true, true>(lds, g, S, E, wave);
    __syncthreads();
  }
  SEAM(1);
  if (IN(2)) for (int rep_ = 0; rep_ < NREP(2); ++rep_) {
    LOAD_PTRS();
    { FRESH_TID(tidb); build_btab(lds, P.rel_bias, tidb); }
#pragma unroll 1
    for (int i = 0; ; ++i) { int b, qt;
      if (G == 256) { if (i >= 4) break; const int c = vcu & 31; b = 2 * (vcu >> 5) + (i >> 1); qt = (i & 1) ? c : 63 - c; }
      else { const int u = vcu + i * G; if (u >= 1024) break; b = u >> 6; qt = 63 - (u & 63); }
      dsa_unit(lds, P, b, qt, wave); }
    __syncthreads();
  }
  SEAM(2);
  if (IN(3)) for (int rep_ = 0; rep_ < NREP(3); ++rep_) {
    LOAD_PTRS();
    pg8::Gemm g{P.OG, P.WtOA, MTOK, 1024, 1024}; pg8::StaticOrder S; S.init(MTOK, 1024, G, bx);
    EpiRes2 E{P.XN, P.SSQ, (LAS float*)(lds + L_EPI)};
    pg8::gemm_phase<EpiRes2, pg8::StaticOrder, true, true>(lds, g, S, E, wave);
    __syncthreads();
  }
  SEAM(3);
  if (IN(5)) for (int rep_ = 0; rep_ < NREP(5); ++rep_) {
    LOAD_PTRS();
    pg8::Gemm g{P.XN, P.WtB, MTOK, NCOL_B, 1024}; OrderS S; S.init(MTOK, NCOL_B, G, bx); S.sv = P.SSQ; S.ldsb = (unsigned)(uintptr_t)(lds + L_EPI); S.wv = wave; S.k = 0;
    EpiB E{P.Q, P.KV, P.SG, P.qn_b_g, P.kn_b_g, (const LAS f32x4*)(lds + L_EPI), P.KM, 0};
    pg8::gemm_phase<EpiB, OrderS, true, true>(lds, g, S, E, wave);
    __syncthreads();
  }
  SEAM(5);
  if (IN(7)) for (int rep_ = 0; rep_ < NREP(7); ++rep_) {
    LOAD_PTRS();
    { FRESH_TID(tidb); build_btab(lds, P.rel_bias, tidb); }
#pragma unroll 1
    for (int i = 0; ; ++i) { int b, qt;
      if (G == 256) { if (i >= 4) break; const int c = vcu & 31; b = 2 * (vcu >> 5) + (i >> 1); qt = (i & 1) ? c : 63 - c; }
      else { const int u = vcu + i * G; if (u >= 1024) break; b = u >> 6; qt = 63 - (u & 63); }
      moba_unit(lds, P, b, qt, wave); }
    __syncthreads();
  }
  SEAM(7);
  if (IN(8)) for (int rep_ = 0; rep_ < NREP(8); ++rep_) {
    LOAD_PTRS();
    pg8::Gemm g{P.OG, P.WtOB, MTOK, 1024, 1024}; pg8::StaticOrder S; S.init(MTOK, 1024, G, bx);
    EpiRes E{P.XN, P.out, lds + L_EPI};
    pg8::gemm_phase<EpiRes, pg8::StaticOrder, true, true>(lds, g, S, E, wave);
  }
#undef IN
#undef SEAM
}

extern "C" void kernel_launch(void* const* d_in, const int* in_sizes, int n_in, void* d_out, int out_size, void* d_ws, size_t ws_size, hipStream_t stream) {
  static int grid = 0;
  if (grid == 0) {
    if (n_in != 14 || out_size != MTOK * DM || ws_size < WS_END) { fprintf(stderr, "kernel_launch: unexpected problem (n_in %d, out %d, ws %zu)\n", n_in, out_size, ws_size); grid = -1; return; }
    int dev = 0, cus = 0, per_cu = 0;
    if (hipGetDevice(&dev) != hipSuccess || hipDeviceGetAttribute(&cus, hipDeviceAttributeMultiprocessorCount, dev) != hipSuccess) { grid = -1; return; }
    if (hipFuncSetAttribute((const void*)fwd, hipFuncAttributeMaxDynamicSharedMemorySize, LDS_BYTES) != hipSuccess) { fprintf(stderr, "kernel_launch: hipFuncSetAttribute failed\n"); grid = -1; return; }
    if (hipOccupancyMaxActiveBlocksPerMultiprocessor(&per_cu, (const void*)fwd, 512, LDS_BYTES) != hipSuccess || per_cu < 1) { fprintf(stderr, "kernel_launch: occupancy query says %d\n", per_cu); per_cu = 1; }
    (void)hipGetLastError();
    grid = cus;
  }
  if (grid < 0) return;
  Args a{};
  for (int i = 0; i < 14; ++i) a.in[i] = (const float*)d_in[i];
  a.out = (float*)d_out; a.ws = (unsigned char*)d_ws;
#if MK_N_LAUNCHES == 1
  if (hipMemsetAsync(d_ws, 0, 16384 * 9, stream) != hipSuccess) { fprintf(stderr, "kernel_launch: memset of the barrier words failed\n"); return; }
  a.ph_lo = 0; a.ph_hi = NPHASE;
  void* kargs[] = {&a};
  hipError_t e = hipLaunchCooperativeKernel((const void*)fwd, dim3(grid), dim3(512), kargs, LDS_BYTES, stream);
  if (e != hipSuccess) fprintf(stderr, "kernel_launch: cooperative launch failed: %s\n", hipGetErrorString(e));
#else
#ifndef HOST_REP_MASK
#define HOST_REP_MASK 0
#endif
  for (int p = 0; p < NPHASE; ++p) { a.ph_lo = p; a.ph_hi = p + 1; for (int r = 0; r < (((HOST_REP_MASK >> p) & 1) ? 2 : 1); ++r) hipLaunchKernelGGL(fwd, dim3(grid), dim3(512), LDS_BYTES, stream, a); }
#endif
}
```

```cpp
#include <hip/hip_runtime.h>
#include <hip/hip_cooperative_groups.h>
#include <cstdio>
#include <cstdint>
__device__ __forceinline__ int lane_id_hw() { unsigned z = 0u; asm volatile("" : "+v"(z)); return (int)__builtin_amdgcn_mbcnt_hi(~0u, __builtin_amdgcn_mbcnt_lo(~0u, z)); }
namespace pg8 {
#define PG8_LAS __attribute__((address_space(3)))
typedef unsigned short bf16_t;
typedef short bf16x8 __attribute__((ext_vector_type(8)));
typedef float f32x4 __attribute__((ext_vector_type(4)));
typedef unsigned u32x4 __attribute__((ext_vector_type(4)));
constexpr int BM = 256, BK = 64, HALF = 128, HTB = HALF * BK * 2  , STAGE_BYTES = 8 * HTB, NXCD = 8, WGM = 8;

__host__ __device__ __forceinline__ int lds_byte(int r, int c) { const int st = (r >> 4) * 2 + (c >> 5), rr = r & 15, cc = c & 31, ob = rr * 64 + cc * 2; return st * 1024 + (ob ^ (((ob >> 9) & 1) << 5)); }
__host__ __device__ __forceinline__ void stage_rc(int b, int& R, int& C) { const int st = b / 1024, sb = b % 1024, swz = sb ^ (((sb >> 9) & 1) << 5); R = (st >> 1) * 16 + swz / 64; C = (st & 1) * 32 + (swz % 64) / 2; }
__host__ __device__ __forceinline__ int perm32(int rho) { const int n = rho >> 4, i = rho & 15; return 8 * (i >> 2) + 4 * n + (i & 3); }

struct Unit { int pm, pn; };
struct Gemm { const bf16_t* A; const bf16_t* Bt; int M, N, K; };

struct StaticOrder {
    int nM, nN, nwg, G, c;
    __host__ __device__ void init(int M, int N, int G_, int c_) { nM = M / BM; nN = N / BM; nwg = nM * nN; G = G_; c = c_; }
    __host__ __device__ bool next(int i, Unit& u) const {
        const long L = (long)i * G + c; if (L >= nwg) return false;
        int wgid = (int)L; { const int q = nwg / NXCD, r = nwg % NXCD, xcd = wgid % NXCD, off = wgid / NXCD; wgid = (xcd < r ? xcd * (q + 1) : r * (q + 1) + (xcd - r) * q) + off; }
        const int nig = WGM * nN, gid = wgid / nig, fm = gid * WGM, gsz = (nM - fm) < WGM ? (nM - fm) : WGM;
        u.pm = fm + ((wgid % nig) % gsz); u.pn = (wgid % nig) / gsz; return true;
    }
    __device__ __forceinline__ void a_ready(const Unit&) const {}
    __device__ __forceinline__ void done(const Unit&) const {}
};

template <class Epi, class Sched, bool ALIGN_EPI = false, bool SP2 = false>
__device__ __forceinline__ void gemm_phase(PG8_LAS unsigned char* lds, const Gemm g, const Sched& S, const Epi& E, int wave_) {
    const int tid = wave_ * 64 + lane_id_hw(), wid = __builtin_amdgcn_readfirstlane(tid >> 6), lane = tid & 63, wr = wid >> 2, wc = wid & 3, fr = lane & 15, fq = lane >> 4;
    const int K = g.K, nt = K / BK;
    unsigned voffA[2], voffB[2];
#pragma unroll
    for (int i = 0; i < 2; ++i) { int R, C; stage_rc(tid * 16 + i * 8192, R, C); const int Rb = Epi::PERM ? ((R & ~31) + perm32(R & 31)) : R;
        voffA[i] = (unsigned)(R * K + C) * 2u; voffB[i] = (unsigned)(Rb * K + C) * 2u; }
    const size_t kstep = (size_t)(BK * 2);
    const size_t hstep = (size_t)HALF * K * 2;
    const size_t tstep = 2 * hstep;
    const unsigned ldsw = (unsigned)wid * 1024u;
    const int aoff = lds_byte(wr * 64 + fr, fq * 8), boff = lds_byte(wc * 32 + fr, fq * 8);
#define PG8_SA(b, h) (((b) * 2 + (h)) * HTB)
#define PG8_SB(b, h) ((4 + (b) * 2 + (h)) * HTB)
#define PG8_STAGE(bufoff, gbase, voff) do { _Pragma("unroll") for (int _i = 0; _i < 2; ++_i) \
        __builtin_amdgcn_global_load_lds((const unsigned*)((const char*)(gbase) + (voff)[_i]), (PG8_LAS unsigned*)(lds + (bufoff) + ldsw + _i * 8192), 16, 0, 0); } while (0)
#define PG8_LDA(dst, b, h) do { _Pragma("unroll") for (int m = 0; m < 4; ++m) _Pragma("unroll") for (int k = 0; k < 2; ++k) dst[m][k] = *(const PG8_LAS bf16x8*)(lds + PG8_SA(b, h) + aoff + m * 2048 + k * 1024); } while (0)
#define PG8_LDB(dst, b, h) do { _Pragma("unroll") for (int n = 0; n < 2; ++n) _Pragma("unroll") for (int k = 0; k < 2; ++k) dst[n][k] = *(const PG8_LAS bf16x8*)(lds + PG8_SB(b, h) + boff + n * 2048 + k * 1024); } while (0)
#define PG8_MMA(ai, bj, At, Bt) do { __builtin_amdgcn_s_setprio(1); _Pragma("unroll") for (int m = 0; m < 4; ++m) _Pragma("unroll") for (int n = 0; n < 2; ++n) _Pragma("unroll") for (int k = 0; k < 2; ++k) \
        acc[ai][bj][m][n] = __builtin_amdgcn_mfma_f32_16x16x32_bf16(Bt[n][k], At[m][k], acc[ai][bj][m][n], 0, 0, 0); __builtin_amdgcn_s_setprio(0); } while (0)
#define PG8_WAIT_V(n) asm volatile("s_waitcnt vmcnt(" #n ")" ::: "memory")
#define PG8_WAIT_L(n) asm volatile("s_waitcnt lgkmcnt(" #n ")" ::: "memory")
#define PG8_BAR __builtin_amdgcn_s_barrier()
#define PG8_SCHED __builtin_amdgcn_sched_barrier(0)
    Unit cur, nxt; int ui = 0;
    if (!S.next(0, cur)) return;
    f32x4 acc[2][2][4][2];
#pragma unroll
    for (int a = 0; a < 2; ++a)
#pragma unroll
        for (int b = 0; b < 2; ++b)
#pragma unroll
            for (int m = 0; m < 4; ++m)
#pragma unroll
                for (int n = 0; n < 2; ++n) acc[a][b][m][n] = (f32x4){0.f, 0.f, 0.f, 0.f};
    bf16x8 At[4][2], B0[2][2], B1[2][2];
    const char* cA = (const char*)g.A + (size_t)cur.pm * tstep; const char* cB = (const char*)g.Bt + (size_t)cur.pn * tstep;
    S.a_ready(cur);
    if constexpr (SP2) {
        PG8_STAGE(PG8_SB(0, 0), cB, voffB); PG8_STAGE(PG8_SB(0, 1), cB + hstep, voffB); PG8_STAGE(PG8_SA(0, 0), cA, voffA); PG8_STAGE(PG8_SA(0, 1), cA + hstep, voffA);
        if (wr == 1) PG8_BAR;
        PG8_WAIT_V(2); PG8_BAR;
        PG8_STAGE(PG8_SB(1, 0), cB + kstep, voffB); PG8_STAGE(PG8_SA(1, 0), cA + kstep, voffA); PG8_STAGE(PG8_SB(1, 1), cB + hstep + kstep, voffB);
        PG8_WAIT_V(6); PG8_BAR;
    } else {
        PG8_STAGE(PG8_SB(0, 0), cB, voffB); PG8_STAGE(PG8_SA(0, 0), cA, voffA); PG8_STAGE(PG8_SB(0, 1), cB + hstep, voffB); PG8_STAGE(PG8_SA(0, 1), cA + hstep, voffA);
        if (wr == 1) PG8_BAR;
        PG8_WAIT_V(4); PG8_BAR;
        PG8_STAGE(PG8_SB(1, 0), cB + kstep, voffB); PG8_STAGE(PG8_SA(1, 0), cA + kstep, voffA); PG8_STAGE(PG8_SB(1, 1), cB + hstep + kstep, voffB);
        PG8_WAIT_V(6); PG8_BAR;
    }
    for (;;) {
        const bool has_next = S.next(ui + 1, nxt);
        const char* nA = has_next ? (const char*)g.A + (size_t)nxt.pm * tstep : cA; const char* nB = has_next ? (const char*)g.Bt + (size_t)nxt.pn * tstep : cB;
        for (int t = 0; t < nt; t += 2) {
            const bool last = (t == nt - 2);
            const char* a1 = cA + (size_t)(t + 1) * kstep;
            const char* a2 = last ? nA : cA + (size_t)(t + 2) * kstep; const char* b2 = last ? nB : cB + (size_t)(t + 2) * kstep;
            const char* a3 = a2 + kstep; const char* b3 = b2 + kstep;
            if (last && has_next) S.a_ready(nxt);
            if constexpr (SP2) {
            PG8_LDB(B0, 0, 0); PG8_LDB(B1, 0, 1); PG8_SCHED; PG8_LDA(At, 0, 0); PG8_STAGE(PG8_SA(1, 1), a1 + hstep, voffA);
            PG8_WAIT_V(8); PG8_WAIT_L(0); PG8_BAR; PG8_MMA(0, 0, At, B0); PG8_MMA(0, 1, At, B1); PG8_BAR; PG8_SCHED;
            PG8_LDA(At, 0, 1); PG8_STAGE(PG8_SB(0, 0), b2, voffB); PG8_STAGE(PG8_SB(0, 1), b2 + hstep, voffB); PG8_STAGE(PG8_SA(0, 0), a2, voffA);
            PG8_WAIT_V(8); PG8_WAIT_L(0); PG8_BAR; PG8_MMA(1, 0, At, B0); PG8_MMA(1, 1, At, B1); PG8_BAR; PG8_SCHED;
            PG8_LDB(B0, 1, 0); PG8_LDB(B1, 1, 1); PG8_SCHED; PG8_LDA(At, 1, 0); PG8_STAGE(PG8_SA(0, 1), a2 + hstep, voffA);
            PG8_WAIT_V(8); PG8_WAIT_L(0); PG8_BAR; PG8_MMA(0, 0, At, B0); PG8_MMA(0, 1, At, B1); PG8_BAR; PG8_SCHED;
            PG8_LDA(At, 1, 1); PG8_STAGE(PG8_SB(1, 0), b3, voffB); PG8_STAGE(PG8_SB(1, 1), b3 + hstep, voffB); PG8_STAGE(PG8_SA(1, 0), a3, voffA);
            PG8_WAIT_V(8); PG8_WAIT_L(0); PG8_BAR; PG8_MMA(1, 0, At, B0); PG8_MMA(1, 1, At, B1); PG8_BAR; PG8_SCHED;
            } else {
            PG8_LDB(B0, 0, 0); PG8_SCHED; PG8_LDA(At, 0, 0); PG8_STAGE(PG8_SA(1, 1), a1 + hstep, voffA);
            PG8_WAIT_L(8); PG8_BAR; PG8_WAIT_L(0); PG8_MMA(0, 0, At, B0); PG8_BAR; PG8_SCHED;
            PG8_LDB(B1, 0, 1); PG8_STAGE(PG8_SB(0, 0), b2, voffB);
            PG8_BAR; PG8_WAIT_L(0); PG8_MMA(0, 1, At, B1); PG8_BAR;
            PG8_LDA(At, 0, 1); PG8_STAGE(PG8_SA(0, 0), a2, voffA);
            PG8_BAR; PG8_WAIT_L(0); PG8_MMA(1, 0, At, B0); PG8_BAR; PG8_SCHED;
            PG8_STAGE(PG8_SB(0, 1), b2 + hstep, voffB);
            PG8_WAIT_V(6); PG8_BAR; PG8_MMA(1, 1, At, B1); PG8_BAR;
            PG8_LDB(B0, 1, 0); PG8_SCHED; PG8_LDA(At, 1, 0); PG8_STAGE(PG8_SA(0, 1), a2 + hstep, voffA);
            PG8_WAIT_L(8); PG8_BAR; PG8_WAIT_L(0); PG8_MMA(0, 0, At, B0); PG8_BAR; PG8_SCHED;
            PG8_LDB(B1, 1, 1); PG8_STAGE(PG8_SB(1, 0), b3, voffB);
            PG8_BAR; PG8_WAIT_L(0); PG8_MMA(0, 1, At, B1); PG8_BAR;
            PG8_LDA(At, 1, 1); PG8_STAGE(PG8_SA(1, 0), a3, voffA);
            PG8_BAR; PG8_WAIT_L(0); PG8_MMA(1, 0, At, B0); PG8_BAR; PG8_SCHED;
            PG8_STAGE(PG8_SB(1, 1), b3 + hstep, voffB);
            PG8_WAIT_V(6); PG8_BAR; PG8_MMA(1, 1, At, B1); PG8_BAR;
            }
        }
        if constexpr (ALIGN_EPI) { if (wr == 0) PG8_BAR; }
        if constexpr (!Epi::AFTER_DRAIN) { E(acc, cur, wr, wc, fr, fq); S.done(cur); }
        if (!has_next) break;
#pragma unroll
        for (int a = 0; a < 2; ++a)
#pragma unroll
            for (int b = 0; b < 2; ++b)
#pragma unroll
                for (int m = 0; m < 4; ++m)
#pragma unroll
                    for (int n = 0; n < 2; ++n) acc[a][b][m][n] = (f32x4){0.f, 0.f, 0.f, 0.f};
        cur = nxt; cA = nA; cB = nB; ++ui;
        if constexpr (ALIGN_EPI) { if (wr == 1) PG8_BAR; }
    }
    PG8_WAIT_V(0);
    if constexpr (!ALIGN_EPI) { if (wr == 0) PG8_BAR; }
    PG8_BAR;
    if constexpr (Epi::AFTER_DRAIN) { E.fused(acc, cur, wr, wc, fr, fq, lds, wid, lane); S.done(cur); }
#undef PG8_SA
#undef PG8_SB
#undef PG8_STAGE
#undef PG8_LDA
#undef PG8_LDB
#undef PG8_MMA
#undef PG8_WAIT_V
#undef PG8_WAIT_L
#undef PG8_BAR
#undef PG8_SCHED
}
}

#ifndef MK_N_LAUNCHES
#define MK_N_LAUNCHES 1
#endif
namespace cg = cooperative_groups;
#define DI __device__ __forceinline__
#define LAS __attribute__((address_space(3)))
typedef unsigned short bf16;
typedef short bf16x8 __attribute__((ext_vector_type(8)));
typedef float f32x4 __attribute__((ext_vector_type(4)));
typedef float f32x16 __attribute__((ext_vector_type(16)));
typedef unsigned u32x4 __attribute__((ext_vector_type(4)));
typedef unsigned u32x2 __attribute__((ext_vector_type(2)));
typedef float f32x2_t __attribute__((ext_vector_type(2)));
typedef __bf16 bf16x2_t __attribute__((ext_vector_type(2)));
typedef short s16x2 __attribute__((ext_vector_type(2)));
typedef unsigned short u16x2 __attribute__((ext_vector_type(2)));

constexpr int SEQ = 2048, DM = 1024, NBATCH = 16, MTOK = NBATCH * SEQ;
constexpr int NCOL_A = 3328, NCOL_B = 2560;
constexpr float EPS = 1e-6f;
constexpr float LOG2E = 1.4426950408889634f;
constexpr float C2 = 0.125f * LOG2E;
constexpr int NPHASE = 9;

constexpr size_t MiB = 1u << 20;
constexpr size_t WS_WA = 1 * MiB, WS_WOA = 8 * MiB, WS_WB = 10 * MiB, WS_WOB = 15 * MiB, WS_KM = 17 * MiB, WS_IW = 18 * MiB, WS_IK = 19 * MiB;
constexpr size_t WS_XN = 24 * MiB, WS_Q = 88 * MiB, WS_K = 152 * MiB, WS_VT = 168 * MiB, WS_SG = 184 * MiB, WS_IQ = 248 * MiB, WS_OG = 280 * MiB, WS_H1 = 344 * MiB, WS_END = 472 * MiB;

constexpr int LDS_BYTES = 153600;
constexpr int IQ_STRIDE = 1040;
constexpr int L_IQ = 0, L_HIST = 33280, L_SEL = 131072, L_MASK = L_SEL + 512, L_BTAB = L_MASK + 8192, L_SELM = L_BTAB + 12288, L_BLK = L_SELM + 128, L_END = L_BLK + 16;
static_assert(L_HIST + 32 * 257 * 4 + 256 <= L_SEL, "selection scratch inside the ring");
constexpr int L_EPI = 131072;
static_assert(L_EPI + 8 * 2304 <= 152320, "epilogue staging");
constexpr int L_MISC = 152320;
static_assert(L_END <= L_MISC && L_MISC + 64 + 128 <= LDS_BYTES && LDS_BYTES <= 163840, "LDS map");

__device__ const unsigned char BKT[128] = {
  0, 1, 2, 3, 4, 5, 6, 7, 8, 9, 10, 11, 12, 13, 14, 15, 16, 16, 16, 17, 17, 18, 18, 18, 19, 19, 19, 20, 20, 20, 20, 21,
  21, 21, 21, 22, 22, 22, 22, 22, 23, 23, 23, 23, 23, 23, 24, 24, 24, 24, 24, 24, 25, 25, 25, 25, 25, 25, 25, 26, 26, 26, 26, 26,
  26, 26, 26, 27, 27, 27, 27, 27, 27, 27, 27, 27, 27, 28, 28, 28, 28, 28, 28, 28, 28, 28, 28, 29, 29, 29, 29, 29, 29, 29, 29, 29,
  29, 29, 29, 30, 30, 30, 30, 30, 30, 30, 30, 30, 30, 30, 30, 30, 30, 31, 31, 31, 31, 31, 31, 31, 31, 31, 31, 31, 31, 31, 31, 31};

struct Args { const float* in[14]; float* out; unsigned char* ws; int ph_lo, ph_hi; };

struct Ptrs {
  const float *x, *norm_a_g, *w_in_a, *qn_a_g, *kn_a_g, *w_out_a, *rel_bias, *norm_kv_g, *w_kv, *kn_b_g, *norm_b_g, *w_in_b, *qn_b_g, *w_out_b;
  float* out;
  bf16 *WtA, *WtOA, *WtB, *WtOB, *XN, *Q, *KV, *SG, *IQ, *IK, *OG;
  float *IW, *KM, *RINV, *SSQ;
};

DI unsigned cvtpk(float lo, float hi) { f32x2_t v = {lo, hi}; bf16x2_t b = __builtin_convertvector(v, bf16x2_t); return __builtin_bit_cast(unsigned, b); }
DI float bflo(unsigned u) { return __uint_as_float(u << 16); }
DI float bfhi(unsigned u) { return __uint_as_float(u & 0xffff0000u); }
DI float wave_sum(float v) {
#pragma unroll
  for (int o = 1; o < 64; o <<= 1) v += __shfl_xor(v, o);
  return v;
}
DI float silu_f(float v) { return v * __builtin_amdgcn_rcpf(1.0f + __expf(-v)); }
#define MFMA32(a, b, c) __builtin_amdgcn_mfma_f32_32x32x16_bf16((a), (b), (c), 0, 0, 0)

#define XB_TMO      128
#define XB_XCNT(j)  (256  + 64 * (j))
#define XB_XSUB(j)  (1280 + 64 * (j))
#define XB_XGEN(j)  (2304 + 64 * (j))
#define XB_TOP      3328
#define XB_TOPGEN   3392
#define XCD_BAR_WORDS 3456
#define XB_SPIN_CAP (1u << 18)

__device__ __forceinline__ unsigned xb_ld(unsigned* p)              { return __hip_atomic_load(p, __ATOMIC_RELAXED, __HIP_MEMORY_SCOPE_AGENT); }
__device__ __forceinline__ unsigned xb_add(unsigned* p, unsigned v) { return __hip_atomic_fetch_add(p, v, __ATOMIC_RELAXED, __HIP_MEMORY_SCOPE_AGENT); }
__device__ __forceinline__ unsigned xb_xcc_id() { return (unsigned)__builtin_amdgcn_s_getreg((3 << 11) | 20) & 0xFu; }
#define XB_SPIN(cond, bar) do { unsigned _sp = 0; while (cond) { __builtin_amdgcn_s_sleep(1); \
    if ((++_sp & 255u) == 0u) { if (xb_ld(&(bar)[XB_TMO])) break; if (_sp > XB_SPIN_CAP) { atomicAdd(&(bar)[XB_TMO], 1u); break; } } } } while (0)

struct XcdBarrier {
    unsigned* bar; unsigned x; unsigned total;
    volatile LAS unsigned* st;
};

__device__ __forceinline__ XcdBarrier xcd_barrier_post(unsigned* bar, volatile LAS unsigned* st, bool lead_, unsigned total_) {
    XcdBarrier b; b.bar = bar; b.x = xb_xcc_id(); b.st = st; b.total = total_;
    if (lead_) (void)xb_add(&bar[XB_XCNT(b.x)], 1u);
    return b;
}
__device__ __forceinline__ void xcd_barrier_complete(unsigned* bar, unsigned x, unsigned& nloc, unsigned& nx, unsigned G) {
    unsigned sum, cnt, mine, sp = 0u;
    for (;;) {
        sum = 0u; cnt = 0u; mine = 0u;
#pragma unroll
        for (unsigned j = 0; j < 16; ++j) { const unsigned c = xb_ld(&bar[XB_XCNT(j)]); sum += c; cnt += (c > 0u) ? 1u : 0u; mine = (j == x) ? c : mine; }
        if (sum == G) break;
        __builtin_amdgcn_s_sleep(1);
        if ((++sp & 255u) == 0u) { if (xb_ld(&bar[XB_TMO])) break; if (sp > XB_SPIN_CAP) { atomicAdd(&bar[XB_TMO], 1u); break; } }
    }
    nloc = mine > 0u ? mine : 1u; nx = cnt > 0u ? cnt : 1u;
}

__device__ __forceinline__ void xcd_barrier(const XcdBarrier& b, bool lead_) {
    asm volatile("s_waitcnt vmcnt(0)" ::: "memory");
    __syncthreads();
    if (lead_) {
        unsigned* bar = b.bar;
        __builtin_amdgcn_s_waitcnt(0);
        unsigned nloc = b.st[0], nx = b.st[1];
        if (nloc == 0u) { xcd_barrier_complete(bar, b.x, nloc, nx, b.total); b.st[0] = nloc; b.st[1] = nx; }
        const unsigned old = xb_add(&bar[XB_XSUB(b.x)], 1u);
        const unsigned gen = old / nloc;
        if (old + 1u == (gen + 1u) * nloc) {
            if (nx > 1u) __builtin_amdgcn_fence(__ATOMIC_RELEASE, "agent");
            else __builtin_amdgcn_fence(__ATOMIC_RELEASE, "workgroup");
            asm volatile("s_waitcnt vmcnt(0)" ::: "memory");
            if (nx > 1u) {
            const unsigned og = xb_add(&bar[XB_TOP], 1u);
            const unsigned tg = og / nx;
            if (og + 1u == (tg + 1u) * nx) xb_add(&bar[XB_TOPGEN], 1u);
            else XB_SPIN(xb_ld(&bar[XB_TOPGEN]) == tg, bar);
            }
            if (nx == 1u) (void)__hip_atomic_fetch_add(&bar[XB_XGEN(b.x)], 1u, __ATOMIC_RELAXED, __HIP_MEMORY_SCOPE_AGENT);
            __builtin_amdgcn_fence(__ATOMIC_ACQUIRE, "agent");
            if (nx > 1u) xb_add(&bar[XB_XGEN(b.x)], 1u);
            asm volatile("s_waitcnt vmcnt(0)" ::: "memory");
        } else {
            XB_SPIN(xb_ld(&bar[XB_XGEN(b.x)]) == gen, bar);
            __builtin_amdgcn_fence(__ATOMIC_ACQUIRE, "agent");
            asm volatile("s_waitcnt vmcnt(0)" ::: "memory");
        }
    }
    __syncthreads();
}

DI int slot_of(int gc) { const int u = gc & 255; return (gc & ~255) + 128 * ((u >> 5) & 1) + 32 * (u >> 6) + 16 * ((u >> 2) & 1) + 4 * ((u >> 3) & 3) + (u & 3); }

typedef pg8::f32x4 accq;
DI int pi32(int r) { return (r & ~12) | ((r & 4) << 1) | ((r & 8) >> 1); }
DI size_t kv_tile_elem(int row) { return (size_t)(row >> 5) * 16384; }
DI bf16* q_piece(bf16* Q, int row, int head, int bj, int fq) {
  return Q + ((size_t)(row >> 5) * 16 + head) * 2048 + (size_t)(((2 * bj + (fq >> 1)) * 64 + (fq & 1) * 32 + (row & 31)) * 8);
}
DI bf16* k_piece(bf16* KV, int row, int g, int bj, int fq) {
  return KV + kv_tile_elem(row) + (size_t)(((g * 4 + 2 * bj + (fq >> 1)) * 64 + (fq & 1) * 32 + pi32(row & 31)) * 8);
}
struct OrderR : pg8::StaticOrder {
  const float* rv; unsigned ldsb; int wv; mutable int k;
  DI void a_ready(const pg8::Unit& u) const {
    if (wv == 0) { const float* src = rv + (size_t)u.pm * 256 + lane_id_hw() * 4; unsigned keep; const unsigned dst = (unsigned)__builtin_amdgcn_readfirstlane((int)(ldsb + (unsigned)(k & 1) * 1024u));
      asm volatile("s_mov_b32 %0, m0\n\ts_mov_b32 m0, %2\n\ts_nop 0\n\tglobal_load_lds_dwordx4 %1, off\n\ts_mov_b32 m0, %0\n\ts_nop 0" : "=&s"(keep) : "v"(src), "s"(dst) : "memory"); }
    ++k;
  }
};
struct OrderS : pg8::StaticOrder {
  const float* sv; unsigned ldsb; int wv; mutable int k;
  DI void a_ready(const pg8::Unit& u) const {
    if (wv == 0) { const char* src = (const char*)(sv + (size_t)u.pm * 1024) + lane_id_hw() * 16; const unsigned dst0 = ldsb + (unsigned)(k & 1) * 4096u;
#pragma unroll
      for (int i = 0; i < 4; ++i) { unsigned keep; const unsigned d_ = (unsigned)__builtin_amdgcn_readfirstlane((int)(dst0 + (unsigned)i * 1024u)); const char* p_ = src + i * 1024;
        asm volatile("s_mov_b32 %0, m0\n\ts_mov_b32 m0, %2\n\ts_nop 0\n\tglobal_load_lds_dwordx4 %1, off\n\ts_mov_b32 m0, %0\n\ts_nop 0" : "=&s"(keep) : "v"(p_), "s"(d_) : "memory"); } }
    ++k;
  }
};
DI void load_gain(float (&gv)[2][2][4], const float* g, int fq, float sc) {
#pragma unroll
  for (int bj = 0; bj < 2; ++bj)
#pragma unroll
    for (int n = 0; n < 2; ++n)
#pragma unroll
      for (int e = 0; e < 4; ++e) gv[bj][n][e] = g[32 * bj + 8 * fq + 4 * n + e] * sc;
}
template <int ACT  > DI void plain_store(const accq (&acc)[2][2][4][2], int ai, int m, float sc, bf16* dst) {
#pragma unroll
  for (int bj = 0; bj < 2; ++bj) {
    float v[8];
#pragma unroll
    for (int n = 0; n < 2; ++n)
#pragma unroll
      for (int e = 0; e < 4; ++e) { float t = acc[ai][bj][m][n][e] * sc; if (ACT == 1) t = silu_f(t); v[4 * n + e] = t; }
    u32x4 w; w.x = cvtpk(v[0], v[1]); w.y = cvtpk(v[2], v[3]); w.z = cvtpk(v[4], v[5]); w.w = cvtpk(v[6], v[7]);
    *(u32x4*)(dst + 32 * bj) = w;
  }
}
DI void v_store_scaled(const accq (&acc)[2][2][4][2], int ai, int m, bf16* KV, int row, int g, int fq, float sc) {
  const int i = row & 31;
  bf16* base = KV + kv_tile_elem(row) + (size_t)((16 + g * 4 + (i >> 4)) * 512 + ((i >> 3) & 1) * 256 + (i & 7));
#pragma unroll
  for (int bj = 0; bj < 2; ++bj)
#pragma unroll
    for (int n = 0; n < 2; ++n)
#pragma unroll
      for (int e = 0; e < 4; e += 2) {
        const unsigned pk = cvtpk(acc[ai][bj][m][n][e] * sc, acc[ai][bj][m][n][e + 1] * sc);
        const int r = 8 * fq + 4 * n + e;
        base[bj * 1024 + r * 8] = (bf16)(pk & 0xffffu); base[bj * 1024 + (r + 1) * 8] = (bf16)(pk >> 16);
      }
}

struct EpiA {
  static constexpr bool PERM = false, AFTER_DRAIN = false;
  bf16 *Q, *KV, *SG, *IQ, *IK; float* IW; const float *qn_g, *kn_g; const LAS float* rl; mutable int k;
  DI void operator()(const accq (&acc)[2][2][4][2], const pg8::Unit& u, int wr, int wc, int fr, int fq) const {
    const int pn = u.pn, row0 = u.pm * 256 + wr * 64 + fr; const LAS float* rinv = rl + (k & 1) * 256 - u.pm * 256; ++k;
    if (pn <= 4) {
      float gv[2][2][4]; load_gain(gv, pn < 4 ? qn_g : kn_g, fq, pn < 4 ? C2 : 1.0f);
#pragma unroll
      for (int ai = 0; ai < 2; ++ai)
#pragma unroll
        for (int m = 0; m < 4; ++m) { const int row = row0 + 128 * ai + 16 * m; const float ri = rinv[row];
          float v[2][2][4]; float ss = 0.f;
#pragma unroll
          for (int bj = 0; bj < 2; ++bj)
#pragma unroll
            for (int n = 0; n < 2; ++n)
#pragma unroll
              for (int e = 0; e < 4; ++e) { v[bj][n][e] = acc[ai][bj][m][n][e] * ri; ss += v[bj][n][e] * v[bj][n][e]; }
          ss += __shfl_xor(ss, 16); ss += __shfl_xor(ss, 32);
          const float rn = rsqrtf(ss * (1.0f / 64.0f) + EPS);
#pragma unroll
          for (int bj = 0; bj < 2; ++bj) {
            u32x4 w; w.x = cvtpk(v[bj][0][0] * rn * gv[bj][0][0], v[bj][0][1] * rn * gv[bj][0][1]); w.y = cvtpk(v[bj][0][2] * rn * gv[bj][0][2], v[bj][0][3] * rn * gv[bj][0][3]);
            w.z = cvtpk(v[bj][1][0] * rn * gv[bj][1][0], v[bj][1][1] * rn * gv[bj][1][1]); w.w = cvtpk(v[bj][1][2] * rn * gv[bj][1][2], v[bj][1][3] * rn * gv[bj][1][3]);
            bf16* dst = pn < 4 ? q_piece(Q, row, 4 * pn + wc, bj, fq) : k_piece(KV, row, wc, bj, fq);
            *(u32x4*)dst = w; } }
    } else if (pn == 5) {
#pragma unroll
      for (int ai = 0; ai < 2; ++ai)
#pragma unroll
        for (int m = 0; m < 4; ++m) { const int row = row0 + 128 * ai + 16 * m; v_store_scaled(acc, ai, m, KV, row, wc, fq, rinv[row]); }
    } else if (pn <= 9) {
#pragma unroll
      for (int ai = 0; ai < 2; ++ai)
#pragma unroll
        for (int m = 0; m < 4; ++m) { const int row = row0 + 128 * ai + 16 * m; plain_store<1>(acc, ai, m, rinv[row], SG + (size_t)row * 1024 + 256 * (pn - 6) + 64 * wc + 8 * fq); }
    } else if (pn <= 11) {
#pragma unroll
      for (int ai = 0; ai < 2; ++ai)
#pragma unroll
        for (int m = 0; m < 4; ++m) { const int row = row0 + 128 * ai + 16 * m; plain_store<0>(acc, ai, m, 0.125f * rinv[row], IQ + (size_t)row * 512 + 256 * (pn - 10) + 64 * wc + 8 * fq); }
    } else {
      if (wc == 0) {
#pragma unroll
        for (int ai = 0; ai < 2; ++ai)
#pragma unroll
          for (int m = 0; m < 4; ++m) { const int row = row0 + 128 * ai + 16 * m; const float sc = rinv[row];
#pragma unroll
            for (int bj = 0; bj < 2; ++bj) { u32x4 w; w.x = cvtpk(acc[ai][bj][m][0][0] * sc, acc[ai][bj][m][0][1] * sc); w.y = cvtpk(acc[ai][bj][m][0][2] * sc, acc[ai][bj][m][0][3] * sc);
              w.z = cvtpk(acc[ai][bj][m][1][0] * sc, acc[ai][bj][m][1][1] * sc); w.w = cvtpk(acc[ai][bj][m][1][2] * sc, acc[ai][bj][m][1][3] * sc);
              *(u32x4*)(IK + (size_t)(row >> 5) * 2048 + (size_t)(((2 * bj + (fq >> 1)) * 64 + (fq & 1) * 32 + pi32(row & 31)) * 8)) = w; } }
      } else if (wc == 1 && fq == 0) {
#pragma unroll
        for (int ai = 0; ai < 2; ++ai)
#pragma unroll
          for (int m = 0; m < 4; ++m) { const int row = row0 + 128 * ai + 16 * m; float* d = IW + (size_t)row * 8; const float sc = 0.35355339059327373f * rinv[row];
            *(f32x4*)d = acc[ai][0][m][0] * sc; *(f32x4*)(d + 4) = acc[ai][0][m][1] * sc; }
      }
    }
  }
};
struct EpiB {
  static constexpr bool PERM = false, AFTER_DRAIN = false;
  bf16 *Q, *KV, *SG; const float *qn_g, *kn_g; const LAS f32x4* rl; float* KM; mutable int k;
  DI void operator()(const accq (&acc)[2][2][4][2], const pg8::Unit& u, int wr, int wc, int fr, int fq) const {
    const int pn = u.pn, row0 = u.pm * 256 + wr * 64 + fr; const LAS f32x4* s4 = rl + (k & 1) * 256 - u.pm * 256; ++k;
#define RINV2(row_) ({ const f32x4 p_ = s4[(row_)]; rsqrtf(((p_.x + p_.y) + (p_.z + p_.w)) * (1.0f / 1024.0f) + EPS); })
    if (pn == 0 || (pn >= 2 && pn <= 5)) {
      float gv[2][2][4]; load_gain(gv, pn == 0 ? kn_g : qn_g, fq, pn == 0 ? 1.0f : C2);
      float cs[2][2][4];
#pragma unroll
      for (int bj = 0; bj < 2; ++bj)
#pragma unroll
        for (int n = 0; n < 2; ++n)
#pragma unroll
          for (int e = 0; e < 4; ++e) cs[bj][n][e] = 0.f;
#pragma unroll
      for (int ai = 0; ai < 2; ++ai)
#pragma unroll
        for (int m = 0; m < 4; ++m) { const int row = row0 + 128 * ai + 16 * m; const float ri = RINV2(row);
          float v[2][2][4]; float ss = 0.f;
#pragma unroll
          for (int bj = 0; bj < 2; ++bj)
#pragma unroll
            for (int n = 0; n < 2; ++n)
#pragma unroll
              for (int e = 0; e < 4; ++e) { v[bj][n][e] = acc[ai][bj][m][n][e] * ri; ss += v[bj][n][e] * v[bj][n][e]; }
          ss += __shfl_xor(ss, 16); ss += __shfl_xor(ss, 32);
          const float rn = rsqrtf(ss * (1.0f / 64.0f) + EPS);
#pragma unroll
          for (int bj = 0; bj < 2; ++bj) {
#pragma unroll
            for (int n = 0; n < 2; ++n)
#pragma unroll
              for (int e = 0; e < 4; ++e) { v[bj][n][e] = v[bj][n][e] * rn * gv[bj][n][e]; cs[bj][n][e] += v[bj][n][e]; }
            u32x4 w; w.x = cvtpk(v[bj][0][0], v[bj][0][1]); w.y = cvtpk(v[bj][0][2], v[bj][0][3]); w.z = cvtpk(v[bj][1][0], v[bj][1][1]); w.w = cvtpk(v[bj][1][2], v[bj][1][3]);
            bf16* dst = pn != 0 ? q_piece(Q, row, 4 * (pn - 2) + wc, bj, fq) : k_piece(KV, row, wc, bj, fq);
            *(u32x4*)dst = w; } }
      if (pn == 0) {
        LAS float* kp = (LAS float*)rl + 2048 + wc * 64 + 8 * fq;
        float tt[2][2][4];
#pragma unroll
        for (int bj = 0; bj < 2; ++bj)
#pragma unroll
          for (int n = 0; n < 2; ++n)
#pragma unroll
            for (int e = 0; e < 4; ++e) { float t = cs[bj][n][e]; t += __shfl_xor(t, 1); t += __shfl_xor(t, 2); t += __shfl_xor(t, 4); t += __shfl_xor(t, 8); tt[bj][n][e] = t;
              if (fr == 0 && wr == 1) kp[32 * bj + 4 * n + e] = t; }
        asm volatile("s_waitcnt lgkmcnt(0)" ::: "memory"); __builtin_amdgcn_s_barrier();
        if (fr == 0 && wr == 0) { float* km = KM + ((size_t)((u.pm >> 3) * 4 + wc) * 8 + (u.pm & 7)) * 64 + 8 * fq;
#pragma unroll
          for (int bj = 0; bj < 2; ++bj)
#pragma unroll
            for (int n = 0; n < 2; ++n)
#pragma unroll
              for (int e = 0; e < 4; ++e) km[32 * bj + 4 * n + e] = (tt[bj][n][e] + kp[32 * bj + 4 * n + e]) * (1.0f / 256.0f); }
      }
    } else if (pn == 1) {
#pragma unroll
      for (int ai = 0; ai < 2; ++ai)
#pragma unroll
        for (int m = 0; m < 4; ++m) { const int row = row0 + 128 * ai + 16 * m; const float ri = RINV2(row);
          v_store_scaled(acc, ai, m, KV, row, wc, fq, ri); }
    } else {
#pragma unroll
      for (int ai = 0; ai < 2; ++ai)
#pragma unroll
        for (int m = 0; m < 4; ++m) { const int row = row0 + 128 * ai + 16 * m; plain_store<1>(acc, ai, m, RINV2(row), SG + (size_t)row * 1024 + 256 * (pn - 6) + 64 * wc + 8 * fq); }
    }
  }
};
DI void unpack8(const u32x4 w, float (&f)[8]) { f[0] = bflo(w.x); f[1] = bfhi(w.x); f[2] = bflo(w.y); f[3] = bfhi(w.y); f[4] = bflo(w.z); f[5] = bfhi(w.z); f[6] = bflo(w.w); f[7] = bfhi(w.w); }
struct EpiRes {
  static constexpr bool PERM = false, AFTER_DRAIN = false;
  const bf16* res; float* out; LAS unsigned char* stg0;
  DI void operator()(const accq (&acc)[2][2][4][2], const pg8::Unit& u, int wr, int wc, int fr, int fq) const {
    const int row0 = u.pm * 256 + wr * 64 + fr, col0 = u.pn * 256 + 64 * wc + 8 * fq; LAS unsigned char* stg = stg0 + (wr * 4 + wc) * 2304; const int lane = fq * 16 + fr, r8 = lane >> 3, p8 = lane & 7;
    u32x4 rv[2][4][2];
#pragma unroll
    for (int ai = 0; ai < 2; ++ai)
#pragma unroll
      for (int m = 0; m < 4; ++m)
#pragma unroll
        for (int bj = 0; bj < 2; ++bj) rv[ai][m][bj] = *(const u32x4*)(res + (size_t)(row0 + 128 * ai + 16 * m) * 1024 + col0 + 32 * bj);
#pragma unroll
    for (int ai = 0; ai < 2; ++ai)
#pragma unroll
      for (int m = 0; m < 4; ++m) {
#pragma unroll
        for (int bj = 0; bj < 2; ++bj) { float f[8]; unpack8(rv[ai][m][bj], f);
          f32x4 o0 = acc[ai][bj][m][0], o1 = acc[ai][bj][m][1];
          o0.x += f[0]; o0.y += f[1]; o0.z += f[2]; o0.w += f[3]; o1.x += f[4]; o1.y += f[5]; o1.z += f[6]; o1.w += f[7];
          *(LAS f32x4*)(stg + fr * 144 + fq * 32) = o0; *(LAS f32x4*)(stg + fr * 144 + fq * 32 + 16) = o1;
          asm volatile("" ::: "memory");
          const f32x4 a = *(const LAS f32x4*)(stg + r8 * 144 + p8 * 16), b = *(const LAS f32x4*)(stg + (r8 + 8) * 144 + p8 * 16);
          float* ob = out + (size_t)(row0 - fr + 128 * ai + 16 * m) * 1024 + u.pn * 256 + 64 * wc + 32 * bj + 4 * p8;
          __builtin_nontemporal_store(a, (f32x4*)(ob + (size_t)r8 * 1024)); __builtin_nontemporal_store(b, (f32x4*)(ob + (size_t)(r8 + 8) * 1024));
          asm volatile("" ::: "memory"); } }
  }
};
struct EpiRes2 {
  static constexpr bool PERM = false, AFTER_DRAIN = false;
  bf16* xh; float* ssq4; LAS float* part;
  DI void operator()(const accq (&acc)[2][2][4][2], const pg8::Unit& u, int wr, int wc, int fr, int fq) const {
    const int row0 = u.pm * 256 + wr * 64 + fr, col0 = u.pn * 256 + 64 * wc + 8 * fq;
    u32x4 xv[2][4][2];
#pragma unroll
    for (int ai = 0; ai < 2; ++ai)
#pragma unroll
      for (int m = 0; m < 4; ++m)
#pragma unroll
        for (int bj = 0; bj < 2; ++bj) xv[ai][m][bj] = *(const u32x4*)(xh + (size_t)(row0 + 128 * ai + 16 * m) * 1024 + col0 + 32 * bj);
#pragma unroll
    for (int ai = 0; ai < 2; ++ai)
#pragma unroll
      for (int m = 0; m < 4; ++m) { const int row = row0 + 128 * ai + 16 * m; const size_t off = (size_t)row * 1024 + col0; float ss = 0.f;
#pragma unroll
        for (int bj = 0; bj < 2; ++bj) { float f[8]; unpack8(xv[ai][m][bj], f);
#pragma unroll
          for (int n = 0; n < 2; ++n)
#pragma unroll
            for (int e = 0; e < 4; ++e) { f[4 * n + e] += acc[ai][bj][m][n][e]; ss += f[4 * n + e] * f[4 * n + e]; }
          u32x4 w; w.x = cvtpk(f[0], f[1]); w.y = cvtpk(f[2], f[3]); w.z = cvtpk(f[4], f[5]); w.w = cvtpk(f[6], f[7]);
          *(u32x4*)(xh + off + 32 * bj) = w; }
        ss += __shfl_xor(ss, 16); ss += __shfl_xor(ss, 32);
        if (fq == 0) part[wc * 256 + (row - u.pm * 256)] = ss; }
    asm volatile("s_waitcnt lgkmcnt(0)" ::: "memory"); __builtin_amdgcn_s_barrier();
    const int t = (wr * 4 + wc) * 64 + fq * 16 + fr;
    if (t < 256) ssq4[(size_t)(u.pm * 256 + t) * 4 + u.pn] = (part[t] + part[256 + t]) + (part[512 + t] + part[768 + t]);
  }
};
DI int srccol_A(int gc) { if (gc < 3072) return gc; if (gc < 3136) return 3080 + (gc - 3072); if (gc < 3144) return 3072 + (gc - 3136); return -1; }
DI void trans_item(const float* W, int Ns, const float* gk, bf16* Wt, int item, int nblk, int kindA, LAS float* scr, int lane) {
  const int kb = item / nblk, nb = item % nblk, k0 = 64 * kb, gc0 = 32 * nb;
  const int n = lane & 31, gc = gc0 + n; const int sc = kindA ? srccol_A(gc) : gc;
  const int c = lane & 7;
  float v[32];
  const float* wp = W + (size_t)(k0 + (lane >> 5)) * Ns + (sc >= 0 ? sc : 0);
#pragma unroll
  for (int i = 0; i < 32; ++i) v[i] = __builtin_nontemporal_load(wp + (size_t)(2 * i) * Ns);
  f32x4 g0 = {1.f, 1.f, 1.f, 1.f}, g1 = {1.f, 1.f, 1.f, 1.f};
  if (gk) { g0 = *(const f32x4*)(gk + k0 + 8 * c); g1 = *(const f32x4*)(gk + k0 + 8 * c + 4); }
#pragma unroll
  for (int i = 0; i < 32; ++i) scr[(2 * i + (lane >> 5)) * 33 + n] = sc >= 0 ? v[i] : 0.f;
  asm volatile("s_waitcnt lgkmcnt(0)" ::: "memory");
#pragma unroll
  for (int j = 0; j < 4; ++j) { const int nn = (lane >> 3) + 8 * j; const LAS float* s = scr + (8 * c) * 33 + nn;
    u32x4 o; o.x = cvtpk(s[0 * 33] * g0.x, s[1 * 33] * g0.y); o.y = cvtpk(s[2 * 33] * g0.z, s[3 * 33] * g0.w); o.z = cvtpk(s[4 * 33] * g1.x, s[5 * 33] * g1.y); o.w = cvtpk(s[6 * 33] * g1.z, s[7 * 33] * g1.w);
    *(u32x4*)(Wt + (size_t)slot_of(gc0 + nn) * 1024 + k0 + 8 * c) = o; }
  asm volatile("s_waitcnt lgkmcnt(0)" ::: "memory");
}

DI int kidx(int r, int hi) { return 16 * (r >> 3) + 8 * hi + (r & 7); }
DI void k_dma(const char* ksrc  , unsigned voff  , unsigned lds_slot  ) {
  unsigned keep;
  asm volatile("s_waitcnt lgkmcnt(0)\n\ts_mov_b32 %0, m0\n\ts_mov_b32 m0, %3\n\ts_nop 0\n\t"
               "global_load_lds_dwordx4 %1, %2\n\tglobal_load_lds_dwordx4 %1, %2 offset:1024\n\tglobal_load_lds_dwordx4 %1, %2 offset:2048\n\tglobal_load_lds_dwordx4 %1, %2 offset:3072\n\t"
               "s_mov_b32 m0, %0" : "=&s"(keep) : "v"(voff), "s"(ksrc), "s"(lds_slot) : "memory");
}
DI void v_load(bf16x8 (&vf)[4], const char* vsrc  , unsigned voff) {
  asm volatile("global_load_dwordx4 %0, %4, %5\n\tglobal_load_dwordx4 %1, %4, %5 offset:1024\n\tglobal_load_dwordx4 %2, %4, %5 offset:2048\n\tglobal_load_dwordx4 %3, %4, %5 offset:3072"
               : "=&v"(vf[0]), "=&v"(vf[1]), "=&v"(vf[2]), "=&v"(vf[3]) : "v"(voff), "s"(vsrc) : "memory");
}
DI void kv_wait(bf16x8 (&vf)[4]) { asm volatile("s_waitcnt vmcnt(0)" : "+v"(vf[0]), "+v"(vf[1]), "+v"(vf[2]), "+v"(vf[3]) :: "memory"); }
DI void qk_tile(f32x16 (&c)[2], const LAS unsigned char* kslot  , const bf16x8 (&qf)[2][4]) {
  bf16x8 kf[4];
#pragma unroll
  for (int s = 0; s < 4; ++s) kf[s] = *(const LAS bf16x8*)(kslot + s * 1024);
#pragma unroll
  for (int j = 0; j < 2; ++j) {
    f32x16 z;
#pragma unroll
    for (int r = 0; r < 16; ++r) z[r] = 0.f;
    c[j] = MFMA32(kf[0], qf[j][0], z);
#pragma unroll
    for (int s = 1; s < 4; ++s) c[j] = MFMA32(kf[s], qf[j][s], c[j]);
  }
}
DI void add_bias(f32x16 (&c)[2], const LAS float* bt0, int dist0) {
#pragma unroll
  for (int j = 0; j < 2; ++j) { const LAS float* tp = bt0 + j * 192 + (dist0 + 8);
#pragma unroll
    for (int r = 0; r < 16; ++r) c[j][r] += tp[23 - (16 * (r >> 3) + (r & 7))]; }
}
template <int MODE> DI void sm_pv(f32x16 (&O)[2][2], float (&l)[2], const f32x16 (&c)[2], const bf16x8 (&vf4)[4], unsigned m) {
#pragma unroll
  for (int j = 0; j < 2; ++j) {
    float p[16]; float ls = 0.f;
#pragma unroll
    for (int r = 0; r < 16; ++r) {
      const float e = __builtin_amdgcn_exp2f(c[j][r]);
      if (MODE == 0) { const unsigned ext = (unsigned)__builtin_amdgcn_sbfe((int)m, r, 1); p[r] = __uint_as_float(__float_as_uint(e) & ext); }
      else p[r] = e;
      ls += p[r];
    }
    if (MODE == 1) ls = __uint_as_float(__float_as_uint(ls) & m);
    l[j] += ls;
    bf16x8 pk[2];
#pragma unroll
    for (int s = 0; s < 2; ++s) { u32x4 w; w.x = cvtpk(p[8 * s], p[8 * s + 1]); w.y = cvtpk(p[8 * s + 2], p[8 * s + 3]); w.z = cvtpk(p[8 * s + 4], p[8 * s + 5]); w.w = cvtpk(p[8 * s + 6], p[8 * s + 7]);
      if (MODE == 1) { w.x &= m; w.y &= m; w.z &= m; w.w &= m; }
      pk[s] = __builtin_bit_cast(bf16x8, w); }
#pragma unroll
    for (int dt = 0; dt < 2; ++dt)
#pragma unroll
      for (int s = 0; s < 2; ++s) O[j][dt] = MFMA32(vf4[dt * 2 + s], pk[s], O[j][dt]);
  }
}
DI void attn_store(const f32x16 (&O)[2][2], const float (&l)[2], const bf16* SG, bf16* OG, size_t row0, int head0, LAS unsigned char* stg, int lane) {
  const int q = lane & 31, hi = lane >> 5, rr = lane >> 3, pc = lane & 7;
  const size_t goff = (row0 + rr) * 1024 + (size_t)head0 * 64 + 8 * pc;
  u32x4 sg[2][4];
#pragma unroll
  for (int j = 0; j < 2; ++j)
#pragma unroll
    for (int i = 0; i < 4; ++i) sg[j][i] = *(const u32x4*)(SG + goff + (size_t)i * 8192 + j * 64);
  LAS unsigned char* wb = stg + q * 256; const int wt = ((q & 15) ^ hi) << 4;
  const LAS unsigned char* rb = stg + rr * 256; const int rt = ((2 * pc) ^ rr) << 4;
#pragma unroll
  for (int j = 0; j < 2; ++j) {
    const float lt = l[j] + __shfl_xor(l[j], 32); const float inv = 1.0f / lt;
#pragma unroll
    for (int dt = 0; dt < 2; ++dt)
#pragma unroll
      for (int a = 0; a < 4; ++a) {
        f32x4 v; v.x = O[j][dt][4 * a + 0] * inv; v.y = O[j][dt][4 * a + 1] * inv; v.z = O[j][dt][4 * a + 2] * inv; v.w = O[j][dt][4 * a + 3] * inv;
        *(LAS f32x4*)(wb + (wt ^ ((8 * dt + 2 * a) << 4))) = v;
      }
    asm volatile("" ::: "memory");
#pragma unroll
    for (int i = 0; i < 4; ++i) {
      const int x0 = rt ^ ((i & 1) << 7);
      const f32x4 a0 = *(const LAS f32x4*)(rb + i * 2048 + x0), a1 = *(const LAS f32x4*)(rb + i * 2048 + (x0 ^ 16));
      const u32x4 g = sg[j][i]; u32x4 w;
      w.x = cvtpk(a0.x * bflo(g.x), a0.y * bfhi(g.x)); w.y = cvtpk(a0.z * bflo(g.y), a0.w * bfhi(g.y));
      w.z = cvtpk(a1.x * bflo(g.z), a1.y * bfhi(g.z)); w.w = cvtpk(a1.z * bflo(g.w), a1.w * bfhi(g.w));
      *(u32x4*)(OG + goff + (size_t)i * 8192 + j * 64) = w;
    }
    asm volatile("" ::: "memory");
  }
}
DI void build_btab(LAS unsigned char* lds, const float* rel_bias, int tid_) {
  LAS float* bt = (LAS float*)(lds + L_BTAB);
  int bk[6]; float vb[6], vf[6];
#pragma unroll
  for (int k = 0; k < 6; ++k) { const int i = tid_ + 512 * k, dist = i % 192 - 31; bk[k] = (int)BKT[dist < 0 ? 0 : (dist > 127 ? 127 : dist)]; }
#pragma unroll
  for (int k = 0; k < 6; ++k) { const int i = tid_ + 512 * k, h = i / 192; vb[k] = rel_bias[bk[k] * 16 + h]; vf[k] = rel_bias[31 * 16 + h]; }
#pragma unroll
  for (int k = 0; k < 6; ++k) { const int i = tid_ + 512 * k, dist = i % 192 - 31; bt[i] = dist < 0 ? -INFINITY : (dist < 128 ? (vb[k] - vf[k]) * LOG2E : 0.f); }
}
DI unsigned causal16(int q, int hi) { unsigned m = 0;
#pragma unroll
  for (int r = 0; r < 16; ++r) m |= (kidx(r, hi) <= q) ? (1u << r) : 0u;
  return m; }

DI void dsa_unit(LAS unsigned char* lds, const Ptrs& P, int b, int qt, int wave_) {
  int tid = wave_ * 64 + lane_id_hw(); asm volatile("" : "+v"(tid));
  const int lane = tid & 63, w = __builtin_amdgcn_readfirstlane(tid >> 6), q = lane & 31, hi = lane >> 5;
  const int t0 = 32 * qt, nkt = qt + 1; const size_t rowb = (size_t)b * SEQ;
  LAS unsigned short* maskl = (LAS unsigned short*)(lds + L_MASK);
  bf16x8 qf[2][4];
#pragma unroll
  for (int j = 0; j < 2; ++j)
#pragma unroll
    for (int s = 0; s < 4; ++s) qf[j][s] = *(const bf16x8*)(P.Q + ((size_t)(b * 64 + qt) * 16 + (2 * w + j)) * 2048 + s * 512 + lane * 8);
  __syncthreads();
  if (qt >= 8) {
    const bf16* ikb = P.IK + (size_t)(b * 64) * 2048 + lane * 8;
    bf16x8 ikc[4], ikn[4];
#pragma unroll
    for (int s = 0; s < 4; ++s) ikc[s] = *(const bf16x8*)(ikb + (size_t)w * 2048 + 512 * s);
    LAS float* wl = (LAS float*)(lds + L_HIST);
    { f32x4 wv = {0.f, 0.f, 0.f, 0.f}; if (tid < 64) wv = *(const f32x4*)(P.IW + (rowb + t0) * 8 + tid * 4);
      const int row = tid >> 4, ch = tid & 15; const u32x4* src = (const u32x4*)(P.IQ + (rowb + t0 + row) * 512);
#pragma unroll
      for (int c = 0; c < 4; ++c) *(LAS u32x4*)(lds + L_IQ + row * IQ_STRIDE + (ch + 16 * c) * 16) = __builtin_nontemporal_load(src + ch + 16 * c);
      if (tid < 64) *(LAS f32x4*)(wl + tid * 4) = wv; }
    __syncthreads();
    unsigned pl[4][16];
#pragma unroll
    for (int B = 0; B < 4; ++B) {
      if (B == 0 || w + 16 * B < nkt) {
#pragma unroll
      for (int h2 = 0; h2 < 2; ++h2) {
        const int kt = w + 8 * (2 * B + h2);
        if (2 * B + h2 < 7) { const int ktn = (kt + 8 < nkt) ? kt + 8 : w;
#pragma unroll
          for (int s = 0; s < 4; ++s) ikn[s] = *(const bf16x8*)(ikb + (size_t)ktn * 2048 + 512 * s); }
        float sc[16];
        if (2 * B + h2 == 0 || kt < nkt) {
#pragma unroll
          for (int s = 0; s < 4; ++s) asm volatile("" : "+v"(ikc[s]));
#pragma unroll
          for (int r = 0; r < 16; ++r) sc[r] = 0.f;
#pragma unroll 2
          for (int hd = 0; hd < 8; ++hd) {
            f32x16 c;
#pragma unroll
            for (int r = 0; r < 16; ++r) c[r] = 0.f;
#pragma unroll
            for (int s = 0; s < 4; ++s) { const bf16x8 bq = *(const LAS bf16x8*)(lds + L_IQ + q * IQ_STRIDE + (hd * 64 + 16 * s + 8 * hi) * 2); c = MFMA32(ikc[s], bq, c); }
            const float wh = wl[q * 8 + hd];
#pragma unroll
            for (int r = 0; r < 16; ++r) { const int ci_ = __builtin_bit_cast(int, (float)c[r]); sc[r] += wh * __builtin_bit_cast(float, ci_ > 0 ? ci_ : 0); asm("" : "+v"(sc[r])); }
          }
          if (kt == qt) {
#pragma unroll
            for (int r = 0; r < 16; ++r) if (kidx(r, hi) > q) sc[r] = -INFINITY;
          }
        } else {
#pragma unroll
          for (int r = 0; r < 16; ++r) sc[r] = -INFINITY;
        }
#pragma unroll
        for (int v = 0; v < 16; ++v) {
          if (h2 == 0) pl[B][v] = __builtin_bit_cast(unsigned, __builtin_amdgcn_cvt_pkrtz(sc[v], 0.f));
          else pl[B][v] |= __builtin_bit_cast(unsigned, __builtin_amdgcn_cvt_pkrtz(0.f, sc[v]));
        }
#pragma unroll
        for (int s = 0; s < 4; ++s) ikc[s] = ikn[s];
      }
#pragma unroll
      for (int v = 0; v < 16; ++v) { const unsigned u = pl[B][v]; const s16x2 sg = __builtin_bit_cast(s16x2, u) >> (s16x2){15, 15}; pl[B][v] = u ^ (__builtin_bit_cast(unsigned, sg) & 0x7FFF7FFFu); }
#define TR_STAGE(J, MJ) _Pragma("unroll") for (int k = 0; k < 16; ++k) if ((k & (J)) == 0) { const unsigned t = ((pl[B][k] >> (J)) ^ pl[B][k + (J)]) & (MJ); pl[B][k + (J)] ^= t; pl[B][k] ^= t << (J); }
      TR_STAGE(8, 0x00FF00FFu) TR_STAGE(4, 0x0F0F0F0Fu) TR_STAGE(2, 0x33333333u) TR_STAGE(1, 0x55555555u)
#undef TR_STAGE
      pl[B][15] = ~pl[B][15];
      } else {
#pragma unroll
        for (int v = 0; v < 16; ++v) pl[B][v] = v < 10 ? 0xFFFFFFFFu : 0u;
      }
#pragma unroll
      for (int v = 0; v < 16; ++v) asm volatile("" : "+v"(pl[B][v]));
      __builtin_amdgcn_sched_barrier(0);
    }
    LAS unsigned* cb = (LAS unsigned*)(lds + L_HIST + 32 * 257 * 4);
    if (tid < 64) cb[tid] = 0u;
    __syncthreads();
    unsigned mm[4] = {0xFFFFFFFFu, 0xFFFFFFFFu, 0xFFFFFFFFu, 0xFFFFFFFFu}, gt[4] = {0u, 0u, 0u, 0u}, Gtot = 0u, prev0 = 0u, prev1 = 0u;
#pragma unroll
    for (int bit = 15; bit >= 0; --bit) {
      unsigned t4[4]; unsigned cnt = 0u;
#pragma unroll
      for (int B = 0; B < 4; ++B) { t4[B] = mm[B] & pl[B][bit]; cnt += (unsigned)__builtin_popcount(t4[B]); }
      LAS unsigned* cw = cb + ((bit & 1) ? 32 : 0) + q;
      __hip_atomic_fetch_add(cw, cnt, __ATOMIC_RELAXED, __HIP_MEMORY_SCOPE_WORKGROUP);
      __syncthreads();
      const unsigned run = *cw; unsigned tot;
      if (bit & 1) { tot = run - prev1; prev1 = run; } else { tot = run - prev0; prev0 = run; }
      const bool acc1 = (Gtot + tot) >= 256u;
#pragma unroll
      for (int B = 0; B < 4; ++B) { if (acc1) mm[B] = t4[B]; else { gt[B] |= t4[B]; mm[B] ^= t4[B]; } }
      if (!acc1) Gtot += tot;
    }
    LAS unsigned short* tm = (LAS unsigned short*)(lds + L_HIST + 1024); LAS unsigned short* pf = (LAS unsigned short*)(lds + L_HIST + 1024 + 8192);
#pragma unroll
    for (int B = 0; B < 4; ++B) {
      tm[((w + 8 * (2 * B)) * 32 + q) * 2 + hi] = (unsigned short)(mm[B] & 0xFFFFu);
      tm[((w + 8 * (2 * B + 1)) * 32 + q) * 2 + hi] = (unsigned short)(mm[B] >> 16);
    }
    __syncthreads();
#pragma unroll
    for (int e = 0; e < 4; ++e) {
      const int qq = 4 * w + e;
      const unsigned c = (unsigned)__builtin_popcount(((const LAS unsigned*)tm)[lane * 32 + qq]);
      unsigned excl = 0u;
#pragma unroll
      for (int k = 0; k < 6; ++k) {
        const unsigned long long bm = __builtin_amdgcn_ballot_w64(((c >> k) & 1u) != 0u);
        excl += __builtin_amdgcn_mbcnt_hi((unsigned)(bm >> 32), __builtin_amdgcn_mbcnt_lo((unsigned)bm, 0u)) << k;
      }
      pf[lane * 32 + qq] = (unsigned short)excl;
    }
    __syncthreads();
    { const unsigned need = 256u - Gtot;
#pragma unroll
      for (int B = 0; B < 4; ++B) {
        unsigned sel = gt[B];
#pragma unroll
        for (int h2 = 0; h2 < 2; ++h2) {
          const unsigned t16 = (mm[B] >> (16 * h2)) & 0xFFFFu;
          if (t16) {
            const int kt = w + 8 * (2 * B + h2);
            const unsigned pair = ((const LAS unsigned*)tm)[kt * 32 + q], base = pf[kt * 32 + q];
            const unsigned c0 = (unsigned)__builtin_popcount(pair & 0xFFu), c1 = (unsigned)__builtin_popcount(pair & 0xFF0000u), c2 = (unsigned)__builtin_popcount(pair & 0xFF00u);
            const unsigned offL = base + (hi ? c0 : 0u), offH = base + (hi ? c0 + c1 + c2 : c0 + c1);
            unsigned rem = t16;
            while (rem) { const int pos = __builtin_ctz(rem); rem &= rem - 1u;
              const unsigned below = (unsigned)__builtin_popcount(t16 & ((1u << pos) - 1u) & (pos >= 8 ? 0xFF00u : 0xFFu));
              if ((pos >= 8 ? offH : offL) + below < need) sel |= 1u << (pos + 16 * h2); }
          }
        }
        if (w + 8 * (2 * B) < nkt) maskl[(w + 8 * (2 * B)) * 64 + lane] = (unsigned short)(sel & 0xFFFFu);
        if (w + 8 * (2 * B + 1) < nkt) maskl[(w + 8 * (2 * B + 1)) * 64 + lane] = (unsigned short)(sel >> 16);
      } }
  } else {
    const unsigned cm = causal16(q, hi);
#pragma unroll
    for (int i = 0; i < 8; ++i) { const int kt = w + 8 * i; if (kt < nkt) maskl[kt * 64 + lane] = (unsigned short)(kt == qt ? cm : 0xFFFFu); }
  }
  __syncthreads();
  const int g = w >> 1;
  const bf16* img = P.KV + (size_t)(b * 64) * 16384;
  const unsigned lds0 = (unsigned)(uintptr_t)lds;
#pragma unroll
  for (int j = 0; j < 2; ++j)
#pragma unroll
    for (int s = 0; s < 4; ++s) asm volatile("" : "+v"(qf[j][s]));
  f32x16 O[2][2]; float l[2] = {0.f, 0.f};
#pragma unroll
  for (int j = 0; j < 2; ++j)
#pragma unroll
    for (int dt = 0; dt < 2; ++dt)
#pragma unroll
      for (int r = 0; r < 16; ++r) O[j][dt][r] = 0.f;
  const LAS float* bt0 = (const LAS float*)(lds + L_BTAB) + (2 * w) * 192;
  LAS unsigned char* ringp = lds + 65536 + w * 8192;
  const char* ksrc = (const char*)img + g * 4096; const unsigned voff = (unsigned)lane * 16u;
  const unsigned kring = lds0 + (unsigned)w * 8192u; const LAS unsigned char* kl = lds + w * 8192 + lane * 16;
#define TSRC(t_) (ksrc + (size_t)((t_) < nkt ? (t_) : nkt - 1) * 32768)
  bf16x8 vA[4], vB[4]; f32x16 cA[2], cB[2];
  k_dma(TSRC(0), voff, kring); v_load(vA, TSRC(0) + 16384, voff); k_dma(TSRC(1), voff, kring + 4096u);
  kv_wait(vA);
  qk_tile(cA, kl, qf);
#pragma unroll 1
  for (int kt = 0; ; kt += 2) {
    k_dma(TSRC(kt + 2), voff, kring); v_load(vB, TSRC(kt + 1) + 16384, voff);
    if (qt - kt <= 4) add_bias(cA, bt0, (t0 + q) - (32 * kt + 8 * hi));
    { const unsigned m16 = maskl[kt * 64 + lane];
      qk_tile(cB, kl + 4096, qf); sm_pv<0>(O, l, cA, vA, m16); }
    kv_wait(vB);
    if (kt + 1 >= nkt) break;
    k_dma(TSRC(kt + 3), voff, kring + 4096u); v_load(vA, TSRC(kt + 2) + 16384, voff);
    if (qt - (kt + 1) <= 4) add_bias(cB, bt0, (t0 + q) - (32 * (kt + 1) + 8 * hi));
    { const unsigned m16 = maskl[(kt + 1) * 64 + lane];
      qk_tile(cA, kl, qf); sm_pv<0>(O, l, cB, vB, m16); }
    kv_wait(vA);
    if (kt + 2 >= nkt) break;
  }
#undef TSRC
  { int tid2 = lane_id_hw(); asm volatile("" : "+v"(tid2)); const int lane2 = tid2 & 63;
    attn_store(O, l, P.SG, P.OG, rowb + t0, 2 * w, ringp, lane2); }
}

DI void moba_unit(LAS unsigned char* lds, const Ptrs& P, int b, int qt, int wave_) {
  int tid = wave_ * 64 + lane_id_hw(); asm volatile("" : "+v"(tid));
  const int lane = tid & 63, w = __builtin_amdgcn_readfirstlane(tid >> 6), q = lane & 31, hi = lane >> 5;
  const int t0 = 32 * qt, ob = qt >> 3; const size_t rowb = (size_t)b * SEQ;
  LAS unsigned char* selm = lds + L_SELM; LAS unsigned* blkw = (LAS unsigned*)(lds + L_BLK);
  bf16x8 qf[2][4];
#pragma unroll
  for (int j = 0; j < 2; ++j)
#pragma unroll
    for (int s = 0; s < 4; ++s) qf[j][s] = *(const bf16x8*)(P.Q + ((size_t)(b * 64 + qt) * 16 + (2 * w + j)) * 2048 + s * 512 + lane * 8);
  const int g = w >> 1;
  bf16x8 akh[4], akl[4];
  { const int ia = lane & 31, kh = lane >> 5, nb_ = ia < 4 ? ia : ia - 4; const bool av = (ia < 4 || (ia >= 8 && ia < 11)) && nb_ < ob;
    const float* kmp = P.KM + ((size_t)(b * 4 + g) * 8 + (av ? nb_ : 0)) * 64 + 8 * kh;
#pragma unroll
    for (int s = 0; s < 4; ++s) { const f32x4 k0 = *(const f32x4*)(kmp + 16 * s), k1 = *(const f32x4*)(kmp + 16 * s + 4);
      u32x4 hw; hw.x = cvtpk(k0.x, k0.y); hw.y = cvtpk(k0.z, k0.w); hw.z = cvtpk(k1.x, k1.y); hw.w = cvtpk(k1.z, k1.w);
      u32x4 lw; lw.x = cvtpk(k0.x - bflo(hw.x), k0.y - bfhi(hw.x)); lw.y = cvtpk(k0.z - bflo(hw.y), k0.w - bfhi(hw.y)); lw.z = cvtpk(k1.x - bflo(hw.z), k1.y - bfhi(hw.z)); lw.w = cvtpk(k1.z - bflo(hw.w), k1.w - bfhi(hw.w));
      if (!av) { hw = (u32x4){0u, 0u, 0u, 0u}; lw = hw; }
      akh[s] = __builtin_bit_cast(bf16x8, hw); akl[s] = __builtin_bit_cast(bf16x8, lw); } }
  __syncthreads();
  if (tid == 0) blkw[0] = 0u;
  f32x16 cs;
#pragma unroll
  for (int r = 0; r < 16; ++r) cs[r] = 0.f;
#pragma unroll
  for (int j = 0; j < 2; ++j)
#pragma unroll
    for (int s = 0; s < 4; ++s) { cs = MFMA32(akh[s], qf[j][s], cs); cs = MFMA32(akl[s], qf[j][s], cs); }
  LAS float* gpx = (LAS float*)lds + (size_t)(g * 32 + q) * 8;
  if ((w & 1) && hi == 0) {
#pragma unroll
    for (int n = 0; n < 7; ++n) gpx[n] = cs[n]; }
  __syncthreads();
  if (!(w & 1) && hi == 0) {
    unsigned sel = 0;
    if (ob > 0) {
      float gs[7];
#pragma unroll
      for (int n = 0; n < 7; ++n) gs[n] = (n < ob) ? (cs[n] + gpx[n]) : -INFINITY;
#pragma unroll
      for (int n = 0; n < 7; ++n) { if (n < ob) { int rank = 0;
#pragma unroll
          for (int m = 0; m < 7; ++m) if (m != n && m < ob) rank += ((gs[m] > gs[n]) || (gs[m] == gs[n] && m < n)) ? 1 : 0;
          if (rank < 3) sel |= 1u << n; } }
    }
    selm[g * 32 + q] = (unsigned char)sel;
    if (sel) __hip_atomic_fetch_or(blkw, sel, __ATOMIC_RELAXED, __HIP_MEMORY_SCOPE_WORKGROUP);
  }
  __syncthreads();
  const unsigned mysel = selm[g * 32 + q];
  const unsigned blk = (unsigned)__builtin_amdgcn_readfirstlane(blkw[0]) | (1u << ob);
  const bf16* img = P.KV + (size_t)(b * 64) * 16384;
  const unsigned lds0 = (unsigned)(uintptr_t)lds;
#pragma unroll
  for (int j = 0; j < 2; ++j)
#pragma unroll
    for (int s = 0; s < 4; ++s) asm volatile("" : "+v"(qf[j][s]));
  f32x16 O[2][2]; float l[2] = {0.f, 0.f};
#pragma unroll
  for (int j = 0; j < 2; ++j)
#pragma unroll
    for (int dt = 0; dt < 2; ++dt)
#pragma unroll
      for (int r = 0; r < 16; ++r) O[j][dt][r] = 0.f;
  const LAS float* bt0 = (const LAS float*)(lds + L_BTAB) + (2 * w) * 192;
#define NEXT_TILE(kt_, out_) do { int kn_ = (kt_) + 1; if (kn_ > qt) kn_ = -1; else if (((blk >> (kn_ >> 3)) & 1u) == 0u) kn_ = 8 * ((kn_ >> 3) + __builtin_ctz(blk >> (kn_ >> 3))); (out_) = kn_; } while (0)
  LAS unsigned char* ringp = lds + 65536 + w * 8192;
  const char* ksrc = (const char*)img + g * 4096; const unsigned voff = (unsigned)lane * 16u;
  const unsigned kring = lds0 + (unsigned)w * 8192u; const LAS unsigned char* kl = lds + w * 8192 + lane * 16;
  int ta = 8 * __builtin_ctz(blk), tb, tc, td;
  NEXT_TILE(ta, tb); tc = -1; if (tb >= 0) NEXT_TILE(tb, tc);
  const int tfirst = ta;
#define TSRC(t_) (ksrc + (size_t)((t_) >= 0 ? (t_) : tfirst) * 32768)
#define MOBA_SM(C, VF, KT) do { const int n_ = (KT) >> 3; const unsigned lm_ = (n_ < ob) ? (0u - ((mysel >> n_) & 1u)) : 0xFFFFFFFFu; sm_pv<1>(O, l, C, VF, lm_); } while (0)
  bf16x8 vA[4], vB[4]; f32x16 cA[2], cB[2];
  k_dma(TSRC(ta), voff, kring); v_load(vA, TSRC(ta) + 16384, voff); k_dma(TSRC(tb), voff, kring + 4096u);
  kv_wait(vA);
  qk_tile(cA, kl, qf);
#pragma unroll 1
  while (true) {
    k_dma(TSRC(tc), voff, kring); v_load(vB, TSRC(tb) + 16384, voff);
    if (qt - ta <= 4) add_bias(cA, bt0, (t0 + q) - (32 * ta + 8 * hi));
    qk_tile(cB, kl + 4096, qf); MOBA_SM(cA, vA, ta);
    kv_wait(vB);
    if (tb < 0) break;
    td = -1; if (tc >= 0) NEXT_TILE(tc, td);
    k_dma(TSRC(td), voff, kring + 4096u); v_load(vA, TSRC(tc) + 16384, voff);
    if (qt - tb <= 4) add_bias(cB, bt0, (t0 + q) - (32 * tb + 8 * hi));
    qk_tile(cA, kl, qf); MOBA_SM(cB, vB, tb);
    kv_wait(vA);
    if (tc < 0) break;
    ta = tc; tb = td; tc = -1; if (tb >= 0) NEXT_TILE(tb, tc);
  }
#undef MOBA_SM
#undef TSRC
#undef NEXT_TILE
  { int tid2 = lane_id_hw(); asm volatile("" : "+v"(tid2)); const int lane2 = tid2 & 63;
    attn_store(O, l, P.SG, P.OG, rowb + t0, 2 * w, ringp, lane2); }
}

__global__ void __launch_bounds__(512, 2) fwd(Args args) {
  extern __shared__ __attribute__((aligned(16))) unsigned char lds_raw[];
  LAS unsigned char* lds = (LAS unsigned char*)lds_raw;
  const int wave = __builtin_amdgcn_readfirstlane((int)threadIdx.x >> 6);
#define FRESH_TID(t_) int t_ = wave * 64 + lane_id_hw(); asm volatile("" : "+v"(t_))
  const int G = gridDim.x, bx = blockIdx.x;
  const int vcu = (G % 8 == 0) ? (bx % 8) * (G / 8) + bx / 8 : bx;
  LAS unsigned long long* ptab = (LAS unsigned long long*)(lds + L_MISC + 64);
  { FRESH_TID(tid0);
    if (tid0 < 16) { const unsigned long long* ka = (const unsigned long long*)__builtin_amdgcn_kernarg_segment_ptr(); ptab[tid0] = ka[tid0]; ((LAS unsigned*)(lds + L_MISC))[tid0] = 0u; }
    __syncthreads(); }
#define TABPTR(k) ((unsigned char*)(__attribute__((address_space(1))) unsigned char*)(((unsigned long long)(unsigned)__builtin_amdgcn_readfirstlane((int)(ptab[(k)] >> 32)) << 32) | (unsigned long long)(unsigned)__builtin_amdgcn_readfirstlane((int)(unsigned)ptab[(k)])))
#define LOAD_PTRS() Ptrs P; { asm volatile("" ::: "memory"); unsigned char* ws = TABPTR(15); \
  P.x = (const float*)TABPTR(0); P.norm_a_g = (const float*)TABPTR(1); P.w_in_a = (const float*)TABPTR(2); P.qn_a_g = (const float*)TABPTR(3); P.kn_a_g = (const float*)TABPTR(4); P.w_out_a = (const float*)TABPTR(5); P.rel_bias = (const float*)TABPTR(6); \
  P.norm_kv_g = (const float*)TABPTR(7); P.w_kv = (const float*)TABPTR(8); P.kn_b_g = (const float*)TABPTR(9); P.norm_b_g = (const float*)TABPTR(10); P.w_in_b = (const float*)TABPTR(11); P.qn_b_g = (const float*)TABPTR(12); P.w_out_b = (const float*)TABPTR(13); \
  P.out = (float*)TABPTR(14); \
  P.WtA = (bf16*)(ws + WS_WA); P.WtOA = (bf16*)(ws + WS_WOA); P.WtB = (bf16*)(ws + WS_WB); P.WtOB = (bf16*)(ws + WS_WOB); \
  P.XN = (bf16*)(ws + WS_XN); P.Q = (bf16*)(ws + WS_Q); P.KV = (bf16*)(ws + WS_K); P.SG = (bf16*)(ws + WS_SG); \
  P.IQ = (bf16*)(ws + WS_IQ); P.IK = (bf16*)(ws + WS_IK); P.OG = (bf16*)(ws + WS_OG); \
  P.IW = (float*)(ws + WS_IW); P.KM = (float*)(ws + WS_KM); P.RINV = (float*)(ws + WS_KM + 524288); P.SSQ = (float*)(ws + WS_H1); }
  const int lo = args.ph_lo, hi = args.ph_hi;
#ifndef PH_MASK
#define PH_MASK 0x1ff
#endif
#ifndef REP_MASK
#define REP_MASK 0
#endif
#define IN(k) (((PH_MASK >> (k)) & 1) && lo <= (k) && (k) < hi)
#define NREP(k) ((((REP_MASK) >> (k)) & 1) ? 2 : 1)
#if MK_N_LAUNCHES == 1
  const bool grouped = (G == 256);
  XcdBarrier xbar = xcd_barrier_post((unsigned*)TABPTR(15), (volatile LAS unsigned*)(lds + L_MISC), wave == 0 && lane_id_hw() == 0, (unsigned)G);
  XcdBarrier xbarL = xcd_barrier_post((unsigned*)(TABPTR(15) + 16384 * (1 + (bx & 7))), (volatile LAS unsigned*)(lds + L_MISC) + 2, wave == 0 && lane_id_hw() == 0, (unsigned)(G / 8));
#define SEAM(k) do { if (IN(k) && (hi > (k) + 1)) { if ((k) == 0 || !grouped) xcd_barrier(xbar, wave == 0 && lane_id_hw() == 0); else xcd_barrier(xbarL, wave == 0 && lane_id_hw() == 0); } } while (0)
#else
#define SEAM(k) do { } while (0)
#endif
  const int gw = vcu * 8 + wave, NGW = G * 8;

  if (IN(0)) {
    LOAD_PTRS();
    FRESH_TID(tid); const int lane = tid & 63;
    LAS float* scr = (LAS float*)(lds + wave * 8448);
    constexpr int I_A = 16 * (NCOL_A / 32), I_O = 16 * 32, I_KV = 16 * 16, I_B = 16 * 64;
    constexpr int NITEMS = I_A + I_O + I_KV + I_B + I_O;
#define P0_ITEM(it_) do { int r = (it_); \
      if (r < I_A) { trans_item(P.w_in_a, 3144, P.norm_a_g, P.WtA, r, NCOL_A / 32, 1, scr, lane); break; } r -= I_A; \
      if (r < I_O) { trans_item(P.w_out_a, 1024, nullptr, P.WtOA, r, 32, 0, scr, lane); break; } r -= I_O; \
      if (r < I_KV) { trans_item(P.w_kv, 512, P.norm_kv_g, P.WtB, r, 16, 0, scr, lane); break; } r -= I_KV; \
      if (r < I_B) { trans_item(P.w_in_b, 2048, P.norm_b_g, P.WtB + (size_t)512 * 1024, r, 64, 0, scr, lane); break; } r -= I_B; \
      trans_item(P.w_out_b, 1024, nullptr, P.WtOB, r, 32, 0, scr, lane); } while (0)
    int itw = gw;
    for (int m = gw; m < MTOK; m += 4 * NGW) {
      f32x4 v[4][4]; float ss[4];
#pragma unroll
      for (int u = 0; u < 4; ++u) { const int mm = m + u * NGW; const f32x4* xr = (const f32x4*)(P.x + (size_t)(mm < MTOK ? mm : m) * 1024) + lane;
#pragma unroll
        for (int j = 0; j < 4; ++j) v[u][j] = __builtin_nontemporal_load(xr + 64 * j); }
      if (itw < NITEMS) { P0_ITEM(itw); itw += NGW; }
#pragma unroll
      for (int u = 0; u < 4; ++u) { float a = 0.f;
#pragma unroll
        for (int j = 0; j < 4; ++j) a += (v[u][j].x * v[u][j].x + v[u][j].y * v[u][j].y) + (v[u][j].z * v[u][j].z + v[u][j].w * v[u][j].w);
        ss[u] = a; }
#pragma unroll
      for (int o = 1; o < 64; o <<= 1) {
#pragma unroll
        for (int u = 0; u < 4; ++u) ss[u] += __shfl_xor(ss[u], o); }
#pragma unroll
      for (int u = 0; u < 4; ++u) { const int mm = m + u * NGW; if (mm < MTOK) {
          u32x2* o8 = (u32x2*)(P.XN + (size_t)mm * 1024) + lane;
#pragma unroll
          for (int j = 0; j < 4; ++j) { u32x2 w; w.x = cvtpk(v[u][j].x, v[u][j].y); w.y = cvtpk(v[u][j].z, v[u][j].w); o8[64 * j] = w; }
          if (lane == 0) P.RINV[mm] = rsqrtf(ss[u] * (1.0f / 1024.0f) + EPS); } }
    }
    for (; itw < NITEMS; itw += NGW) P0_ITEM(itw);
#undef P0_ITEM
    for (int i = gw * 64 + lane; i < NBATCH * 4 * 8 * 64; i += NGW * 64) P.KM[i] = 0.f;
    __syncthreads();
  }
  SEAM(0);
  if (IN(1)) for (int rep_ = 0; rep_ < NREP(1); ++rep_) {
    LOAD_PTRS();
    pg8::Gemm g{P.XN, P.WtA, MTOK, NCOL_A, 1024}; OrderR S; S.init(MTOK, NCOL_A, G, bx); S.rv = P.RINV; S.ldsb = (unsigned)(uintptr_t)(lds + L_EPI); S.wv = wave; S.k = 0;
    EpiA E{P.Q, P.KV, P.SG, P.IQ, P.IK, P.IW, P.qn_a_g, P.kn_a_g, (const LAS float*)(lds + L_EPI), 0};
    pg8::gemm_phase<EpiA, OrderR, true, true>(lds, g, S, E, wave);
    __syncthreads();
  }
  SEAM(1);
  if (IN(2)) for (int rep_ = 0; rep_ < NREP(2); ++rep_) {
    LOAD_PTRS();
    { FRESH_TID(tidb); build_btab(lds, P.rel_bias, tidb); }
#pragma unroll 1
    for (int i = 0; ; ++i) { int b, qt;
      if (G == 256) { if (i >= 4) break; const int c = vcu & 31; b = 2 * (vcu >> 5) + (i >> 1); qt = (i & 1) ? c : 63 - c; }
      else { const int u = vcu + i * G; if (u >= 1024) break; b = u >> 6; qt = 63 - (u & 63); }
      dsa_unit(lds, P, b, qt, wave); }
    __syncthreads();
  }
  SEAM(2);
  if (IN(3)) for (int rep_ = 0; rep_ < NREP(3); ++rep_) {
    LOAD_PTRS();
    pg8::Gemm g{P.OG, P.WtOA, MTOK, 1024, 1024}; pg8::StaticOrder S; S.init(MTOK, 1024, G, bx);
    EpiRes2 E{P.XN, P.SSQ, (LAS float*)(lds + L_EPI)};
    pg8::gemm_phase<EpiRes2, pg8::StaticOrder, true, true>(lds, g, S, E, wave);
    __syncthreads();
  }
  SEAM(3);
  if (IN(5)) for (int rep_ = 0; rep_ < NREP(5); ++rep_) {
    LOAD_PTRS();
    pg8::Gemm g{P.XN, P.WtB, MTOK, NCOL_B, 1024}; OrderS S; S.init(MTOK, NCOL_B, G, bx); S.sv = P.SSQ; S.ldsb = (unsigned)(uintptr_t)(lds + L_EPI); S.wv = wave; S.k = 0;
    EpiB E{P.Q, P.KV, P.SG, P.qn_b_g, P.kn_b_g, (const LAS f32x4*)(lds + L_EPI), P.KM, 0};
    pg8::gemm_phase<EpiB, OrderS, true, true>(lds, g, S, E, wave);
    __syncthreads();
  }
  SEAM(5);
  if (IN(7)) for (int rep_ = 0; rep_ < NREP(7); ++rep_) {
    LOAD_PTRS();
    { FRESH_TID(tidb); build_btab(lds, P.rel_bias, tidb); }
#pragma unroll 1
    for (int i = 0; ; ++i) { int b, qt;
      if (G == 256) { if (i >= 4) break; const int c = vcu & 31; b = 2 * (vcu >> 5) + (i >> 1); qt = (i & 1) ? c : 63 - c; }
      else { const int u = vcu + i * G; if (u >= 1024) break; b = u >> 6; qt = 63 - (u & 63); }
      moba_unit(lds, P, b, qt, wave); }
    __syncthreads();
  }
  SEAM(7);
  if (IN(8)) for (int rep_ = 0; rep_ < NREP(8); ++rep_) {
    LOAD_PTRS();
    pg8::Gemm g{P.OG, P.WtOB, MTOK, 1024, 1024}; pg8::StaticOrder S; S.init(MTOK, 1024, G, bx);
    EpiRes E{P.XN, P.out, lds + L_EPI};
    pg8::gemm_phase<EpiRes, pg8::StaticOrder, true, true>(lds, g, S, E, wave);
  }
#undef IN
#undef SEAM
}

extern "C" void kernel_launch(void* const* d_in, const int* in_sizes, int n_in, void* d_out, int out_size, void* d_ws, size_t ws_size, hipStream_t stream) {
  static int grid = 0;
  if (grid == 0) {
    if (n_in != 14 || out_size != MTOK * DM || ws_size < WS_END) { fprintf(stderr, "kernel_launch: unexpected problem (n_in %d, out %d, ws %zu)\n", n_in, out_size, ws_size); grid = -1; return; }
    int dev = 0, cus = 0, per_cu = 0;
    if (hipGetDevice(&dev) != hipSuccess || hipDeviceGetAttribute(&cus, hipDeviceAttributeMultiprocessorCount, dev) != hipSuccess) { grid = -1; return; }
    if (hipFuncSetAttribute((const void*)fwd, hipFuncAttributeMaxDynamicSharedMemorySize, LDS_BYTES) != hipSuccess) { fprintf(stderr, "kernel_launch: hipFuncSetAttribute failed\n"); grid = -1; return; }
    if (hipOccupancyMaxActiveBlocksPerMultiprocessor(&per_cu, (const void*)fwd, 512, LDS_BYTES) != hipSuccess || per_cu < 1) { fprintf(stderr, "kernel_launch: occupancy query says %d\n", per_cu); per_cu = 1; }
    (void)hipGetLastError();
    grid = cus;
  }
  if (grid < 0) return;
  Args a{};
  for (int i = 0; i < 14; ++i) a.in[i] = (const float*)d_in[i];
  a.out = (float*)d_out; a.ws = (unsigned char*)d_ws;
#if MK_N_LAUNCHES == 1
  if (hipMemsetAsync(d_ws, 0, 16384 * 9, stream) != hipSuccess) { fprintf(stderr, "kernel_launch: memset of the barrier words failed\n"); return; }
  a.ph_lo = 0; a.ph_hi = NPHASE;
  void* kargs[] = {&a};
  hipError_t e = hipLaunchCooperativeKernel((const void*)fwd, dim3(grid), dim3(512), kargs, LDS_BYTES, stream);
  if (e != hipSuccess) fprintf(stderr, "kernel_launch: cooperative launch failed: %s\n", hipGetErrorString(e));
#else
#ifndef HOST_REP_MASK
#define HOST_REP_MASK 0
#endif
  for (int p = 0; p < NPHASE; ++p) { a.ph_lo = p; a.ph_hi = p + 1; for (int r = 0; r < (((HOST_REP_MASK >> p) & 1) ? 2 : 1); ++r) hipLaunchKernelGGL(fwd, dim3(grid), dim3(512), LDS_BYTES, stream, a); }
#endif
}
```
